# Optimizing an MI355X kernel written in HIP

```python
import math
import jax
import jax.numpy as jnp
from jax import lax
import numpy as np

D_MODEL = 1024
BATCH = 16
SEQ = 2048
DEPTH = 2

MLSTM_HEADS = 4
MLSTM_HEAD_DIM = D_MODEL // 8
MLSTM_WIDTH = MLSTM_HEADS * MLSTM_HEAD_DIM
MLSTM_CHUNK = 128
CONV_WIDTH = 4
POOL_WINDOWS = (2, 4, 8, 16)
POOL_GROUPS = len(POOL_WINDOWS)
POOL_GROUP_DIM = D_MODEL // 8
POOL_WIDTH = POOL_GROUPS * POOL_GROUP_DIM
EVEN_MIX_WIDTH = MLSTM_WIDTH + POOL_WIDTH
EVEN_IN_WIDTH = 3 * MLSTM_WIDTH + POOL_WIDTH + 2 * MLSTM_HEADS
ATTN_HEADS = 16
ATTN_KV_HEADS = 2
ATTN_GROUP = ATTN_HEADS // ATTN_KV_HEADS
ATTN_HEAD_DIM = D_MODEL // ATTN_HEADS
ATTN_WIDTH = ATTN_HEADS * ATTN_HEAD_DIM
QKV_WIDTH = (ATTN_HEADS + 2 * ATTN_KV_HEADS) * ATTN_HEAD_DIM
ATTN_WINDOW = 128
ATTN_BLOCK = 128
REL_BUCKETS = 32
REL_MAX_DIST = 128
PEER_HEADS = 8
PEER_NKEYS = 128
PEER_EXPERTS = PEER_NKEYS * PEER_NKEYS
PEER_TOPK = 16
PEER_QUERY_DIM = 256
PEER_HALF_DIM = PEER_QUERY_DIM // 2
PEER_TOKEN_CHUNK = 128

NORM_EPS = 1e-6
MLSTM_EPS = 1e-6
NEG_INF = -1e30

kernel_name = 'hybrid_mlstm_pool_swa_peer_adaln'


def rms_norm(x, g):
    xf = x.astype(jnp.float32)
    y = xf * lax.rsqrt(jnp.mean(xf * xf, axis=-1, keepdims=True) + NORM_EPS)
    return (y * g.astype(jnp.float32)).astype(x.dtype)


def ada_norm(x, g, cond, w, b):
    mod = (cond @ w + b)[:, None, :]
    shift, scale, gate = jnp.split(mod, 3, axis=-1)
    return rms_norm(x, g) * (1 + scale) + shift, gate


def causal_depthwise_conv(u, w, b):
    out = lax.conv_general_dilated(
        u, w[:, None, :].astype(u.dtype), window_strides=(1,),
        padding=[(CONV_WIDTH - 1, 0)], dimension_numbers=('NWC', 'WIO', 'NWC'),
        feature_group_count=u.shape[-1])
    return out + b


def mlstm_chunkwise(q, k, v, i_pre, log_f):
    B, H, S, d = q.shape
    nc = S // MLSTM_CHUNK
    L = MLSTM_CHUNK

    def to_chunks(a):
        return jnp.moveaxis(a.reshape(B, H, nc, L, *a.shape[3:]), 2, 0)

    causal = jnp.tril(jnp.ones((L, L), dtype=bool))

    def step(carry, xs):
        C, n, m = carry
        q_c, k_c, v_c, i_c, f_c = xs
        g = jnp.cumsum(f_c, axis=-1)
        a = g + m[..., None]
        log_d = g[..., :, None] - g[..., None, :] + i_c[..., None, :]
        log_d = jnp.where(causal, log_d, NEG_INF)
        m_row = jnp.maximum(a, jnp.max(log_d, axis=-1))
        d_mat = jnp.exp(log_d - m_row[..., None])
        inter = jnp.exp(a - m_row)
        s = jnp.einsum('bhld,bhsd->bhls', q_c, k_c) * d_mat
        num = inter[..., None] * jnp.einsum('bhld,bhde->bhle', q_c, C) + jnp.einsum('bhls,bhse->bhle', s, v_c)
        den = inter * jnp.einsum('bhld,bhd->bhl', q_c, n) + jnp.sum(s, axis=-1)
        h = num / (jnp.maximum(jnp.abs(den), jnp.exp(-m_row)) + MLSTM_EPS)[..., None]
        g_tot = g[..., -1]
        log_w = g_tot[..., None] - g + i_c
        m_new = jnp.maximum(g_tot + m, jnp.max(log_w, axis=-1))
        w = jnp.exp(log_w - m_new[..., None])
        decay = jnp.exp(g_tot + m - m_new)
        C_new = decay[..., None, None] * C + jnp.einsum('bhs,bhsd,bhse->bhde', w, k_c, v_c)
        n_new = decay[..., None] * n + jnp.einsum('bhs,bhsd->bhd', w, k_c)
        return (C_new, n_new, m_new), h

    init = (jnp.zeros((B, H, d, d), jnp.float32), jnp.zeros((B, H, d), jnp.float32),
            jnp.full((B, H), NEG_INF, jnp.float32))
    xs = (to_chunks(q), to_chunks(k), to_chunks(v), to_chunks(i_pre), to_chunks(log_f))
    _, hs = lax.scan(step, init, xs)
    return jnp.moveaxis(hs, 0, 2).reshape(B, H, S, d)


def multiscale_pool(u, pool_w, pool_scale):
    B, S, _ = u.shape
    ug = u.reshape(B, S, POOL_GROUPS, POOL_GROUP_DIM).astype(jnp.float32)
    cs = jnp.pad(jnp.cumsum(ug, axis=1), ((0, 0), (1, 0), (0, 0), (0, 0)))
    t = jnp.arange(S)[:, None]
    win = jnp.array(POOL_WINDOWS, dtype=jnp.int32)[None, :]
    lo = jnp.maximum(t + 1 - win, 0)
    win_sum = cs[:, 1:] - cs[:, lo, jnp.arange(POOL_GROUPS)]
    count = jnp.minimum(t + 1, win).astype(jnp.float32)
    pooled = win_sum / count[None, :, :, None] - ug
    y = jnp.einsum('bsgc,gce->bsge', pooled, pool_w.astype(jnp.float32))
    return y.reshape(B, S, POOL_WIDTH) * pool_scale.astype(jnp.float32)


def mlstm_pool_mixer(h, w_in, b_if, conv_w, conv_b, w_q, w_k, head_g, skip, pool_w, pool_scale, w_out):
    B, S, _ = h.shape
    mw = MLSTM_WIDTH
    proj = h @ w_in
    u_m = proj[..., :mw]
    v = proj[..., mw:2 * mw]
    z = proj[..., 2 * mw:3 * mw]
    u_p = proj[..., 3 * mw:3 * mw + POOL_WIDTH]
    gates = proj[..., 3 * mw + POOL_WIDTH:].reshape(B, S, 2, MLSTM_HEADS).astype(jnp.float32) + b_if.astype(jnp.float32)
    i_pre = jnp.transpose(gates[:, :, 0], (0, 2, 1))
    log_f = jax.nn.log_sigmoid(jnp.transpose(gates[:, :, 1], (0, 2, 1)))
    c_m = jax.nn.silu(causal_depthwise_conv(u_m, conv_w, conv_b))
    c_h = c_m.reshape(B, S, MLSTM_HEADS, MLSTM_HEAD_DIM)
    q = jnp.einsum('bshd,hde->bhse', c_h, w_q).astype(jnp.float32)
    k = jnp.einsum('bshd,hde->bhse', c_h, w_k).astype(jnp.float32) * (MLSTM_HEAD_DIM ** -0.5)
    vh = jnp.transpose(v.reshape(B, S, MLSTM_HEADS, MLSTM_HEAD_DIM), (0, 2, 1, 3)).astype(jnp.float32)
    h_t = mlstm_chunkwise(q, k, vh, i_pre, log_f)
    mu = jnp.mean(h_t, axis=-1, keepdims=True)
    var = jnp.mean(jnp.square(h_t - mu), axis=-1, keepdims=True)
    h_n = jnp.transpose((h_t - mu) * lax.rsqrt(var + NORM_EPS), (0, 2, 1, 3)).reshape(B, S, mw)
    a_out = jax.nn.sigmoid(z.astype(jnp.float32)) * (h_n * head_g + skip * c_m.astype(jnp.float32))
    p_out = multiscale_pool(u_p, pool_w, pool_scale)
    mixed = jnp.concatenate([a_out, p_out], axis=-1).astype(h.dtype)
    return mixed @ w_out


def t5_causal_bucket(dist):
    n = jnp.maximum(dist, 0)
    max_exact = REL_BUCKETS // 2
    log_ratio = jnp.log(jnp.maximum(n, 1).astype(jnp.float32) / max_exact) / math.log(REL_MAX_DIST / max_exact)
    large = jnp.minimum(max_exact + (log_ratio * (REL_BUCKETS - max_exact)).astype(jnp.int32), REL_BUCKETS - 1)
    return jnp.where(n < max_exact, n, large)


def sliding_window_attention(h, w_qkv, b_qkv, sinks, w_o, b_o, rel_bias):
    B, S, _ = h.shape
    nb = S // ATTN_BLOCK
    qkv = h @ w_qkv + b_qkv
    k0 = ATTN_WIDTH
    k1 = k0 + ATTN_KV_HEADS * ATTN_HEAD_DIM
    q = qkv[..., :k0].reshape(B, nb, ATTN_BLOCK, ATTN_KV_HEADS, ATTN_GROUP, ATTN_HEAD_DIM)
    k = qkv[..., k0:k1].reshape(B, nb, ATTN_BLOCK, ATTN_KV_HEADS, ATTN_HEAD_DIM)
    v = qkv[..., k1:].reshape(B, nb, ATTN_BLOCK, ATTN_KV_HEADS, ATTN_HEAD_DIM)

    def band(a):
        prev = jnp.pad(a[:, :-1], ((0, 0), (1, 0), (0, 0), (0, 0), (0, 0)))
        return jnp.concatenate([prev, a], axis=2)

    k_band = band(k)
    v_band = band(v)
    qi = jnp.arange(ATTN_BLOCK)[:, None]
    kj = jnp.arange(2 * ATTN_BLOCK)[None, :]
    dist = qi + ATTN_BLOCK - kj
    in_window = (dist >= 0) & (dist < ATTN_WINDOW)
    bias = rel_bias[t5_causal_bucket(dist)].astype(jnp.float32)
    bias = jnp.transpose(bias, (2, 0, 1)).reshape(ATTN_KV_HEADS, ATTN_GROUP, ATTN_BLOCK, 2 * ATTN_BLOCK)
    sink = jnp.broadcast_to(sinks.astype(jnp.float32).reshape(1, ATTN_KV_HEADS, ATTN_GROUP, 1, 1),
                            (B, ATTN_KV_HEADS, ATTN_GROUP, ATTN_BLOCK, 1))
    scale = ATTN_HEAD_DIM ** -0.5

    def block(args):
        qb, kb, vb, blk = args
        logits = jnp.einsum('bqkgd,bskd->bkgqs', qb, kb).astype(jnp.float32) * scale + bias
        key_pos = blk * ATTN_BLOCK - ATTN_BLOCK + jnp.arange(2 * ATTN_BLOCK)
        valid = in_window & (key_pos >= 0)[None, :]
        logits = jnp.where(valid, logits, NEG_INF)
        probs = jax.nn.softmax(jnp.concatenate([logits, sink], axis=-1), axis=-1)[..., :-1]
        return jnp.einsum('bkgqs,bskd->bqkgd', probs.astype(vb.dtype), vb)

    xs = (jnp.moveaxis(q, 1, 0), jnp.moveaxis(k_band, 1, 0), jnp.moveaxis(v_band, 1, 0), jnp.arange(nb))
    out = lax.map(block, xs)
    out = jnp.moveaxis(out, 0, 1).reshape(B, S, ATTN_WIDTH)
    return out @ w_o + b_o


def peer_ffn(h, w_q, sub_keys, u_tab, v_tab):
    B, S, D = h.shape
    tc = PEER_TOKEN_CHUNK
    tokens = h.reshape(B * S // tc, tc, D)

    def chunk(xc):
        q = (xc @ w_q).reshape(tc, PEER_HEADS, 2, PEER_HALF_DIM)
        s = jnp.einsum('thpd,hpkd->thpk', q, sub_keys).astype(jnp.float32)
        sv, si = lax.top_k(s, PEER_TOPK)
        cand = (sv[:, :, 0, :, None] + sv[:, :, 1, None, :]).reshape(tc, PEER_HEADS, PEER_TOPK * PEER_TOPK)
        cv, ci = lax.top_k(cand, PEER_TOPK)
        e = (jnp.take_along_axis(si[:, :, 0], ci // PEER_TOPK, axis=-1) * PEER_NKEYS
             + jnp.take_along_axis(si[:, :, 1], ci % PEER_TOPK, axis=-1))
        g = jax.nn.softmax(cv, axis=-1)
        act = jax.nn.gelu(jnp.einsum('thed,td->the', u_tab[e], xc).astype(jnp.float32))
        return jnp.einsum('the,thed->td', (g * act).astype(xc.dtype), v_tab[e])

    return lax.map(chunk, tokens).reshape(B, S, D)


def setup_inputs(seed: int = 0) -> dict:
    key = jax.random.key(seed)
    ks = jax.random.split(key, 32)
    D = D_MODEL
    ne = (DEPTH + 1) // 2
    no = DEPTH // 2
    hd = MLSTM_HEAD_DIM
    pgd = POOL_GROUP_DIM

    def nrm(k, shape, s):
        return jax.random.normal(k, shape, jnp.float32) * s

    f_bias = jnp.linspace(3.0, 6.0, MLSTM_HEADS, dtype=jnp.float32)
    ev_b_if = jnp.stack([nrm(ks[6], (ne, MLSTM_HEADS), 0.1),
                         f_bias + nrm(ks[7], (ne, MLSTM_HEADS), 0.1)], axis=1)
    return {
        'x': nrm(ks[0], (BATCH, SEQ, D), 1.0),
        'c': nrm(ks[1], (BATCH, D), 1.0),
        'ada_w': nrm(ks[2], (DEPTH, 2, D, 3 * D), 0.5 * D ** -0.5),
        'ada_b': nrm(ks[3], (DEPTH, 2, 3 * D), 0.01),
        'norm_g': 1.0 + nrm(ks[4], (DEPTH, 2, D), 0.02),
        'ev_w_in': nrm(ks[5], (ne, D, EVEN_IN_WIDTH), D ** -0.5),
        'ev_b_if': ev_b_if,
        'ev_conv_w': nrm(ks[8], (ne, CONV_WIDTH, MLSTM_WIDTH), CONV_WIDTH ** -0.5),
        'ev_conv_b': nrm(ks[9], (ne, MLSTM_WIDTH), 0.01),
        'ev_w_q': nrm(ks[10], (ne, MLSTM_HEADS, hd, hd), hd ** -0.5),
        'ev_w_k': nrm(ks[11], (ne, MLSTM_HEADS, hd, hd), hd ** -0.5),
        'ev_head_g': 1.0 + nrm(ks[12], (ne, MLSTM_WIDTH), 0.02),
        'ev_skip': 1.0 + nrm(ks[13], (ne, MLSTM_WIDTH), 0.02),
        'ev_pool_w': nrm(ks[14], (ne, POOL_GROUPS, pgd, pgd), pgd ** -0.5),
        'ev_pool_scale': 1.0 + nrm(ks[15], (ne, POOL_WIDTH), 0.02),
        'ev_w_out': nrm(ks[16], (ne, EVEN_MIX_WIDTH, D), EVEN_MIX_WIDTH ** -0.5),
        'od_w_qkv': nrm(ks[17], (no, D, QKV_WIDTH), D ** -0.5),
        'od_b_qkv': nrm(ks[18], (no, QKV_WIDTH), 0.01),
        'od_sinks': nrm(ks[19], (no, ATTN_HEADS), 0.5),
        'od_w_o': nrm(ks[20], (no, ATTN_WIDTH, D), ATTN_WIDTH ** -0.5),
        'od_b_o': nrm(ks[21], (no, D), 0.01),
        'rel_bias': nrm(ks[22], (REL_BUCKETS, ATTN_HEADS), 0.5),
        'peer_w_q': nrm(ks[23], (DEPTH, D, PEER_HEADS * PEER_QUERY_DIM), D ** -0.5),
        'peer_keys': nrm(ks[24], (DEPTH, PEER_HEADS, 2, PEER_NKEYS, PEER_HALF_DIM), PEER_HALF_DIM ** -0.5),
        'peer_u': nrm(ks[25], (DEPTH, PEER_EXPERTS, D), D ** -0.5),
        'peer_v': nrm(ks[26], (DEPTH, PEER_EXPERTS, D), 1.0),
        'final_g': 1.0 + nrm(ks[27], (D,), 0.02),
    }


def reference(x, c, ada_w, ada_b, norm_g, ev_w_in, ev_b_if, ev_conv_w, ev_conv_b, ev_w_q, ev_w_k,
              ev_head_g, ev_skip, ev_pool_w, ev_pool_scale, ev_w_out, od_w_qkv, od_b_qkv, od_sinks,
              od_w_o, od_b_o, rel_bias, peer_w_q, peer_keys, peer_u, peer_v, final_g):
    cond = jax.nn.silu(c)
    for layer in range(DEPTH):
        h, gate = ada_norm(x, norm_g[layer, 0], cond, ada_w[layer, 0], ada_b[layer, 0])
        if layer % 2 == 0:
            e = layer // 2
            y = mlstm_pool_mixer(h, ev_w_in[e], ev_b_if[e], ev_conv_w[e], ev_conv_b[e], ev_w_q[e],
                                 ev_w_k[e], ev_head_g[e], ev_skip[e], ev_pool_w[e], ev_pool_scale[e],
                                 ev_w_out[e])
        else:
            o = layer // 2
            y = sliding_window_attention(h, od_w_qkv[o], od_b_qkv[o], od_sinks[o], od_w_o[o],
                                         od_b_o[o], rel_bias)
        x = x + gate * y
        h, gate = ada_norm(x, norm_g[layer, 1], cond, ada_w[layer, 1], ada_b[layer, 1])
        x = x + gate * peer_ffn(h, peer_w_q[layer], peer_keys[layer], peer_u[layer], peer_v[layer])
    return rms_norm(x, final_g)
```

```cpp
#include <hip/hip_runtime.h>
#include <stdint.h>
#include <stdio.h>

#ifndef ONE_LAUNCH
#define ONE_LAUNCH 1
#endif
#ifndef PROBE_MASK
#define PROBE_MASK 0u
#endif

#define DI __device__ __forceinline__
typedef unsigned short bf16_t;
typedef __attribute__((ext_vector_type(8))) short bf16x8;
typedef __attribute__((ext_vector_type(16))) float f32x16;
typedef unsigned u32x4_t __attribute__((ext_vector_type(4)));
typedef float f32x4n_t __attribute__((ext_vector_type(4)));
typedef unsigned u32x2_t __attribute__((ext_vector_type(2)));
#define MFMA32(a, b, c) __builtin_amdgcn_mfma_f32_32x32x16_bf16((a), (b), (c), 0, 0, 0)

#define T_TOK 32768
#define SEQ 2048
#define NBATCH 16
#define DM 1024
#define NEG_INF_F (-1e30f)

#define MiB (1024ull * 1024ull)
#define OFF_BAR     0ull
#define OFF_MODS    (16ull * 1024)
#define OFF_WGT     (1ull * MiB)
#define OFF_IPRE    (OFF_WGT + 64ull * 1024)
#define OFF_LOGF    (OFF_IPRE + 512ull * 1024)
#define OFF_G       (OFF_LOGF + 512ull * 1024)
#define OFF_BV      (OFF_G + 512ull * 1024)
#define OFF_USC     (OFF_BV + 512ull * 1024)
#define OFF_ND      (OFF_USC + 64ull * 1024)
#define OFF_NIN     (OFF_ND + 512ull * 1024)
#define OFF_HS      (27ull * MiB)
#define OFF_PTRS    (27ull * MiB + 512ull * 1024)
#define OFF_AS      (27ull * MiB + 256ull * 1024)
#define OFF_WSC     (27ull * MiB + 768ull * 1024)
#define OFF_SC      (26ull * MiB)
#define OFF_WINT    (4ull * MiB)
#define OFF_WOUTT   (8ull * MiB)
#define OFF_WQKVT   (10ull * MiB)
#define OFF_WOT     (13ull * MiB)
#define OFF_WPQT    (15ull * MiB)
#define OFF_WQT     (23ull * MiB)
#define OFF_WKT     (OFF_WQT + 128ull * 1024)
#define OFF_PWT     (OFF_WKT + 128ull * 1024)
#define OFF_KEYS    (24ull * MiB)
#define OFF_R1      (32ull * MiB)
#define OFF_R2      (160ull * MiB)
#define OFF_R3      (224ull * MiB)
#define OFF_R4      (352ull * MiB)
#define OFF_R5      (416ull * MiB)
#define WS_NEEDED   (512ull * MiB)

struct Params {
    const float *x, *c, *ada_w, *ada_b, *norm_g, *w_in, *b_if, *conv_w, *conv_b, *w_q, *w_k, *head_g, *skip, *pool_w,
        *pool_scale, *w_out, *w_qkv, *b_qkv, *sinks, *w_o, *b_o, *rel_bias, *peer_wq, *peer_keys, *peer_u, *peer_v, *final_g;
    float* out;
    char* ws;
};


#define XB_TMO      128
#define XB_XCNT(j)  (256  + 64 * (j))
#define XB_XSUB(j)  (1280 + 64 * (j))
#define XB_XGEN(j)  (2304 + 64 * (j))
#define XB_TOP      3328
#define XB_TOPGEN   3392
#define XCD_BAR_WORDS 3456
#define XB_SPIN_CAP (1u << 18)
#define LAS __attribute__((address_space(3)))

__device__ __forceinline__ unsigned xb_ld(unsigned* p)              { return __hip_atomic_load(p, __ATOMIC_RELAXED, __HIP_MEMORY_SCOPE_AGENT); }
__device__ __forceinline__ unsigned xb_add(unsigned* p, unsigned v) { return __hip_atomic_fetch_add(p, v, __ATOMIC_RELAXED, __HIP_MEMORY_SCOPE_AGENT); }
__device__ __forceinline__ unsigned xb_xcc_id() { return (unsigned)__builtin_amdgcn_s_getreg((3 << 11) | 20) & 0xFu; }
#define XB_SPIN(cond, bar) do { unsigned _sp = 0; while (cond) { __builtin_amdgcn_s_sleep(1); \
    if ((++_sp & 255u) == 0u) { if (xb_ld(&(bar)[XB_TMO])) break; if (_sp > XB_SPIN_CAP) { atomicAdd(&(bar)[XB_TMO], 1u); break; } } } } while (0)

struct XcdBarrier {
    unsigned* bar; unsigned x;
    volatile LAS unsigned* st;
};

__device__ __forceinline__ XcdBarrier xcd_barrier_post(unsigned* bar, volatile LAS unsigned* st) {
    XcdBarrier b; b.bar = bar; b.x = xb_xcc_id(); b.st = st;
    if (threadIdx.x == 0) (void)xb_add(&bar[XB_XCNT(b.x)], 1u);
    return b;
}
__device__ __forceinline__ void xcd_barrier_complete(unsigned* bar, unsigned x, unsigned& nloc, unsigned& nx) {
    const unsigned G = gridDim.x * gridDim.y * gridDim.z;
    unsigned sum, cnt, mine, sp = 0u;
    for (;;) {
        sum = 0u; cnt = 0u; mine = 0u;
#pragma unroll
        for (unsigned j = 0; j < 16; ++j) { const unsigned c = xb_ld(&bar[XB_XCNT(j)]); sum += c; cnt += (c > 0u) ? 1u : 0u; mine = (j == x) ? c : mine; }
        if (sum == G) break;
        __builtin_amdgcn_s_sleep(1);
        if ((++sp & 255u) == 0u) { if (xb_ld(&bar[XB_TMO])) break; if (sp > XB_SPIN_CAP) { atomicAdd(&bar[XB_TMO], 1u); break; } }
    }
    nloc = mine > 0u ? mine : 1u; nx = cnt > 0u ? cnt : 1u;
}
__device__ __forceinline__ void xcd_barrier(const XcdBarrier& b) {
    asm volatile("s_waitcnt vmcnt(0)" ::: "memory");
    __syncthreads();
    if (threadIdx.x == 0) {
        unsigned* bar = b.bar;
        __builtin_amdgcn_s_waitcnt(0);
        unsigned nloc = b.st[0], nx = b.st[1];
        if (nloc == 0u) { xcd_barrier_complete(bar, b.x, nloc, nx); b.st[0] = nloc; b.st[1] = nx; }
        const unsigned old = xb_add(&bar[XB_XSUB(b.x)], 1u);
        const unsigned gen = old / nloc;
        if (old + 1u == (gen + 1u) * nloc) {
            __builtin_amdgcn_fence(__ATOMIC_RELEASE, "agent");
            asm volatile("s_waitcnt vmcnt(0)" ::: "memory");
            const unsigned og = xb_add(&bar[XB_TOP], 1u);
            const unsigned tg = og / nx;
            if (og + 1u == (tg + 1u) * nx) xb_add(&bar[XB_TOPGEN], 1u);
            else XB_SPIN(xb_ld(&bar[XB_TOPGEN]) == tg, bar);
            __builtin_amdgcn_fence(__ATOMIC_ACQUIRE, "agent");
            xb_add(&bar[XB_XGEN(b.x)], 1u);
            asm volatile("s_waitcnt vmcnt(0)" ::: "memory");
        } else {
            XB_SPIN(xb_ld(&bar[XB_XGEN(b.x)]) == gen, bar);
            __builtin_amdgcn_fence(__ATOMIC_ACQUIRE, "agent");
            asm volatile("s_waitcnt vmcnt(0)" ::: "memory");
        }
    }
    __syncthreads();
}

DI bf16_t f2bf(float x) {
    unsigned u = __float_as_uint(x);
    u += 0x7fffu + ((u >> 16) & 1u);
    return (bf16_t)(u >> 16);
}
DI float bf2f(bf16_t h) { return __uint_as_float(((unsigned)h) << 16); }
DI unsigned pack2bf(float a, float b) { return (unsigned)f2bf(a) | ((unsigned)f2bf(b) << 16); }
DI int get_tid() { int t = (int)threadIdx.x; asm volatile("" : "+v"(t)); return t; }
DI int crow(int i, int h) { return (i & 3) + 8 * (i >> 2) + 4 * h; }
DI float wave_sum(float v) {
#pragma unroll
    for (int o = 32; o >= 1; o >>= 1) v += __shfl_xor(v, o);
    return v;
}
DI float wave_sum_dpp(float v) {
    v += __int_as_float(__builtin_amdgcn_mov_dpp(__float_as_int(v), 0xB1, 0xF, 0xF, true));
    v += __int_as_float(__builtin_amdgcn_mov_dpp(__float_as_int(v), 0x4E, 0xF, 0xF, true));
    v += __int_as_float(__builtin_amdgcn_mov_dpp(__float_as_int(v), 0x141, 0xF, 0xF, true));
    v += __int_as_float(__builtin_amdgcn_mov_dpp(__float_as_int(v), 0x140, 0xF, 0xF, true));
    return __int_as_float(__builtin_amdgcn_readlane(__float_as_int(v), 0)) + __int_as_float(__builtin_amdgcn_readlane(__float_as_int(v), 16)) +
           __int_as_float(__builtin_amdgcn_readlane(__float_as_int(v), 32)) + __int_as_float(__builtin_amdgcn_readlane(__float_as_int(v), 48));
}
DI float half_sum(float v) {
#pragma unroll
    for (int o = 16; o >= 1; o >>= 1) v += __shfl_xor(v, o);
    return v;
}
DI float half_max(float v) {
#pragma unroll
    for (int o = 16; o >= 1; o >>= 1) v = fmaxf(v, __shfl_xor(v, o));
    return v;
}
DI unsigned half_umax(unsigned v) {
#pragma unroll
    for (int o = 16; o >= 1; o >>= 1) { unsigned t = (unsigned)__shfl_xor((int)v, o); v = v > t ? v : t; }
    return v;
}
DI float sigmoidf_(float x) { return 1.f / (1.f + __expf(-x)); }
DI float siluf_(float x) { return x * sigmoidf_(x); }
DI float gelu_tanh(float x) {
    const float k0 = 0.7978845608028654f, k1 = 0.044715f;
    float u = k0 * (x + k1 * x * x * x);
    float t = 1.f - 2.f / (1.f + __expf(2.f * u));
    return 0.5f * x * (1.f + t);
}
DI float logsigmoidf_(float x) { return fminf(x, 0.f) - log1pf(__expf(-fabsf(x))); }

template <int N> DI void zero_acc(f32x16 (&acc)[N]) {
#pragma unroll
    for (int n = 0; n < N; ++n)
#pragma unroll
        for (int i = 0; i < 16; ++i) acc[n][i] = 0.f;
}

template <int NT, int KSTEPS, typename PA, typename PB>
DI void wave_mma(f32x16 (&acc)[NT], PA A, int lda, PB B, int ldb, int lane) {
    const int r = lane & 31, h = lane >> 5;
    bf16x8 a0, b0[NT], a1, b1[NT];
    a0 = *(const bf16x8*)(A + (size_t)r * lda + h * 8);
#pragma unroll
    for (int nt = 0; nt < NT; ++nt) b0[nt] = *(const bf16x8*)(B + (size_t)(nt * 32 + r) * ldb + h * 8);
#pragma unroll
    for (int ks = 0; ks < KSTEPS; ks += 2) {
        if (ks + 1 < KSTEPS) {
            a1 = *(const bf16x8*)(A + (size_t)r * lda + (ks + 1) * 16 + h * 8);
#pragma unroll
            for (int nt = 0; nt < NT; ++nt) b1[nt] = *(const bf16x8*)(B + (size_t)(nt * 32 + r) * ldb + (ks + 1) * 16 + h * 8);
        }
        asm volatile("" ::: "memory");
#pragma unroll
        for (int nt = 0; nt < NT; ++nt) acc[nt] = MFMA32(a0, b0[nt], acc[nt]);
        if (ks + 1 < KSTEPS) {
            if (ks + 2 < KSTEPS) {
                a0 = *(const bf16x8*)(A + (size_t)r * lda + (ks + 2) * 16 + h * 8);
#pragma unroll
                for (int nt = 0; nt < NT; ++nt) b0[nt] = *(const bf16x8*)(B + (size_t)(nt * 32 + r) * ldb + (ks + 2) * 16 + h * 8);
            }
            asm volatile("" ::: "memory");
#pragma unroll
            for (int nt = 0; nt < NT; ++nt) acc[nt] = MFMA32(a1, b1[nt], acc[nt]);
        }
    }
}

DI void phase_pre_mods(const Params& p, char* ws, char* smem) {
    float* cond = (float*)smem;
    float* mods = (float*)(ws + OFF_MODS);
    const int tid = get_tid();
    for (int unit = blockIdx.x; unit < 384; unit += gridDim.x) {
        const int lj = unit / 96, n0 = (unit % 96) * 32;
        __syncthreads();
        for (int i = tid; i < 16 * 1024; i += 256) cond[i] = siluf_(p.c[i]);
        __syncthreads();
        const int ksl = tid >> 5, col = tid & 31;
        const float* W = p.ada_w + (size_t)lj * 1024 * 3072 + n0 + col;
        float acc[16];
#pragma unroll
        for (int b = 0; b < 16; ++b) acc[b] = 0.f;
        for (int kk0 = 0; kk0 < 128; kk0 += 16) {
            float wv_[16];
#pragma unroll
            for (int q = 0; q < 16; ++q) wv_[q] = W[(size_t)(ksl * 128 + kk0 + q) * 3072];
#pragma unroll
            for (int q = 0; q < 16; ++q) {
                const int k = ksl * 128 + kk0 + q;
#pragma unroll
                for (int b = 0; b < 16; ++b) acc[b] += cond[b * 1024 + k] * wv_[q];
            }
        }
        __syncthreads();
        float* red = (float*)smem;
#pragma unroll
        for (int b = 0; b < 16; ++b) red[(ksl * 16 + b) * 32 + col] = acc[b];
        __syncthreads();
        for (int o = tid; o < 512; o += 256) {
            const int b = o >> 5, cc = o & 31;
            float s = 0.f;
#pragma unroll
            for (int q = 0; q < 8; ++q) s += red[(q * 16 + b) * 32 + cc];
            mods[((size_t)lj * 16 + b) * 3072 + n0 + cc] = s + p.ada_b[(size_t)lj * 3072 + n0 + cc];
        }
    }
    __syncthreads();
}

DI void transpose_job(const float* __restrict__ src, int ldsrc, int K, int N, bf16_t* __restrict__ dst, const float* nscale, float cscale,
                      int tile, float* tl) {
    const int tiles_n = N / 32;
    const int tk = tile / tiles_n, tn = tile % tiles_n;
    const int tid_ = get_tid();
    const int tx = tid_ & 31, ty = tid_ >> 5;
    __syncthreads();
#pragma unroll
    for (int q = 0; q < 4; ++q) {
        const int k = tk * 32 + ty + q * 8;
        tl[(ty + q * 8) * 33 + tx] = src[(size_t)k * ldsrc + tn * 32 + tx];
    }
    __syncthreads();
#pragma unroll
    for (int q = 0; q < 4; ++q) {
        const int n = tn * 32 + ty + q * 8;
        float v = tl[tx * 33 + ty + q * 8] * cscale;
        if (nscale) v *= nscale[n];
        dst[(size_t)n * K + tk * 32 + tx] = f2bf(v);
    }
}

DI void quant_job(const float* __restrict__ src, int ldsrc, unsigned char* __restrict__ dst, float* __restrict__ wsc, int n0, float* red) {
    const int tid = get_tid(), tx = tid & 31, ty = tid >> 5;
    const float* col = src + n0 + tx;
    float am = 0.f;
    for (int k = ty; k < 1024; k += 8) am = fmaxf(am, fabsf(col[(size_t)k * ldsrc]));
    __syncthreads();
    red[ty * 32 + tx] = am;
    __syncthreads();
#pragma unroll
    for (int q = 0; q < 8; ++q) am = fmaxf(am, red[q * 32 + tx]);
    const float sc = (am > 0.f) ? 127.f / am : 0.f;
    if (ty == 0) wsc[n0 + tx] = am * (1.f / 127.f);
    unsigned char* drow = dst + (size_t)(n0 + tx) * 1024 + ty * 128;
    for (int k4 = 0; k4 < 32; k4 += 4) {
        unsigned w[4];
#pragma unroll
        for (int q = 0; q < 4; ++q) {
            const int k = ty * 128 + (k4 + q) * 4;
            const int q0 = __float2int_rn(col[(size_t)(k + 0) * ldsrc] * sc), q1 = __float2int_rn(col[(size_t)(k + 1) * ldsrc] * sc);
            const int q2 = __float2int_rn(col[(size_t)(k + 2) * ldsrc] * sc), q3 = __float2int_rn(col[(size_t)(k + 3) * ldsrc] * sc);
            w[q] = ((unsigned)q0 & 0xffu) | (((unsigned)q1 & 0xffu) << 8) | (((unsigned)q2 & 0xffu) << 16) | (((unsigned)q3 & 0xffu) << 24);
        }
        *(uint4*)(drow + k4 * 4) = make_uint4(w[0], w[1], w[2], w[3]);
    }
}
DI void phase_pre_weights(const Params& p, char* ws, char* smem) {
    {
        float* red = (float*)smem;
        float* wsc = (float*)(ws + OFF_WSC);
        for (int j = blockIdx.x; j < 64 + 40 + 64 + 64; j += gridDim.x) {
            if (j < 64) quant_job(p.w_in, 2056, (unsigned char*)(ws + OFF_WINT), wsc, j * 32, red);
            else if (j < 104) quant_job(p.w_qkv, 1280, (unsigned char*)(ws + OFF_WQKVT), wsc + 2048, (j - 64) * 32, red);
            else if (j < 168) quant_job(p.peer_wq, 2048, (unsigned char*)(ws + OFF_WPQT), wsc + 3328, (j - 104) * 32, red);
            else quant_job(p.peer_wq + (size_t)1024 * 2048, 2048, (unsigned char*)(ws + OFF_WPQT) + (size_t)2048 * 1024, wsc + 5376, (j - 168) * 32, red);
        }
        __syncthreads();
    }
    float* tl = (float*)smem;
    const int J1 = 32 * 32;
    const int J3 = 32 * 32;
    const int J6 = 4 * 16;
    const int J7 = 4 * 16;
    const int J8 = 4 * 16;
    const int total = J1 + J3 + J6 + J7 + J8;
    for (int j = blockIdx.x; j < total; j += gridDim.x) {
        int t = j;
        if (t < J1) { transpose_job(p.w_out, 1024, 1024, 1024, (bf16_t*)(ws + OFF_WOUTT), nullptr, 1.f, t, tl); continue; }
        t -= J1;
        if (t < J3) { transpose_job(p.w_o, 1024, 1024, 1024, (bf16_t*)(ws + OFF_WOT), nullptr, 1.f, t, tl); continue; }
        t -= J3;
        if (t < J6) { const int hh = t / 16; transpose_job(p.w_q + (size_t)hh * 16384, 128, 128, 128, (bf16_t*)(ws + OFF_WQT) + (size_t)hh * 16384, nullptr, 1.f, t % 16, tl); continue; }
        t -= J6;
        if (t < J7) { const int hh = t / 16; transpose_job(p.w_k + (size_t)hh * 16384, 128, 128, 128, (bf16_t*)(ws + OFF_WKT) + (size_t)hh * 16384, nullptr, 0.08838834764831845f, t % 16, tl); continue; }
        t -= J7;
        { const int g = t / 16; transpose_job(p.pool_w + (size_t)g * 16384, 128, 128, 128, (bf16_t*)(ws + OFF_PWT) + (size_t)g * 16384, p.pool_scale + g * 128, 1.f, t % 16, tl); }
    }
    const size_t gtid = (size_t)blockIdx.x * 256 + get_tid(), gsz = (size_t)gridDim.x * 256;
    bf16_t* keys = (bf16_t*)(ws + OFF_KEYS);
    for (size_t i = gtid; i < (size_t)2 * 8 * 2 * 128 * 128; i += gsz) keys[i] = f2bf(p.peer_keys[i]);
    __syncthreads();
}

template <bool GATES, bool WITH_H8, bool XBF>
DI void phase_adanorm(const Params& p, char* ws, const void* __restrict__ Xv, int lj, char* smem) {
    unsigned char* H8 = (unsigned char*)(ws + OFF_R5 + 16ull * MiB);
    const float* mods = (const float*)(ws + OFF_MODS) + (size_t)lj * 16 * 3072;
    const float* ng = p.norm_g + (size_t)lj * 1024;
    const int tid = get_tid(), lane = tid & 63, wave = tid >> 6;
    float* wg = (float*)smem;
    if (GATES) {
        __syncthreads();
        for (int i = tid; i < 8 * 1024; i += 256) { const int k = i >> 3, jn = i & 7; wg[jn * 1024 + k] = p.w_in[(size_t)k * 2056 + 2048 + jn]; }
        __syncthreads();
    }
    for (int unit = blockIdx.x; unit < T_TOK / 64; unit += gridDim.x) {
        const int row0 = unit * 64, b = row0 >> 11;
        float am[16], sh[16];
#pragma unroll
        for (int i = 0; i < 4; ++i) {
            const int col = i * 256 + lane * 4;
            const float4 g4 = *(const float4*)(ng + col);
            const float4 s4 = *(const float4*)(mods + (size_t)b * 3072 + col);
            const float4 c4 = *(const float4*)(mods + (size_t)b * 3072 + 1024 + col);
            am[i * 4 + 0] = g4.x * (1.f + c4.x); am[i * 4 + 1] = g4.y * (1.f + c4.y);
            am[i * 4 + 2] = g4.z * (1.f + c4.z); am[i * 4 + 3] = g4.w * (1.f + c4.w);
            sh[i * 4 + 0] = s4.x; sh[i * 4 + 1] = s4.y; sh[i * 4 + 2] = s4.z; sh[i * 4 + 3] = s4.w;
        }
        for (int rr = wave; rr < 64; rr += 4) {
            const int t = row0 + rr;
            float xv[16];
            float ss = 0.f;
#pragma unroll
            for (int i = 0; i < 4; ++i) {
                float4 v;
                if (XBF) {
                    const uint2 q = *(const uint2*)((const bf16_t*)Xv + (size_t)t * 1024 + i * 256 + lane * 4);
                    v = make_float4(__uint_as_float(q.x << 16), __uint_as_float(q.x & 0xffff0000u), __uint_as_float(q.y << 16), __uint_as_float(q.y & 0xffff0000u));
                } else v = *(const float4*)((const float*)Xv + (size_t)t * 1024 + i * 256 + lane * 4);
                xv[i * 4 + 0] = v.x; xv[i * 4 + 1] = v.y; xv[i * 4 + 2] = v.z; xv[i * 4 + 3] = v.w;
                ss += v.x * v.x + v.y * v.y + v.z * v.z + v.w * v.w;
            }
            ss = wave_sum(ss);
            const float rinv = rsqrtf(ss * (1.f / 1024.f) + 1e-6f);
            float hv[16];
#pragma unroll
            for (int i = 0; i < 16; ++i) hv[i] = xv[i] * rinv * am[i] + sh[i];
            if (WITH_H8) {
                float amx = 0.f;
#pragma unroll
                for (int i = 0; i < 16; ++i) amx = fmaxf(amx, fabsf(hv[i]));
#pragma unroll
                for (int o = 32; o >= 1; o >>= 1) amx = fmaxf(amx, __shfl_xor(amx, o));
                const float qs = (amx > 0.f) ? 127.f / amx : 0.f;
#pragma unroll
                for (int i = 0; i < 4; ++i) {
                    const int q0 = __float2int_rn(hv[i * 4 + 0] * qs), q1 = __float2int_rn(hv[i * 4 + 1] * qs);
                    const int q2 = __float2int_rn(hv[i * 4 + 2] * qs), q3 = __float2int_rn(hv[i * 4 + 3] * qs);
                    const unsigned w8 = ((unsigned)q0 & 0xffu) | (((unsigned)q1 & 0xffu) << 8) | (((unsigned)q2 & 0xffu) << 16) | (((unsigned)q3 & 0xffu) << 24);
                    *(unsigned*)(H8 + (size_t)t * 1024 + i * 256 + lane * 4) = w8;
                }
                if (lane == 0) ((float*)(ws + OFF_HS))[t] = amx * (1.f / 127.f);
            }
            if (GATES) {
                float vi = 0.f, vf = 0.f;
#pragma unroll 1
                for (int j = 0; j < 8; ++j) {
                    float s = 0.f;
#pragma unroll
                    for (int i = 0; i < 4; ++i) {
                        const float4 w4 = *(const float4*)(wg + j * 1024 + i * 256 + lane * 4);
                        s += hv[i * 4 + 0] * w4.x + hv[i * 4 + 1] * w4.y + hv[i * 4 + 2] * w4.z + hv[i * 4 + 3] * w4.w;
                    }
                    s = wave_sum(s);
                    if (lane == (j & 3)) { if (j < 4) vi = s; else vf = s; }
                }
                if (lane < 4) {
                    float* ipre = (float*)(ws + OFF_IPRE);
                    float* logf_ = (float*)(ws + OFF_LOGF);
                    ipre[(size_t)t * 4 + lane] = vi + p.b_if[lane];
                    logf_[(size_t)t * 4 + lane] = logsigmoidf_(vf + p.b_if[4 + lane]);
                }
            }
        }
    }
}

#define GM_INPROJ 0
#define GM_RESID  1
#define GM_RESID_BF 4
#define GM_PLAIN  2
#define GM_QKV    3
#define LDS_ROW 72

struct GemmArgs {
    const bf16_t* A; const bf16_t* Bt; int N;
    const float* hs; const float* wsc;
    const void* xin; bf16_t* xout; const float* gate; const float* bias;
    bf16_t* out;
};

#define CT_LD 132
typedef __attribute__((address_space(1))) char gch_t;
#define LAUNDER(ptr) do { gch_t* _g = (gch_t*)(ptr); asm volatile("" : "+v"(_g)); (ptr) = (decltype(ptr))(char*)_g; } while (0)
template <int MODE>
DI void gemm_epilogue(const Params& p, char* ws, const GemmArgs& ga, const f32x16 (&acc)[2][2], int m0, int n0, int tn, int wm, int wn, int tid, bool swapped, float* Ct, const f32x4n_t (&xi)[16]) {
    const int lane = tid & 63, r = lane & 31, h = lane >> 5;
    {
#pragma unroll
        for (int mt = 0; mt < 2; ++mt)
#pragma unroll
            for (int nt = 0; nt < 2; ++nt) {
                float* dst = Ct + (wm * 64 + mt * 32 + 4 * h) * CT_LD + wn * 64 + nt * 32 + r;
#pragma unroll
                for (int i = 0; i < 16; ++i) dst[((i & 3) + 8 * (i >> 2)) * CT_LD] = acc[mt][nt][i];
            }
    }
    __syncthreads();
    if (MODE == GM_RESID || MODE == GM_RESID_BF) {
        const int c4 = tid & 31, rr = tid >> 5;
        const int n = n0 + c4 * 4, b = m0 >> 11;
        const float4 g4 = *(const float4*)(ga.gate + (size_t)b * 3072 + n);
        float4 b4 = make_float4(0.f, 0.f, 0.f, 0.f);
        if (ga.bias) b4 = *(const float4*)(ga.bias + n);
        bf16_t* op = ga.xout + (size_t)(m0 + rr) * 1024 + n;
#pragma unroll
        for (int it = 0; it < 16; ++it) {
            const float4 c = *(const float4*)(Ct + (rr + 8 * it) * CT_LD + c4 * 4);
            float4 xq;
            if (MODE == GM_RESID_BF) {
                const unsigned q0 = __float_as_uint(xi[it].x), q1 = __float_as_uint(xi[it].y);
                xq = make_float4(__uint_as_float(q0 << 16), __uint_as_float(q0 & 0xffff0000u), __uint_as_float(q1 << 16), __uint_as_float(q1 & 0xffff0000u));
            } else xq = make_float4(xi[it].x, xi[it].y, xi[it].z, xi[it].w);
            float4 o;
            o.x = xq.x + g4.x * (c.x + b4.x); o.y = xq.y + g4.y * (c.y + b4.y);
            o.z = xq.z + g4.z * (c.z + b4.z); o.w = xq.w + g4.w * (c.w + b4.w);
            { u32x2_t ov_; ov_.x = pack2bf(o.x, o.y); ov_.y = pack2bf(o.z, o.w); __builtin_nontemporal_store(ov_, (u32x2_t*)(op + (size_t)it * 8 * 1024)); }
        }
    } else {
        const int c8 = tid & 15, rr = tid >> 4;
        bf16_t* dst; size_t rstride; const float* colbias = nullptr; const float* rowbias = nullptr;
        bf16_t* R3 = (bf16_t*)(ws + OFF_R3);
        const int b = m0 >> 11, s0 = m0 & 2047;
        if (MODE == GM_PLAIN) { dst = ga.out + (size_t)m0 * ga.N + n0; rstride = (size_t)ga.N; }
        else if (MODE == GM_INPROJ) {
            if (!swapped) { dst = R3 + (size_t)(tn >> 2) * T_TOK * 512 + (size_t)m0 * 512 + (n0 & 511); rstride = 512; }
            else { dst = R3 + (size_t)T_TOK * 512 + ((size_t)b * 512 + (n0 - 512)) * 2048 + s0; rstride = 2048; }
        } else {
            if (tn < 8) { dst = R3 + (size_t)m0 * 1024 + n0; rstride = 1024; colbias = p.b_qkv + n0; }
            else if (tn == 8) { dst = R3 + (size_t)T_TOK * 1024 + (size_t)m0 * 128; rstride = 128; colbias = p.b_qkv + n0; }
            else { dst = R3 + (size_t)T_TOK * 1024 + (size_t)T_TOK * 128 + (size_t)b * 128 * 2048 + s0; rstride = 2048; rowbias = p.b_qkv + 1152; }
        }
        const float* rowscale = nullptr; const float* colscale = nullptr;
        if (ga.hs) { rowscale = swapped ? ga.wsc + n0 : ga.hs + m0; colscale = swapped ? ga.hs + m0 : ga.wsc + n0; }
        float csv[8];
#pragma unroll
        for (int e = 0; e < 8; ++e) csv[e] = 1.f;
        if (colscale) {
            const float4 a = *(const float4*)(colscale + c8 * 8), bq = *(const float4*)(colscale + c8 * 8 + 4);
            csv[0] = a.x; csv[1] = a.y; csv[2] = a.z; csv[3] = a.w; csv[4] = bq.x; csv[5] = bq.y; csv[6] = bq.z; csv[7] = bq.w;
        }
        float cbv[8];
#pragma unroll
        for (int e = 0; e < 8; ++e) cbv[e] = 0.f;
        if (colbias) {
            const float4 a = *(const float4*)(colbias + c8 * 8), bq = *(const float4*)(colbias + c8 * 8 + 4);
            cbv[0] = a.x; cbv[1] = a.y; cbv[2] = a.z; cbv[3] = a.w; cbv[4] = bq.x; cbv[5] = bq.y; cbv[6] = bq.z; cbv[7] = bq.w;
        }
        bf16_t* dp = dst + (size_t)rr * rstride + c8 * 8;
#pragma unroll
        for (int it = 0; it < 8; ++it) {
            const int row = rr + 16 * it;
            const float4 c0 = *(const float4*)(Ct + row * CT_LD + c8 * 8);
            const float4 c1 = *(const float4*)(Ct + row * CT_LD + c8 * 8 + 4);
            float rbv = 0.f, rsv = 1.f;
            if (rowbias) rbv = rowbias[row];
            if (rowscale) rsv = rowscale[row];
            uint4 o;
            o.x = pack2bf(c0.x * rsv * csv[0] + cbv[0] + rbv, c0.y * rsv * csv[1] + cbv[1] + rbv);
            o.y = pack2bf(c0.z * rsv * csv[2] + cbv[2] + rbv, c0.w * rsv * csv[3] + cbv[3] + rbv);
            o.z = pack2bf(c1.x * rsv * csv[4] + cbv[4] + rbv, c1.y * rsv * csv[5] + cbv[5] + rbv);
            o.w = pack2bf(c1.z * rsv * csv[6] + cbv[6] + rbv, c1.w * rsv * csv[7] + cbv[7] + rbv);
            { u32x4_t ov_; ov_.x = o.x; ov_.y = o.y; ov_.z = o.z; ov_.w = o.w; __builtin_nontemporal_store(ov_, (u32x4_t*)(dp + (size_t)it * 16 * rstride)); }
        }
    }
    __syncthreads();
}

#define GT_BYTES 16384
typedef int i32x4_t __attribute__((ext_vector_type(4)));
typedef int i32x16_t __attribute__((ext_vector_type(16)));
template <int MODE, bool I8>
DI void phase_gemm(const Params& p, char* ws, const GemmArgs& ga, char* smem) {
    const int tid = get_tid(), lane = tid & 63, wave = tid >> 6;
    const int wm = wave >> 1, wn = wave & 1;
    const int r = lane & 31, h = lane >> 5;
    const int NT = ga.N / 128;
    const int total = 256 * NT;
    constexpr int RS = I8 ? 1024 : 2048;
    constexpr int NK = I8 ? 8 : 16;
    const int srow = wave * 8 + (lane >> 3);
    const int scg = (lane & 7) ^ ((((wave & 1) << 2) + (lane >> 4)) & 7);
    const size_t soff = (size_t)srow * RS + scg * 16;
    const int fsw = (r >> 1) & 7;
    int fo[4];
#pragma unroll
    for (int ks = 0; ks < 4; ++ks) fo[ks] = ((ks * 2 + h) ^ fsw) * 16;
    for (int ti = blockIdx.x; ti < total; ti += gridDim.x) {
        const int label = ti & 7, j = ti >> 3;
        const int tm = label * 32 + j / NT, tn = j % NT;
        const int m0 = tm * 128, n0 = tn * 128;
        bool swapped = false;
        if (MODE == GM_INPROJ) swapped = (tn >= 4 && tn < 8);
        if (MODE == GM_QKV) swapped = (tn == 9);
        const char* Ag = (const char*)ga.A + (size_t)m0 * RS + soff;
        const char* Bg = (const char*)ga.Bt + (size_t)n0 * RS + soff;
        f32x16 acc[2][2];
        i32x16_t acci[2][2];
#pragma unroll
        for (int a = 0; a < 2; ++a) {
            zero_acc<2>(acc[a]);
#pragma unroll
            for (int b2 = 0; b2 < 2; ++b2)
#pragma unroll
                for (int i = 0; i < 16; ++i) acci[a][b2][i] = 0;
        }
#define GEMM_STAGE(BUF, KT)                                                                                           \
        _Pragma("unroll") for (int i = 0; i < 4; ++i) {                                                                \
            __builtin_amdgcn_global_load_lds((const unsigned*)(Ag + (size_t)i * 32 * RS + (KT) * 128),                \
                                             (unsigned*)(smem + (BUF) * 2 * GT_BYTES + (i * 4 + wave) * 1024), 16, 0, 0); \
            __builtin_amdgcn_global_load_lds((const unsigned*)(Bg + (size_t)i * 32 * RS + (KT) * 128),                \
                                             (unsigned*)(smem + (BUF) * 2 * GT_BYTES + GT_BYTES + (i * 4 + wave) * 1024), 16, 0, 0); \
        }
        f32x4n_t xi[16];
        if (MODE == GM_RESID) {
            const float* xp = (const float*)ga.xin + (size_t)(m0 + (tid >> 5)) * 1024 + n0 + (tid & 31) * 4;
#pragma unroll
            for (int it = 0; it < 16; ++it) xi[it] = __builtin_nontemporal_load((const f32x4n_t*)(xp + (size_t)it * 8 * 1024));
        }
        if (MODE == GM_RESID_BF) {
            const bf16_t* xp = (const bf16_t*)ga.xin + (size_t)(m0 + (tid >> 5)) * 1024 + n0 + (tid & 31) * 4;
#pragma unroll
            for (int it = 0; it < 16; ++it) {
                const u32x2_t q = __builtin_nontemporal_load((const u32x2_t*)(xp + (size_t)it * 8 * 1024));
                xi[it].x = __uint_as_float(q.x); xi[it].y = __uint_as_float(q.y);
            }
        }
        GEMM_STAGE(0, 0)
        asm volatile("s_waitcnt vmcnt(0)" ::: "memory");
        __syncthreads();
        for (int kt = 0; kt < NK; ++kt) {
            const int cur = kt & 1;
            if (kt < NK - 1) { GEMM_STAGE(cur ^ 1, kt + 1) }
            const char* At = smem + cur * 2 * GT_BYTES + (swapped ? GT_BYTES : 0) + (wm * 64 + r) * 128;
            const char* Bt2 = smem + cur * 2 * GT_BYTES + (swapped ? 0 : GT_BYTES) + (wn * 64 + r) * 128;
#pragma unroll
            for (int ks = 0; ks < 4; ++ks) {
                if (I8) {
                    i32x4_t af[2], bfr[2];
                    af[0] = *(const i32x4_t*)(At + fo[ks]);
                    af[1] = *(const i32x4_t*)(At + 32 * 128 + fo[ks]);
                    bfr[0] = *(const i32x4_t*)(Bt2 + fo[ks]);
                    bfr[1] = *(const i32x4_t*)(Bt2 + 32 * 128 + fo[ks]);
#pragma unroll
                    for (int mt = 0; mt < 2; ++mt)
#pragma unroll
                        for (int nt = 0; nt < 2; ++nt) acci[mt][nt] = __builtin_amdgcn_mfma_i32_32x32x32_i8(af[mt], bfr[nt], acci[mt][nt], 0, 0, 0);
                } else {
                    bf16x8 af[2], bfr[2];
                    af[0] = *(const bf16x8*)(At + fo[ks]);
                    af[1] = *(const bf16x8*)(At + 32 * 128 + fo[ks]);
                    bfr[0] = *(const bf16x8*)(Bt2 + fo[ks]);
                    bfr[1] = *(const bf16x8*)(Bt2 + 32 * 128 + fo[ks]);
#pragma unroll
                    for (int mt = 0; mt < 2; ++mt)
#pragma unroll
                        for (int nt = 0; nt < 2; ++nt) acc[mt][nt] = MFMA32(af[mt], bfr[nt], acc[mt][nt]);
                }
            }
            asm volatile("s_waitcnt vmcnt(0) lgkmcnt(0)" ::: "memory");
            __syncthreads();
        }
        if (I8) {
#pragma unroll
            for (int mt = 0; mt < 2; ++mt)
#pragma unroll
                for (int nt = 0; nt < 2; ++nt)
#pragma unroll
                    for (int i = 0; i < 16; ++i) acc[mt][nt][i] = (float)acci[mt][nt][i];
        }
        gemm_epilogue<MODE>(p, ws, ga, acc, m0, n0, tn, wm, wn, tid, swapped, (float*)smem, xi);
    }
}

#define KW_LD 136
DI void phase_m1b(const Params& p, char* ws, char* smem) {
    const bf16_t* VT = (const bf16_t*)(ws + OFF_R3) + (size_t)T_TOK * 512;
    bf16_t* Qm = (bf16_t*)(ws + OFF_R1);
    bf16_t* Km = (bf16_t*)(ws + OFF_R1 + 32ull * MiB);
    float* DT = (float*)(ws + OFF_R5);
    const bf16_t* WqT = (const bf16_t*)(ws + OFF_WQT);
    const bf16_t* WkT = (const bf16_t*)(ws + OFF_WKT);
    const float* ipre = (const float*)(ws + OFF_IPRE);
    const float* logf_ = (const float*)(ws + OFF_LOGF);
    float* Gc = (float*)(ws + OFF_G);
    float* Bv = (float*)(ws + OFF_BV);
    float* usc = (float*)(ws + OFF_USC);
    float* ND = (float*)(ws + OFF_ND);
    bf16_t* KwT = (bf16_t*)smem;
    float* wv = (float*)(smem + 128 * KW_LD * 2);
    bf16_t* CMs = (bf16_t*)(smem + 128 * KW_LD * 2 + 512);
    bf16_t* CMg = (bf16_t*)(ws + OFF_R5 + 64ull * MiB);
    const bf16_t* UM = (const bf16_t*)(ws + OFF_R3);
    const int tid = get_tid(), lane = tid & 63, wave = tid >> 6;
    const int r = lane & 31, h = lane >> 5;
    const int cvc = tid & 15, csub = tid >> 4;
    for (int unit = blockIdx.x; unit < 1024; unit += gridDim.x) {
        const int c = unit & 15, hd = (unit >> 4) & 3, b = unit >> 6;
        const size_t t0 = (size_t)b * SEQ + c * 128;
        __syncthreads();
        {
            const int ch0 = hd * 128 + cvc * 8;
            float cw[4][8], cb[8];
#pragma unroll
            for (int jx = 0; jx < 4; ++jx) {
                const float4 a0 = *(const float4*)(p.conv_w + jx * 512 + ch0), a1 = *(const float4*)(p.conv_w + jx * 512 + ch0 + 4);
                cw[jx][0] = a0.x; cw[jx][1] = a0.y; cw[jx][2] = a0.z; cw[jx][3] = a0.w; cw[jx][4] = a1.x; cw[jx][5] = a1.y; cw[jx][6] = a1.z; cw[jx][7] = a1.w;
            }
            {
                const float4 a0 = *(const float4*)(p.conv_b + ch0), a1 = *(const float4*)(p.conv_b + ch0 + 4);
                cb[0] = a0.x; cb[1] = a0.y; cb[2] = a0.z; cb[3] = a0.w; cb[4] = a1.x; cb[5] = a1.y; cb[6] = a1.z; cb[7] = a1.w;
            }
            u32x4_t raw[11];
#pragma unroll
            for (int q = 0; q < 11; ++q) {
                const int sq = c * 128 + csub * 8 + q - 3;
                raw[q] = (u32x4_t){0u, 0u, 0u, 0u};
                if (sq >= 0) raw[q] = *(const u32x4_t*)(UM + ((size_t)b * SEQ + sq) * 512 + ch0);
            }
            float hist[3][8];
#pragma unroll
            for (int q = 0; q < 3; ++q) {
                const unsigned w[4] = {raw[q].x, raw[q].y, raw[q].z, raw[q].w};
#pragma unroll
                for (int e = 0; e < 4; ++e) { hist[q][2 * e] = __uint_as_float(w[e] << 16); hist[q][2 * e + 1] = __uint_as_float(w[e] & 0xffff0000u); }
            }
#pragma unroll
            for (int q = 0; q < 8; ++q) {
                const unsigned w[4] = {raw[q + 3].x, raw[q + 3].y, raw[q + 3].z, raw[q + 3].w};
                float cur[8], o[8];
#pragma unroll
                for (int e = 0; e < 4; ++e) { cur[2 * e] = __uint_as_float(w[e] << 16); cur[2 * e + 1] = __uint_as_float(w[e] & 0xffff0000u); }
#pragma unroll
                for (int e = 0; e < 8; ++e) {
                    const float a = cw[0][e] * hist[0][e] + cw[1][e] * hist[1][e] + cw[2][e] * hist[2][e] + cw[3][e] * cur[e] + cb[e];
                    o[e] = siluf_(a);
                    hist[0][e] = hist[1][e]; hist[1][e] = hist[2][e]; hist[2][e] = cur[e];
                }
                u32x4_t ov;
                ov.x = pack2bf(o[0], o[1]); ov.y = pack2bf(o[2], o[3]); ov.z = pack2bf(o[4], o[5]); ov.w = pack2bf(o[6], o[7]);
                const int sl_ = csub * 8 + q;
                *(u32x4_t*)(CMs + sl_ * KW_LD + cvc * 8) = ov;
                *(u32x4_t*)(CMg + (t0 + sl_) * 512 + ch0) = ov;
            }
        }
        if (wave == 0) {
            const float i0 = ipre[(t0 + 2 * lane) * 4 + hd], i1 = ipre[(t0 + 2 * lane + 1) * 4 + hd];
            const float f0 = logf_[(t0 + 2 * lane) * 4 + hd], f1 = logf_[(t0 + 2 * lane + 1) * 4 + hd];
            float s = f0 + f1;
#pragma unroll
            for (int d = 1; d < 64; d <<= 1) { const float t = __shfl_up(s, d); if (lane >= d) s += t; }
            const float g1 = s, g0 = s - f1;
            const float gtot = __shfl(s, 63);
            const float b0 = i0 - g0, b1 = i1 - g1;
            float bm = fmaxf(b0, b1);
#pragma unroll
            for (int o = 32; o >= 1; o >>= 1) bm = fmaxf(bm, __shfl_xor(bm, o));
            const float Mc = gtot + bm;
            wv[2 * lane] = __expf(b0 - bm);
            wv[2 * lane + 1] = __expf(b1 - bm);
            Gc[(t0 + 2 * lane) * 4 + hd] = g0; Gc[(t0 + 2 * lane + 1) * 4 + hd] = g1;
            Bv[(t0 + 2 * lane) * 4 + hd] = b0; Bv[(t0 + 2 * lane + 1) * 4 + hd] = b1;
            if (lane == 0) { usc[unit * 4 + 0] = Mc; usc[unit * 4 + 1] = gtot; }
        }
        __syncthreads();
        const bf16_t* Acm = CMs;
        {
            f32x16 acc[4];
            zero_acc<4>(acc);
            wave_mma<4, 8>(acc, Acm + (wave * 32) * KW_LD, KW_LD, WqT + (size_t)hd * 16384, 128, lane);
            {
                bf16_t* qb = Qm + (t0 + wave * 32 + 4 * h) * 512 + hd * 128 + r;
#pragma unroll
                for (int i4 = 0; i4 < 4; ++i4) {
                    bf16_t* q2 = qb + (size_t)i4 * 8 * 512;
                    LAUNDER(q2);
#pragma unroll
                    for (int ii = 0; ii < 4; ++ii)
#pragma unroll
                        for (int nt = 0; nt < 4; ++nt) q2[ii * 512 + nt * 32] = f2bf(acc[nt][i4 * 4 + ii]);
                }
            }
            zero_acc<4>(acc);
            wave_mma<4, 8>(acc, Acm + (wave * 32) * KW_LD, KW_LD, WkT + (size_t)hd * 16384, 128, lane);
            {
                bf16_t* qb = Km + (t0 + wave * 32 + 4 * h) * 512 + hd * 128 + r;
#pragma unroll
                for (int i4 = 0; i4 < 4; ++i4) {
                    bf16_t* q2 = qb + (size_t)i4 * 8 * 512;
                    LAUNDER(q2);
#pragma unroll
                    for (int ii = 0; ii < 4; ++ii)
#pragma unroll
                        for (int nt = 0; nt < 4; ++nt) q2[ii * 512 + nt * 32] = f2bf(acc[nt][i4 * 4 + ii]);
                }
            }
        }
        {
            f32x16 acc[4];
            zero_acc<4>(acc);
            wave_mma<4, 8>(acc, WkT + (size_t)hd * 16384 + (size_t)(wave * 32) * 128, 128, Acm, KW_LD, lane);
#pragma unroll
            for (int nt = 0; nt < 4; ++nt) {
                const float w = wv[nt * 32 + r];
#pragma unroll
                for (int i = 0; i < 16; ++i) KwT[(wave * 32 + crow(i, h)) * KW_LD + nt * 32 + r] = f2bf(acc[nt][i] * w);
            }
        }
        __syncthreads();
        if (tid < 128) {
            float s = 0.f;
            for (int q = 0; q < 128; ++q) s += bf2f(KwT[tid * KW_LD + q]);
            ND[(size_t)unit * 128 + tid] = s;
        }
        {
            f32x16 acc[4];
            zero_acc<4>(acc);
            const bf16_t* Av = VT + ((size_t)b * 512 + hd * 128 + wave * 32) * 2048 + c * 128;
            wave_mma<4, 8>(acc, Av, 2048, KwT, KW_LD, lane);
            float* dst = DT + (size_t)unit * 16384 + (wave * 32 + 4 * h) * 128 + r;
#pragma unroll
            for (int i4 = 0; i4 < 4; ++i4) {
                float* d2 = dst + i4 * 8 * 128;
                LAUNDER(d2);
#pragma unroll
                for (int ii = 0; ii < 4; ++ii)
#pragma unroll
                    for (int nt = 0; nt < 4; ++nt) d2[ii * 128 + nt * 32] = acc[nt][i4 * 4 + ii];
            }
        }
    }
    __syncthreads();
}

DI void phase_m2(const Params& p, char* ws) {
    (void)p;
    const float* DT = (const float*)(ws + OFF_R5);
    bf16_t* Cin = (bf16_t*)(ws + OFF_R2);
    float* usc = (float*)(ws + OFF_USC);
    const float* ND = (const float*)(ws + OFF_ND);
    float* NIN = (float*)(ws + OFF_NIN);
    const size_t gtid = (size_t)blockIdx.x * 256 + get_tid(), gsz = (size_t)gridDim.x * 256;
    const size_t total = (size_t)64 * (16384 + 128);
    for (size_t it = gtid; it < total; it += gsz) {
        const int bh = (int)(it / (16384 + 128));
        const int idx = (int)(it % (16384 + 128));
        const bool isC = idx < 16384;
        const float* src = isC ? DT + (size_t)bh * 16 * 16384 + idx : ND + (size_t)bh * 16 * 128 + (idx - 16384);
        const size_t cstride = isC ? 16384 : 128;
        float dv[16], dec[16], sc[16];
#pragma unroll
        for (int c = 0; c < 16; ++c) dv[c] = src[(size_t)c * cstride];
        float m = NEG_INF_F;
#pragma unroll
        for (int c = 0; c < 16; ++c) {
            const int unit = bh * 16 + c;
            const float Mc = usc[unit * 4 + 0], gt = usc[unit * 4 + 1];
            const float mnew = fmaxf(gt + m, Mc);
            dec[c] = __expf(gt + m - mnew); sc[c] = __expf(Mc - mnew);
            if (idx == 16384) usc[unit * 4 + 2] = m;
            m = mnew;
        }
        float st = 0.f;
#pragma unroll
        for (int c = 0; c < 16; ++c) {
            const int unit = bh * 16 + c;
            if (isC) Cin[(size_t)unit * 16384 + idx] = f2bf(st);
            else NIN[(size_t)unit * 128 + (idx - 16384)] = st;
            st = dec[c] * st + sc[c] * dv[c];
        }
    }
}

template <int NT, int KSTEPS>
DI void wave_mma_regA_ldsB(f32x16 (&acc)[NT], const bf16x8 (&af)[KSTEPS], const bf16_t* B, int ldb, int lane) {
    const int r = lane & 31, h = lane >> 5;
#pragma unroll
    for (int ks = 0; ks < KSTEPS; ++ks) {
#pragma unroll
        for (int nt = 0; nt < NT; ++nt) acc[nt] = MFMA32(af[ks], *(const bf16x8*)(B + (nt * 32 + r) * ldb + ks * 16 + h * 8), acc[nt]);
        if (ks & 1) __builtin_amdgcn_sched_barrier(0);
    }
}
template <int NT, int KSTEPS>
DI void wave_mma_ldsAB(f32x16 (&acc)[NT], const bf16_t* A, int lda, const bf16_t* B, int ldb, int lane) {
    const int r = lane & 31, h = lane >> 5;
#pragma unroll
    for (int ks = 0; ks < KSTEPS; ++ks) {
        const bf16x8 a = *(const bf16x8*)(A + r * lda + ks * 16 + h * 8);
#pragma unroll
        for (int nt = 0; nt < NT; ++nt) acc[nt] = MFMA32(a, *(const bf16x8*)(B + (nt * 32 + r) * ldb + ks * 16 + h * 8), acc[nt]);
        if (ks & 1) asm volatile("" ::: "memory");
    }
}
DI void phase_m3(const Params& p, char* ws, char* smem) {
    const bf16_t* R3 = (const bf16_t*)(ws + OFF_R3);
    const bf16_t* VT = R3 + (size_t)T_TOK * 512;
    const bf16_t* Zb = R3 + (size_t)2 * T_TOK * 512;
    const bf16_t* CM = (const bf16_t*)(ws + OFF_R5 + 64ull * MiB);
    const bf16_t* Qm = (const bf16_t*)(ws + OFF_R1);
    const bf16_t* Km = (const bf16_t*)(ws + OFF_R1 + 32ull * MiB);
    const bf16_t* Cin = (const bf16_t*)(ws + OFF_R2);
    const bf16_t* PWT = (const bf16_t*)(ws + OFF_PWT);
    const float* Gc = (const float*)(ws + OFF_G);
    const float* Bv = (const float*)(ws + OFF_BV);
    const float* usc = (const float*)(ws + OFF_USC);
    const float* NIN = (const float*)(ws + OFF_NIN);
    bf16_t* MIX = (bf16_t*)(ws + OFF_R4);
    const int tid = get_tid(), lane = tid & 63, wave = tid >> 6;
    const int r = lane & 31, h = lane >> 5;
    bf16_t* Sp = (bf16_t*)smem + (size_t)wave * 32 * KW_LD;
    bf16_t* OPB = (bf16_t*)(smem + 4 * 32 * KW_LD * 2);
    float* fb = (float*)(smem + 2 * 4 * 32 * KW_LD * 2);
    float* gs = fb;
    float* bs = fb + 128;
    float* mxs = fb + 256;
    float* nin = fb + 384;
    float* qns = fb + 512;
    const int srow = tid >> 4, sch = tid & 15;
    for (int u2 = blockIdx.x; u2 < 1024; u2 += gridDim.x) {
        const int g = u2 & 3, c = (u2 >> 2) & 15, b = u2 >> 6;
        const size_t t0 = (size_t)b * SEQ + c * 128;
        u32x4_t R[8];
#pragma unroll
        for (int q = 0; q < 8; ++q) R[q] = *(const u32x4_t*)(PWT + (size_t)g * 16384 + (size_t)(srow + 16 * q) * 128 + sch * 8);
        __syncthreads();
#pragma unroll
        for (int q = 0; q < 8; ++q) *(u32x4_t*)(OPB + (srow + 16 * q) * KW_LD + sch * 8) = R[q];
        {
            const bf16_t* UP = (const bf16_t*)(ws + OFF_R3) + (size_t)3 * T_TOK * 512;
            const int pvc = tid & 15, psub = tid >> 4;
            const int ch0 = g * 128 + pvc * 8;
            const int W = 2 << g;
            const int s0 = c * 128 + psub * 8;
            const size_t tbase = (size_t)b * SEQ;
            float sum[8];
#pragma unroll
            for (int e = 0; e < 8; ++e) sum[e] = 0.f;
            for (int q = 1; q < W; ++q) {
                const int sq = s0 - q;
                if (sq >= 0) {
                    const u32x4_t rw = *(const u32x4_t*)(UP + (tbase + sq) * 512 + ch0);
                    const unsigned w[4] = {rw.x, rw.y, rw.z, rw.w};
#pragma unroll
                    for (int e = 0; e < 4; ++e) { sum[2 * e] += __uint_as_float(w[e] << 16); sum[2 * e + 1] += __uint_as_float(w[e] & 0xffff0000u); }
                }
            }
            u32x4_t rawb[8], rlb[8];
#pragma unroll
            for (int q = 0; q < 8; ++q) {
                const int sq = s0 + q;
                rawb[q] = *(const u32x4_t*)(UP + (tbase + sq) * 512 + ch0);
                const int sl_ = sq - W + 1;
                rlb[q] = (u32x4_t){0u, 0u, 0u, 0u};
                if (sl_ >= 0) rlb[q] = *(const u32x4_t*)(UP + (tbase + sl_) * 512 + ch0);
            }
#pragma unroll
            for (int q = 0; q < 8; ++q) {
                const int sq = s0 + q;
                const unsigned w[4] = {rawb[q].x, rawb[q].y, rawb[q].z, rawb[q].w};
                float cur[8], o[8];
#pragma unroll
                for (int e = 0; e < 4; ++e) { cur[2 * e] = __uint_as_float(w[e] << 16); cur[2 * e + 1] = __uint_as_float(w[e] & 0xffff0000u); }
                const int cnt = (sq + 1 < W) ? (sq + 1) : W;
                const float inv = 1.f / (float)cnt;
#pragma unroll
                for (int e = 0; e < 8; ++e) { sum[e] += cur[e]; o[e] = sum[e] * inv - cur[e]; }
                u32x4_t ov;
                ov.x = pack2bf(o[0], o[1]); ov.y = pack2bf(o[2], o[3]); ov.z = pack2bf(o[4], o[5]); ov.w = pack2bf(o[6], o[7]);
                *(u32x4_t*)((bf16_t*)smem + (psub * 8 + q) * KW_LD + pvc * 8) = ov;
                const unsigned wl[4] = {rlb[q].x, rlb[q].y, rlb[q].z, rlb[q].w};
#pragma unroll
                for (int e = 0; e < 4; ++e) { sum[2 * e] -= __uint_as_float(wl[e] << 16); sum[2 * e + 1] -= __uint_as_float(wl[e] & 0xffff0000u); }
            }
        }
        __syncthreads();
        f32x16 acc[4];
        zero_acc<4>(acc);
        wave_mma_ldsAB<4, 8>(acc, (const bf16_t*)smem + wave * 32 * KW_LD, KW_LD, OPB, KW_LD, lane);
        bf16_t* mb = MIX + (t0 + wave * 32 + 4 * h) * 1024 + 512 + g * 128 + r;
#pragma unroll
        for (int i4 = 0; i4 < 4; ++i4) {
            bf16_t* m2 = mb + (size_t)i4 * 8 * 1024;
            LAUNDER(m2);
#pragma unroll
            for (int ii = 0; ii < 4; ++ii)
#pragma unroll
                for (int nt = 0; nt < 4; ++nt) m2[ii * 1024 + nt * 32] = f2bf(acc[nt][i4 * 4 + ii]);
        }
    }
    for (int unit = blockIdx.x; unit < 1024; unit += gridDim.x) {
        const int c = unit & 15, hd = (unit >> 4) & 3, b = unit >> 6;
        const size_t t0 = (size_t)b * SEQ + c * 128;
        const float m_in = usc[unit * 4 + 2];
        const int l0 = wave * 32;
        bf16x8 qf[8];
#pragma unroll
        for (int ks = 0; ks < 8; ++ks) qf[ks] = *(const bf16x8*)(Qm + (t0 + l0 + r) * 512 + hd * 128 + ks * 16 + h * 8);
        __syncthreads();
        if (wave == 0) {
            const float b0 = Bv[(t0 + 2 * lane) * 4 + hd], b1 = Bv[(t0 + 2 * lane + 1) * 4 + hd];
            float s = fmaxf(b0, b1);
#pragma unroll
            for (int d = 1; d < 64; d <<= 1) { const float t = __shfl_up(s, d); if (lane >= d) s = fmaxf(s, t); }
            float prev = __shfl_up(s, 1);
            if (lane == 0) prev = NEG_INF_F;
            const float pm0 = fmaxf(prev, b0), pm1 = s;
            bs[2 * lane] = b0; bs[2 * lane + 1] = b1;
            mxs[2 * lane] = fmaxf(m_in, pm0); mxs[2 * lane + 1] = fmaxf(m_in, pm1);
        } else if (wave == 1) {
            gs[2 * lane] = Gc[(t0 + 2 * lane) * 4 + hd]; gs[2 * lane + 1] = Gc[(t0 + 2 * lane + 1) * 4 + hd];
            nin[2 * lane] = NIN[(size_t)unit * 128 + 2 * lane]; nin[2 * lane + 1] = NIN[(size_t)unit * 128 + 2 * lane + 1];
        }
        {
            u32x4_t R[8];
#pragma unroll
            for (int q = 0; q < 8; ++q) R[q] = *(const u32x4_t*)(Km + (t0 + srow + 16 * q) * 512 + hd * 128 + sch * 8);
#pragma unroll
            for (int q = 0; q < 8; ++q) *(u32x4_t*)(OPB + (srow + 16 * q) * KW_LD + sch * 8) = R[q];
        }
        __syncthreads();
        if (lane < 32) {
            const bf16_t* qr = Qm + (t0 + l0 + lane) * 512 + hd * 128;
            float s = 0.f;
            for (int d8 = 0; d8 < 16; ++d8) {
                const uint4 raw = *(const uint4*)(qr + d8 * 8);
                const unsigned w[4] = {raw.x, raw.y, raw.z, raw.w};
#pragma unroll
                for (int e = 0; e < 4; ++e) s += bf2f((bf16_t)(w[e] & 0xffff)) * nin[d8 * 8 + 2 * e] + bf2f((bf16_t)(w[e] >> 16)) * nin[d8 * 8 + 2 * e + 1];
            }
            qns[wave * 32 + lane] = s;
        }
        float den2[16];
        {
            f32x16 acc[4];
            zero_acc<4>(acc);
            wave_mma_regA_ldsB<4, 8>(acc, qf, OPB, KW_LD, lane);
#pragma unroll
            for (int i = 0; i < 16; ++i) {
                const int l = l0 + crow(i, h);
                const float mxl = mxs[l];
                float rs = 0.f;
#pragma unroll
                for (int nt = 0; nt < 4; ++nt) {
                    const int sx = nt * 32 + r;
                    float v = 0.f;
                    if (sx <= l) v = acc[nt][i] * __expf(fminf(bs[sx] - mxl, 0.f));
                    rs += v;
                    Sp[crow(i, h) * KW_LD + sx] = f2bf(v);
                }
                den2[i] = half_sum(rs);
            }
        }
#pragma unroll
        for (int ks = 0; ks < 8; ++ks) qf[ks] = *(const bf16x8*)(Qm + (t0 + l0 + r) * 512 + hd * 128 + ks * 16 + h * 8);
        __syncthreads();
        {
            u32x4_t R[8];
#pragma unroll
            for (int q = 0; q < 8; ++q) R[q] = *(const u32x4_t*)(Cin + (size_t)unit * 16384 + (size_t)(srow + 16 * q) * 128 + sch * 8);
#pragma unroll
            for (int q = 0; q < 8; ++q) *(u32x4_t*)(OPB + (srow + 16 * q) * KW_LD + sch * 8) = R[q];
        }
        __syncthreads();
        f32x16 acc[4];
        zero_acc<4>(acc);
        wave_mma_regA_ldsB<4, 8>(acc, qf, OPB, KW_LD, lane);
#pragma unroll
        for (int i = 0; i < 16; ++i) {
            const int l = l0 + crow(i, h);
            const float inter_i = __expf(m_in - mxs[l]);
#pragma unroll
            for (int nt = 0; nt < 4; ++nt) acc[nt][i] *= inter_i;
        }
        __syncthreads();
        {
            u32x4_t R[8];
#pragma unroll
            for (int q = 0; q < 8; ++q) R[q] = *(const u32x4_t*)(VT + ((size_t)b * 512 + hd * 128 + srow + 16 * q) * 2048 + c * 128 + sch * 8);
#pragma unroll
            for (int q = 0; q < 8; ++q) *(u32x4_t*)(OPB + (srow + 16 * q) * KW_LD + sch * 8) = R[q];
        }
        __syncthreads();
        wave_mma_ldsAB<4, 8>(acc, Sp, KW_LD, OPB, KW_LD, lane);
#pragma unroll
        for (int i = 0; i < 16; ++i) {
            const int lr = crow(i, h), l = l0 + lr;
            const float den = __expf(m_in - mxs[l]) * qns[wave * 32 + lr] + den2[i];
            const float mrow = gs[l] + mxs[l];
            const float dn = fmaxf(fabsf(den), __expf(-mrow)) + 1e-6f;
            const float inv = 1.f / dn;
            float hv[4];
            float sm = 0.f;
#pragma unroll
            for (int nt = 0; nt < 4; ++nt) { hv[nt] = acc[nt][i] * inv; sm += hv[nt]; }
            const float mu = half_sum(sm) * (1.f / 128.f);
            float sq = 0.f;
#pragma unroll
            for (int nt = 0; nt < 4; ++nt) { const float d = hv[nt] - mu; sq += d * d; }
            const float var = half_sum(sq) * (1.f / 128.f);
            const float rstd = rsqrtf(var + 1e-6f);
#pragma unroll
            for (int nt = 0; nt < 4; ++nt) Sp[lr * KW_LD + nt * 32 + r] = f2bf((hv[nt] - mu) * rstd);
        }
        {
            const int c8 = lane & 15;
            const bf16_t* zrow = Zb + (t0 + l0 + (lane >> 4)) * 512 + hd * 128 + c8 * 8;
            const bf16_t* crow_ = CM + (t0 + l0 + (lane >> 4)) * 512 + hd * 128 + c8 * 8;
            bf16_t* mrow = MIX + (t0 + l0 + (lane >> 4)) * 1024 + hd * 128 + c8 * 8;
            const float* hgp = p.head_g + hd * 128 + c8 * 8;
            const float* skp = p.skip + hd * 128 + c8 * 8;
            LAUNDER(zrow); LAUNDER(crow_); LAUNDER(mrow); LAUNDER(hgp); LAUNDER(skp);
            const float4 hgA = *(const float4*)(hgp), hgB = *(const float4*)(hgp + 4);
            const float4 skA = *(const float4*)(skp), skB = *(const float4*)(skp + 4);
#pragma unroll
            for (int hb = 0; hb < 2; ++hb) {
                uint4 zq[4], cq[4];
#pragma unroll
                for (int it = 0; it < 4; ++it) {
                    zq[it] = *(const uint4*)(zrow + (size_t)(hb * 4 + it) * 4 * 512);
                    cq[it] = *(const uint4*)(crow_ + (size_t)(hb * 4 + it) * 4 * 512);
                }
#pragma unroll
                for (int it = 0; it < 4; ++it) {
                    const int row = (hb * 4 + it) * 4 + (lane >> 4);
                    const uint4 hq = *(const uint4*)(Sp + row * KW_LD + c8 * 8);
#define M3_GATE(HW, ZW, CW, G0, G1, S0, S1, OUTW)                                                             \
                    {                                                                                           \
                        const float h0_ = __uint_as_float((HW) << 16), h1_ = __uint_as_float((HW) & 0xffff0000u); \
                        const float z0_ = __uint_as_float((ZW) << 16), z1_ = __uint_as_float((ZW) & 0xffff0000u); \
                        const float m0_ = __uint_as_float((CW) << 16), m1_ = __uint_as_float((CW) & 0xffff0000u); \
                        OUTW = pack2bf(sigmoidf_(z0_) * (h0_ * (G0) + (S0) * m0_), sigmoidf_(z1_) * (h1_ * (G1) + (S1) * m1_)); \
                    }
                    uint4 ov;
                    M3_GATE(hq.x, zq[it].x, cq[it].x, hgA.x, hgA.y, skA.x, skA.y, ov.x)
                    M3_GATE(hq.y, zq[it].y, cq[it].y, hgA.z, hgA.w, skA.z, skA.w, ov.y)
                    M3_GATE(hq.z, zq[it].z, cq[it].z, hgB.x, hgB.y, skB.x, skB.y, ov.z)
                    M3_GATE(hq.w, zq[it].w, cq[it].w, hgB.z, hgB.w, skB.z, skB.w, ov.w)
                    *(uint4*)(mrow + (size_t)(hb * 4 + it) * 4 * 1024) = ov;
                }
                asm volatile("" ::: "memory");
            }
        }
    }
    __syncthreads();
}

DI unsigned f2ord(float x) { const unsigned u = __float_as_uint(x); return (u & 0x80000000u) ? ~u : (u | 0x80000000u); }
DI float ord2f(unsigned k) { const unsigned u = (k & 0x80000000u) ? (k & 0x7fffffffu) : ~k; return __uint_as_float(u); }

DI void convert_row_load(const Params& p, int layer, int row, int lane, float (&v)[16]) {
    const int tab = row >> 14, e = row & 16383;
    const float* src = (tab ? p.peer_v : p.peer_u) + ((size_t)layer * 16384 + e) * 1024 + lane * 16;
#pragma unroll
    for (int i = 0; i < 4; ++i) {
        const f32x4n_t q = __builtin_nontemporal_load((const f32x4n_t*)(src + i * 4));
        v[i * 4 + 0] = q.x; v[i * 4 + 1] = q.y; v[i * 4 + 2] = q.z; v[i * 4 + 3] = q.w;
    }
}
#define TAB_V_OFF (8ull * MiB)
DI void convert_row_finish(char* ws, int layer, int row, int lane, const float (&v)[16]) {
    unsigned char* T8 = (unsigned char*)(ws + OFF_R4);
    float2* SC = (float2*)(ws + OFF_SC) + (size_t)layer * 16384;
    const int tab = row >> 14, e = row & 16383;
    float am = 0.f, ss = 0.f;
#pragma unroll
    for (int i = 0; i < 16; ++i) { am = fmaxf(am, fabsf(v[i])); ss += v[i] * v[i]; }
#pragma unroll
    for (int o = 32; o >= 1; o >>= 1) { am = fmaxf(am, __shfl_xor(am, o)); ss += __shfl_xor(ss, o); }
    const float step = fminf(0.3352f * sqrtf(ss * (1.f / 1024.f)), am * (1.f / 7.5f));
    const float sc = (step > 0.f) ? 1.f / step : 0.f;
    unsigned w[2];
#pragma unroll
    for (int j = 0; j < 2; ++j) {
        unsigned acc = 0;
#pragma unroll
        for (int k = 0; k < 8; ++k) {
            int n = (int)floorf(v[j * 8 + k] * sc) + 8;
            n = n < 0 ? 0 : (n > 15 ? 15 : n);
            const int nibU = (k < 4) ? 2 * k : 2 * (k - 4) + 1;
            const int pos = (tab == 0) ? nibU : k;
            acc |= (unsigned)((pos & 1) ? (n ^ 8) : n) << (4 * pos);
        }
        w[j] = acc;
    }
    *(uint2*)(T8 + (tab ? TAB_V_OFF : 0) + (size_t)(lane >> 4) * (16384 * 128) + (size_t)e * 128 + (lane & 15) * 8) = make_uint2(w[0], w[1]);
    if (lane == 0) { if (tab == 0) SC[e].x = step * (1.f / 16.f); else SC[e].y = step; }
}

typedef float f32x4 __attribute__((ext_vector_type(4)));
#define MFMA16(a, b, c) __builtin_amdgcn_mfma_f32_16x16x32_bf16((a), (b), (c), 0, 0, 0)
#define DPPU(v, ctrl) ((unsigned)__builtin_amdgcn_mov_dpp((int)(v), (ctrl), 0xF, 0xF, true))
DI unsigned umax_(unsigned a, unsigned b) { return a > b ? a : b; }
DI unsigned row16_umax(unsigned v) {
    v = umax_(v, DPPU(v, 0xB1)); v = umax_(v, DPPU(v, 0x4E)); v = umax_(v, DPPU(v, 0x141)); v = umax_(v, DPPU(v, 0x140));
    return v;
}
DI float row16_sum(float v) {
    v += __int_as_float(__builtin_amdgcn_mov_dpp(__float_as_int(v), 0xB1, 0xF, 0xF, true));
    v += __int_as_float(__builtin_amdgcn_mov_dpp(__float_as_int(v), 0x4E, 0xF, 0xF, true));
    v += __int_as_float(__builtin_amdgcn_mov_dpp(__float_as_int(v), 0x141, 0xF, 0xF, true));
    v += __int_as_float(__builtin_amdgcn_mov_dpp(__float_as_int(v), 0x140, 0xF, 0xF, true));
    return v;
}
DI void cand_pair(int c, int& ia, int& ib) {
    if (c < 16) { ia = 0; ib = c; }
    else if (c < 24) { ia = 1; ib = c - 16; }
    else if (c < 29) { ia = 2; ib = c - 24; }
    else if (c < 33) { ia = 3; ib = c - 29; }
    else if (c < 36) { ia = 4; ib = c - 33; }
    else if (c < 38) { ia = 5; ib = c - 36; }
    else if (c < 40) { ia = 6; ib = c - 38; }
    else if (c < 42) { ia = 7; ib = c - 40; }
    else { ia = c - 34; ib = 0; }
}
DI void phase_topk(const Params& p, char* ws, int layer, char* smem) {
    const bf16_t* Qp = (const bf16_t*)(ws + OFF_R3);
    const bf16_t* KEYS = (const bf16_t*)(ws + OFF_KEYS) + (size_t)layer * 8 * 2 * 128 * 128;
    unsigned* LIST = (unsigned*)(ws + OFF_R5);
    const int tid = get_tid(), lane = tid & 63, wave = tid >> 6;
    const int c16 = lane & 15, q4 = lane >> 4, rowbase = lane & 48;
    int ca[4], cb[4];
#pragma unroll
    for (int q = 0; q < 4; ++q) cand_pair(c16 + 16 * q, ca[q], cb[q]);
    const int hd = (int)blockIdx.x & 7;
    const int nblk = ((int)gridDim.x - hd + 7) >> 3;
    const int wv = ((int)blockIdx.x >> 3) * 4 + wave, nwv = nblk * 4;
    __syncthreads();
    for (int i = tid; i < 256 * 16; i += 256) {
        const int row = i >> 4, ch = i & 15;
        *(uint4*)(smem + row * 272 + ch * 16) = *(const uint4*)(KEYS + ((size_t)hd * 256 + row) * 128 + ch * 8);
    }
    __syncthreads();
    const int gw = (int)blockIdx.x * 4 + wave, ngw = (int)gridDim.x * 4;
    int crow_i = gw;
    bf16x8 afc[2][4], afn[2][4];
    {
        const int tl0 = wv < T_TOK / 16 ? wv : T_TOK / 16 - 1;
#pragma unroll
        for (int pp = 0; pp < 2; ++pp)
#pragma unroll
            for (int ks = 0; ks < 4; ++ks) afc[pp][ks] = *(const bf16x8*)(Qp + ((size_t)tl0 * 16 + c16) * 2048 + (hd * 2 + pp) * 128 + q4 * 8 + ks * 32);
    }
    for (int tile = wv; tile < T_TOK / 16; tile += nwv) {
        const size_t t0 = (size_t)tile * 16;
        {
            const int tnx = (tile + nwv < T_TOK / 16) ? tile + nwv : T_TOK / 16 - 1;
#pragma unroll
            for (int pp = 0; pp < 2; ++pp)
#pragma unroll
                for (int ks = 0; ks < 4; ++ks) afn[pp][ks] = *(const bf16x8*)(Qp + ((size_t)tnx * 16 + c16) * 2048 + (hd * 2 + pp) * 128 + q4 * 8 + ks * 32);
        }
        float cva[16], cvb[16];
        const int cr0 = crow_i < 32768 ? crow_i : 32767, cr1 = crow_i + ngw < 32768 ? crow_i + ngw : 32767;
        convert_row_load(p, layer, cr0, lane, cva);
        convert_row_load(p, layer, cr1, lane, cvb);
        crow_i += 2 * ngw;
        unsigned top[2][4];
#pragma unroll
        for (int pp = 0; pp < 2; ++pp) {
            f32x4 acc[8];
#pragma unroll
            for (int nt = 0; nt < 8; ++nt) acc[nt] = (f32x4){0.f, 0.f, 0.f, 0.f};
            const char* Bb = smem + (pp * 128 + c16) * 272 + q4 * 16;
#pragma unroll
            for (int ks = 0; ks < 4; ++ks) {
#pragma unroll
                for (int nt = 0; nt < 8; ++nt) {
                    const bf16x8 bfr = *(const bf16x8*)(Bb + nt * 16 * 272 + ks * 64);
                    acc[nt] = MFMA16(afc[pp][ks], bfr, acc[nt]);
                }
                asm volatile("" ::: "memory");
            }
            unsigned kk[8][4];
#pragma unroll
            for (int nt = 0; nt < 8; ++nt)
#pragma unroll
                for (int rg = 0; rg < 4; ++rg) kk[nt][rg] = (f2ord(acc[nt][rg]) & ~127u) | (unsigned)(127 - (nt * 16 + c16));
#pragma unroll
            for (int rg = 0; rg < 4; ++rg) top[pp][rg] = 0u;
#define CE8(a, b) { const unsigned hi_ = umax_(kk[a][rg], kk[b][rg]); const unsigned lo_ = kk[a][rg] < kk[b][rg] ? kk[a][rg] : kk[b][rg]; kk[a][rg] = hi_; kk[b][rg] = lo_; }
#pragma unroll
            for (int rg = 0; rg < 4; ++rg) {
                CE8(0, 1) CE8(2, 3) CE8(4, 5) CE8(6, 7) CE8(0, 2) CE8(1, 3) CE8(4, 6) CE8(5, 7) CE8(1, 2) CE8(5, 6)
                CE8(0, 4) CE8(3, 7) CE8(1, 5) CE8(2, 6) CE8(1, 4) CE8(3, 6) CE8(2, 4) CE8(3, 5) CE8(3, 4)
            }
#pragma unroll 1
            for (int it = 0; it < 16; ++it) {
#pragma unroll
                for (int rg = 0; rg < 4; ++rg) {
                    const unsigned m = row16_umax(kk[0][rg]);
                    if (c16 == it) top[pp][rg] = m;
                    const bool won = (kk[0][rg] == m);
#pragma unroll
                    for (int nt = 0; nt < 7; ++nt) kk[nt][rg] = won ? kk[nt + 1][rg] : kk[nt][rg];
                    kk[7][rg] = won ? 0u : kk[7][rg];
                }
            }
        }
        unsigned ck[4][4], win[4];
#pragma unroll
        for (int rg = 0; rg < 4; ++rg) {
            const float va = ord2f(top[0][rg] & ~127u), vb = ord2f(top[1][rg] & ~127u);
#pragma unroll
            for (int q = 0; q < 4; ++q) {
                const float a = __shfl(va, rowbase + ca[q]);
                const float bq = __shfl(vb, rowbase + cb[q]);
                const int c = c16 + 16 * q;
                ck[q][rg] = (c < 50) ? ((f2ord(a + bq) & ~63u) | (unsigned)(63 - c)) : 0u;
            }
            win[rg] = 0u;
        }
#define CE4(a, b) { const unsigned hi_ = umax_(ck[a][rg], ck[b][rg]); const unsigned lo_ = ck[a][rg] < ck[b][rg] ? ck[a][rg] : ck[b][rg]; ck[a][rg] = hi_; ck[b][rg] = lo_; }
#pragma unroll
        for (int rg = 0; rg < 4; ++rg) { CE4(0, 1) CE4(2, 3) CE4(0, 2) CE4(1, 3) CE4(1, 2) }
#pragma unroll 1
        for (int it = 0; it < 16; ++it) {
#pragma unroll
            for (int rg = 0; rg < 4; ++rg) {
                const unsigned m = row16_umax(ck[0][rg]);
                if (c16 == it) win[rg] = m;
                const bool won = (ck[0][rg] == m);
                ck[0][rg] = won ? ck[1][rg] : ck[0][rg];
                ck[1][rg] = won ? ck[2][rg] : ck[1][rg];
                ck[2][rg] = won ? ck[3][rg] : ck[2][rg];
                ck[3][rg] = won ? 0u : ck[3][rg];
            }
        }
#pragma unroll
        for (int rg = 0; rg < 4; ++rg) {
            int ia, ib;
            cand_pair(63 - (int)(win[rg] & 63u), ia, ib);
            ia &= 15; ib &= 15;
            const unsigned ta = (unsigned)__shfl((int)top[0][rg], rowbase + ia);
            const unsigned tb = (unsigned)__shfl((int)top[1][rg], rowbase + ib);
            const int e = (127 - (int)(ta & 127u)) * 128 + (127 - (int)(tb & 127u));
            const float cv = ord2f(win[rg] & ~63u);
            const float cmax = __shfl(cv, rowbase);
            const float ex = __expf(cv - cmax);
            const float den = row16_sum(ex);
            const float g = ex / den;
            const size_t t = t0 + q4 * 4 + rg;
            ((unsigned short*)LIST)[t * 128 + hd * 16 + c16] = (unsigned short)e;
            ((unsigned short*)LIST)[(size_t)T_TOK * 128 + t * 128 + hd * 16 + c16] = f2bf(g);
        }
        convert_row_finish(ws, layer, cr0, lane, cva);
        convert_row_finish(ws, layer, cr1, lane, cvb);
#pragma unroll
        for (int pp = 0; pp < 2; ++pp)
#pragma unroll
            for (int ks = 0; ks < 4; ++ks) afc[pp][ks] = afn[pp][ks];
    }
    for (; crow_i < 32768; crow_i += ngw) {
        float cv[16];
        convert_row_load(p, layer, crow_i, lane, cv);
        convert_row_finish(ws, layer, crow_i, lane, cv);
    }
}

typedef float f32x2 __attribute__((ext_vector_type(2)));
DI void fp8x16_to_f32(const uint4& q, float (&f)[16]) {
    const unsigned w[4] = {q.x, q.y, q.z, q.w};
#pragma unroll
    for (int i = 0; i < 4; ++i) {
        const f32x2 lo = __builtin_amdgcn_cvt_pk_f32_fp8((int)w[i], false);
        const f32x2 hi = __builtin_amdgcn_cvt_pk_f32_fp8((int)w[i], true);
        f[i * 4 + 0] = lo.x; f[i * 4 + 1] = lo.y; f[i * 4 + 2] = hi.x; f[i * 4 + 3] = hi.y;
    }
}

DI uint4 nt_load_u4(const void* ptr) { const u32x4_t v = __builtin_nontemporal_load((const u32x4_t*)ptr); return make_uint4(v.x, v.y, v.z, v.w); }
DI float4 nt_load_f4(const void* ptr) { const f32x4n_t v = __builtin_nontemporal_load((const f32x4n_t*)ptr); return make_float4(v.x, v.y, v.z, v.w); }
DI void slice_assign(int& x, int& wv, int& nwv) {
    const int G = (int)gridDim.x;
    x = (int)blockIdx.x & 7;
    const int nblk = (G - x + 7) >> 3;
    wv = ((int)blockIdx.x >> 3) * 4 + (get_tid() >> 6);
    nwv = nblk * 4;
}
DI void peer_issue(const unsigned char* tab, const uint4 (&E)[2], int half, unsigned coloff, uint4 (&buf)[8]) {
    const uint4 ea = half ? E[1] : E[0];
    unsigned w4[4] = {ea.x, ea.y, ea.z, ea.w};
    asm volatile("" : "+v"(w4[0]), "+v"(w4[1]), "+v"(w4[2]), "+v"(w4[3]));
#pragma unroll
    for (int j = 0; j < 8; ++j) {
        const unsigned e = (j & 1) ? (w4[j >> 1] >> 16) : (w4[j >> 1] & 0xffffu);
        buf[j] = *(const uint4*)(tab + (e * 128u + coloff));
    }
}
DI void slice_assign4(int& x, int& wv, int& nwv) {
    const int G = (int)gridDim.x, L = (int)blockIdx.x & 7;
    x = L & 3;
    const int nb_lo = (G - x + 7) >> 3, nb_hi = (G - (x + 4) + 7) >> 3;
    wv = ((L >> 2) ? nb_lo * 4 : 0) + ((int)blockIdx.x >> 3) * 4 + (get_tid() >> 6);
    nwv = (nb_lo + nb_hi) * 4;
}
DI void peer_u_compute(const uint4 (&buf)[8], const uint4& hA_in, const uint4& hB_in, int init, int c, int& keep) {
    unsigned h0 = hA_in.x, h1 = hA_in.y, h2 = hA_in.z, h3 = hA_in.w, h4 = hB_in.x, h5 = hB_in.y, h6 = hB_in.z, h7 = hB_in.w;
    asm volatile("" : "+v"(h0), "+v"(h1), "+v"(h2), "+v"(h3), "+v"(h4), "+v"(h5), "+v"(h6), "+v"(h7), "+v"(keep), "+v"(init));
    const unsigned ML = 0x0F0F0F0Fu, MH = 0xF0F0F0F0u;
#pragma unroll
    for (int j = 0; j < 8; ++j) {
        int accL, accH;
        asm("v_dot4_i32_i8 %0, %1, %2, 0" : "=v"(accL) : "v"(buf[j].x & ML), "v"(h0));
        asm("v_dot4_i32_i8 %0, %1, %2, %3" : "=v"(accH) : "v"(buf[j].x & MH), "v"(h1), "v"(init));
        accL = __builtin_amdgcn_sdot4((int)(buf[j].y & ML), (int)h2, accL, false);
        accH = __builtin_amdgcn_sdot4((int)(buf[j].y & MH), (int)h3, accH, false);
        accL = __builtin_amdgcn_sdot4((int)(buf[j].z & ML), (int)h4, accL, false);
        accH = __builtin_amdgcn_sdot4((int)(buf[j].z & MH), (int)h5, accH, false);
        accL = __builtin_amdgcn_sdot4((int)(buf[j].w & ML), (int)h6, accL, false);
        accH = __builtin_amdgcn_sdot4((int)(buf[j].w & MH), (int)h7, accH, false);
        int acc = accL * 16 + accH;
        acc += __builtin_amdgcn_mov_dpp(acc, 0xB1, 0xF, 0xF, true);
        acc += __builtin_amdgcn_mov_dpp(acc, 0x4E, 0xF, 0xF, true);
        acc += __builtin_amdgcn_mov_dpp(acc, 0x141, 0xF, 0xF, true);
        if (c == j) keep = acc;
    }
    asm volatile("" : "+v"(keep));
}
DI int peer_u_init(const uint4& hA, const uint4& hB) {
    int sl_ = __builtin_amdgcn_sdot4((int)hA.x, 0x01010101, 0, false);
    int sh_ = __builtin_amdgcn_sdot4((int)hA.y, 0x01010101, 0, false);
    sl_ = __builtin_amdgcn_sdot4((int)hA.z, 0x01010101, sl_, false);
    sh_ = __builtin_amdgcn_sdot4((int)hA.w, 0x01010101, sh_, false);
    sl_ = __builtin_amdgcn_sdot4((int)hB.x, 0x01010101, sl_, false);
    sh_ = __builtin_amdgcn_sdot4((int)hB.y, 0x01010101, sh_, false);
    sl_ = __builtin_amdgcn_sdot4((int)hB.z, 0x01010101, sl_, false);
    sh_ = __builtin_amdgcn_sdot4((int)hB.w, 0x01010101, sh_, false);
    return 8 * sh_ - 120 * sl_;
}
DI void phase_peer_u(const Params& p, char* ws, int layer) {
    (void)p; (void)layer;
    const unsigned char* H8 = (const unsigned char*)(ws + OFF_R5 + 16ull * MiB);
    const unsigned* LIST = (const unsigned*)(ws + OFF_R5);
    const unsigned char* U4 = (const unsigned char*)(ws + OFF_R4);
    int* PART = (int*)(ws + OFF_R3);
    const int lane = get_tid() & 63;
    const int sl = lane >> 3, c = lane & 7;
    int x, wv, nwv;
    slice_assign4(x, wv, nwv);
    const unsigned coloff = (unsigned)x * (16384u * 128u) + (unsigned)c * 16u;
    const int n = (T_TOK - wv + nwv - 1) / nwv;
    if (n <= 0) return;
    const unsigned short* EID = (const unsigned short*)LIST;
    uint4 E0[2], E1[2], LE0[2], LE1[2], hA0, hB0, hA1, hB1, lhA0, lhB0, lhA1, lhB1, b0[8], b1[8], b2[8], b3[8];
    int in0, in1;
#define UTOK(I) ((unsigned)wv + __umul24((unsigned)(I), (unsigned)nwv))
#define U_LOAD_E(E, I) { const size_t t_ = UTOK(I); E[0] = nt_load_u4(EID + t_ * 128 + sl * 16); E[1] = nt_load_u4(EID + t_ * 128 + sl * 16 + 8); }
#define U_LOAD_H(HA, HB, I) { const size_t t_ = UTOK(I); HA = nt_load_u4(H8 + t_ * 1024 + x * 256 + c * 32); HB = nt_load_u4(H8 + t_ * 1024 + x * 256 + c * 32 + 16); }
#define U_STORE(I, K0, K1) { int* dst_ = PART + ((size_t)x * T_TOK + UTOK(I)) * 128 + sl * 16 + c; __builtin_nontemporal_store(K0, dst_); __builtin_nontemporal_store(K1, dst_ + 8); }
#define U_ROT(E, HA, HB, INI, LE, LHA, LHB)                                                                    \
    {                                                                                                           \
        asm volatile("" : "+v"(LE[0].x), "+v"(LE[0].y), "+v"(LE[0].z), "+v"(LE[0].w), "+v"(LE[1].x), "+v"(LE[1].y), "+v"(LE[1].z), "+v"(LE[1].w)); \
        asm volatile("" : "+v"(LHA.x), "+v"(LHA.y), "+v"(LHA.z), "+v"(LHA.w), "+v"(LHB.x), "+v"(LHB.y), "+v"(LHB.z), "+v"(LHB.w)); \
        E[0] = LE[0]; E[1] = LE[1]; HA = LHA; HB = LHB; INI = peer_u_init(LHA, LHB);                            \
    }
#define UCL(I) ((I) < n ? (I) : n - 1)
    U_LOAD_E(E0, 0)
    U_LOAD_E(E1, UCL(1))
    peer_issue(U4, E0, 0, coloff, b0);
    peer_issue(U4, E0, 1, coloff, b1);
    peer_issue(U4, E1, 0, coloff, b2);
    peer_issue(U4, E1, 1, coloff, b3);
    U_LOAD_E(LE0, UCL(2)) U_LOAD_H(lhA0, lhB0, 0)
    U_LOAD_E(LE1, UCL(3)) U_LOAD_H(lhA1, lhB1, UCL(1))
    U_ROT(E0, hA0, hB0, in0, LE0, lhA0, lhB0)
    U_ROT(E1, hA1, hB1, in1, LE1, lhA1, lhB1)
#pragma unroll 1
    for (int i = 0; i < n; i += 2) {
        U_LOAD_E(LE0, UCL(i + 4)) U_LOAD_H(lhA0, lhB0, UCL(i + 2))
        U_LOAD_E(LE1, UCL(i + 5)) U_LOAD_H(lhA1, lhB1, UCL(i + 3))
        {
            int k0 = 0, k1 = 0;
            peer_u_compute(b0, hA0, hB0, in0, c, k0);
            peer_issue(U4, E0, 0, coloff, b0);
            peer_u_compute(b1, hA0, hB0, in0, c, k1);
            peer_issue(U4, E0, 1, coloff, b1);
            U_STORE(i, k0, k1)
        }
        {
            int k0 = 0, k1 = 0;
            peer_u_compute(b2, hA1, hB1, in1, c, k0);
            peer_issue(U4, E1, 0, coloff, b2);
            peer_u_compute(b3, hA1, hB1, in1, c, k1);
            peer_issue(U4, E1, 1, coloff, b3);
            U_STORE(UCL(i + 1), k0, k1)
        }
        U_ROT(E0, hA0, hB0, in0, LE0, lhA0, lhB0)
        U_ROT(E1, hA1, hB1, in1, LE1, lhA1, lhB1)
    }
#undef UTOK
}

DI void phase_peer_act(const Params& p, char* ws, int layer) {
    (void)p;
    const unsigned short* EID = (const unsigned short*)(ws + OFF_R5);
    const unsigned short* GW = EID + (size_t)T_TOK * 128;
    const int* PART = (const int*)(ws + OFF_R3);
    unsigned short* ACT8 = (unsigned short*)(ws + OFF_R2);
    float* AS = (float*)(ws + OFF_AS);
    const float2* SC = (const float2*)(ws + OFF_SC) + (size_t)layer * 16384;
    const float* HS = (const float*)(ws + OFF_HS);
    const int tid = get_tid(), lane = tid & 63, wave = tid >> 6;
    for (int tb = (blockIdx.x * 4 + wave) * 4; tb < T_TOK; tb += gridDim.x * 16) {
        uint2 q[4][4];
        unsigned ew[4], gw[4];
        float hs[4];
#pragma unroll
        for (int u = 0; u < 4; ++u) {
            const size_t i = (size_t)(tb + u) * 128 + 2 * lane;
#pragma unroll
            for (int x = 0; x < 4; ++x) q[u][x] = *(const uint2*)(PART + (size_t)x * T_TOK * 128 + i);
            ew[u] = *(const unsigned*)(EID + i); gw[u] = *(const unsigned*)(GW + i);
            hs[u] = HS[tb + u];
        }
        float2 c0[4], c1[4];
#pragma unroll
        for (int u = 0; u < 4; ++u) { c0[u] = SC[ew[u] & 0xffffu]; c1[u] = SC[ew[u] >> 16]; }
        float a0[4], a1[4], am[4];
#pragma unroll
        for (int u = 0; u < 4; ++u) {
            const int s0 = (int)q[u][0].x + (int)q[u][1].x + (int)q[u][2].x + (int)q[u][3].x;
            const int s1 = (int)q[u][0].y + (int)q[u][1].y + (int)q[u][2].y + (int)q[u][3].y;
            a0[u] = gelu_tanh((float)s0 * c0[u].x * hs[u]) * __uint_as_float(gw[u] << 16) * c0[u].y;
            a1[u] = gelu_tanh((float)s1 * c1[u].x * hs[u]) * __uint_as_float(gw[u] & 0xffff0000u) * c1[u].y;
            am[u] = fmaxf(fabsf(a0[u]), fabsf(a1[u]));
        }
#pragma unroll
        for (int o = 32; o >= 1; o >>= 1) {
#pragma unroll
            for (int u = 0; u < 4; ++u) am[u] = fmaxf(am[u], __shfl_xor(am[u], o));
        }
#pragma unroll
        for (int u = 0; u < 4; ++u) {
            const float qs = (am[u] > 0.f) ? 127.f / am[u] : 0.f;
            const int q0 = __float2int_rn(a0[u] * qs), q1 = __float2int_rn(a1[u] * qs);
            ACT8[(size_t)(tb + u) * 64 + lane] = (unsigned short)(((unsigned)q0 & 0xffu) | (((unsigned)q1 & 0xffu) << 8));
            if (lane == 0) AS[tb + u] = am[u] * (1.f / 127.f);
        }
    }
}

template <bool FIRST>
DI void peer_v_compute(const uint4 (&buf)[4], unsigned a4, int (&out)[32]) {
    unsigned sA = 0x05010400u, sB = 0x07030602u, sC = 0x05040100u, sD = 0x07060302u;
    asm volatile("" : "+s"(sA), "+s"(sB), "+s"(sC), "+s"(sD));
    const unsigned M = 0x0F0F0F0Fu;
    const unsigned r0[4] = {buf[0].x, buf[0].y, buf[0].z, buf[0].w}, r1[4] = {buf[1].x, buf[1].y, buf[1].z, buf[1].w};
    const unsigned r2[4] = {buf[2].x, buf[2].y, buf[2].z, buf[2].w}, r3[4] = {buf[3].x, buf[3].y, buf[3].z, buf[3].w};
#pragma unroll
    for (int d = 0; d < 4; ++d) {
        const unsigned t01l = __builtin_amdgcn_perm(r1[d], r0[d], sA);
        const unsigned t01h = __builtin_amdgcn_perm(r1[d], r0[d], sB);
        const unsigned t23l = __builtin_amdgcn_perm(r3[d], r2[d], sA);
        const unsigned t23h = __builtin_amdgcn_perm(r3[d], r2[d], sB);
        unsigned T[4];
        T[0] = __builtin_amdgcn_perm(t23l, t01l, sC);
        T[1] = __builtin_amdgcn_perm(t23l, t01l, sD);
        T[2] = __builtin_amdgcn_perm(t23h, t01h, sC);
        T[3] = __builtin_amdgcn_perm(t23h, t01h, sD);
#pragma unroll
        for (int m = 0; m < 4; ++m) {
            if (FIRST) {
                asm("v_dot4_i32_i8 %0, %1, %2, 0" : "=v"(out[8 * d + 2 * m]) : "v"(T[m] & M), "v"(a4));
                asm("v_dot4_i32_i8 %0, %1, %2, 0" : "=v"(out[8 * d + 2 * m + 1]) : "v"(T[m]), "v"(a4));
            } else {
                out[8 * d + 2 * m]     = __builtin_amdgcn_sdot4((int)(T[m] & M), (int)a4, out[8 * d + 2 * m], false);
                out[8 * d + 2 * m + 1] = __builtin_amdgcn_sdot4((int)T[m], (int)a4, out[8 * d + 2 * m + 1], false);
            }
        }
    }
    asm volatile("" : "+v"(out[0]), "+v"(out[1]), "+v"(out[2]), "+v"(out[3]), "+v"(out[4]), "+v"(out[5]), "+v"(out[6]), "+v"(out[7]));
    asm volatile("" : "+v"(out[8]), "+v"(out[9]), "+v"(out[10]), "+v"(out[11]), "+v"(out[12]), "+v"(out[13]), "+v"(out[14]), "+v"(out[15]));
    asm volatile("" : "+v"(out[16]), "+v"(out[17]), "+v"(out[18]), "+v"(out[19]), "+v"(out[20]), "+v"(out[21]), "+v"(out[22]), "+v"(out[23]));
    asm volatile("" : "+v"(out[24]), "+v"(out[25]), "+v"(out[26]), "+v"(out[27]), "+v"(out[28]), "+v"(out[29]), "+v"(out[30]), "+v"(out[31]));
}
DI void peer_issue4(const unsigned char* tab, unsigned w_lo, unsigned w_hi, unsigned coloff, uint4 (&buf)[4]) {
    asm volatile("" : "+v"(w_lo), "+v"(w_hi));
    buf[0] = *(const uint4*)(tab + ((w_lo & 0xffffu) * 128u + coloff));
    buf[1] = *(const uint4*)(tab + ((w_lo >> 16) * 128u + coloff));
    buf[2] = *(const uint4*)(tab + ((w_hi & 0xffffu) * 128u + coloff));
    buf[3] = *(const uint4*)(tab + ((w_hi >> 16) * 128u + coloff));
}
DI void peer_v_reduce(const int (&out)[32], int sl, int (&r4)[4]) {
    int r16[16];
#pragma unroll
    for (int k = 0; k < 16; ++k) {
        const auto q = __builtin_amdgcn_permlane32_swap((unsigned)out[k], (unsigned)out[16 + k], false, false);
        r16[k] = (int)q[0] + (int)q[1];
    }
    int r8[8];
#pragma unroll
    for (int k = 0; k < 8; ++k) {
        const auto q = __builtin_amdgcn_permlane16_swap((unsigned)r16[k], (unsigned)r16[8 + k], false, false);
        r8[k] = (int)q[0] + (int)q[1];
    }
#pragma unroll
    for (int k = 0; k < 4; ++k) {
        const int mine = (sl & 1) ? r8[4 + k] : r8[k];
        const int send = (sl & 1) ? r8[k] : r8[4 + k];
        r4[k] = mine + __builtin_amdgcn_mov_dpp(send, 0x128, 0xF, 0xF, true);
    }
}
DI int peer_v_asum(const uint4& a) {
    int sa = __builtin_amdgcn_sdot4((int)a.x, 0x01010101, 0, false);
    sa = __builtin_amdgcn_sdot4((int)a.y, 0x01010101, sa, false);
    sa = __builtin_amdgcn_sdot4((int)a.z, 0x01010101, sa, false);
    sa = __builtin_amdgcn_sdot4((int)a.w, 0x01010101, sa, false);
    { const auto q = __builtin_amdgcn_permlane32_swap((unsigned)sa, (unsigned)sa, false, false); sa = (int)q[0] + (int)q[1]; }
    { const auto q = __builtin_amdgcn_permlane16_swap((unsigned)sa, (unsigned)sa, false, false); sa = (int)q[0] + (int)q[1]; }
    sa += __builtin_amdgcn_mov_dpp(sa, 0x128, 0xF, 0xF, true);
    return sa;
}
template <bool DRY>
DI void phase_peer_v(const Params& p, char* ws, char* smem, int layer) {
    bf16_t* X = (bf16_t*)(ws + OFF_R1);
    bf16_t* XO = DRY ? (bf16_t*)p.out : X;
    const int lj = layer * 2 + 1;
    const float* mods = (const float*)(ws + OFF_MODS) + (size_t)lj * 16 * 3072;
    const unsigned short* EID = (const unsigned short*)(ws + OFF_R5);
    const unsigned char* ACT8 = (const unsigned char*)(ws + OFF_R2);
    const float* AS = (const float*)(ws + OFF_AS);
    const unsigned char* V4 = (const unsigned char*)(ws + OFF_R4) + TAB_V_OFF;
    const int tid = get_tid(), lane = tid & 63;
    const int sl = lane >> 3, c = lane & 7;
    int x, wv, nwv;
    slice_assign4(x, wv, nwv);
    float* Gs = (float*)smem;
    for (int i = tid; i < 16 * 256; i += 256) Gs[i] = mods[(size_t)(i >> 8) * 3072 + 2048 + x * 256 + (i & 255)];
    __syncthreads();
    const unsigned coloff = (unsigned)x * (16384u * 128u) + (unsigned)c * 16u;
    const int n = (T_TOK - wv + nwv - 1) / nwv;
    if (n <= 0) return;
    const int colL = c * 32 + 4 * sl;
    const int col0 = x * 256 + colL;
    uint4 E0[2], E1[2], LE0[2], LE1[2], q0[4], q1[4], q2[4], q3[4];
    uint4 a0, a1, la0, la1;
    float as0, as1, las0, las1;
    u32x2_t x0, x1, lx0, lx1;
#define VTOK(I) ((unsigned)wv + __umul24((unsigned)(I), (unsigned)nwv))
#define VCL(I) ((I) < n ? (I) : n - 1)
#define V_LOAD_E(E, I) { const size_t t_ = VTOK(I); E[0] = nt_load_u4(EID + t_ * 128 + sl * 16); E[1] = nt_load_u4(EID + t_ * 128 + sl * 16 + 8); }
#define V_LOAD_M(A, ASV, XV, I)                                                                                \
    {                                                                                                           \
        const size_t t_ = VTOK(I);                                                                              \
        A = nt_load_u4(ACT8 + t_ * 128 + sl * 16);                                                              \
        ASV = AS[t_];                                                                                           \
        XV = __builtin_nontemporal_load((const u32x2_t*)(X + t_ * 1024 + col0));                                \
    }
#define V_ROT(E, A, ASV, XV, LE, LA, LASV, LXV)                                                                \
    {                                                                                                           \
        asm volatile("" : "+v"(LE[0].x), "+v"(LE[0].y), "+v"(LE[0].z), "+v"(LE[0].w), "+v"(LE[1].x), "+v"(LE[1].y), "+v"(LE[1].z), "+v"(LE[1].w)); \
        asm volatile("" : "+v"(LA.x), "+v"(LA.y), "+v"(LA.z), "+v"(LA.w), "+v"(LASV), "+v"(LXV.x), "+v"(LXV.y)); \
        E[0] = LE[0]; E[1] = LE[1]; A = LA; ASV = LASV; XV = LXV;                                               \
    }
#define V_SECTION(I, E, A, ASV, XV, DOIT)                                                                      \
    {                                                                                                           \
        int out[32];                                                                                            \
        peer_v_compute<true>(q0, A.x, out);                                                                     \
        peer_issue4(V4, E[0].x, E[0].y, coloff, q0);                                                            \
        peer_v_compute<false>(q1, A.y, out);                                                                           \
        peer_issue4(V4, E[0].z, E[0].w, coloff, q1);                                                            \
        peer_v_compute<false>(q2, A.z, out);                                                                           \
        peer_issue4(V4, E[1].x, E[1].y, coloff, q2);                                                            \
        peer_v_compute<false>(q3, A.w, out);                                                                           \
        peer_issue4(V4, E[1].z, E[1].w, coloff, q3);                                                            \
        int r4_[4];                                                                                             \
        peer_v_reduce(out, sl, r4_);                                                                            \
        const float sa_ = (float)peer_v_asum(A);                                                                \
        const unsigned tt_ = VTOK(I);                                                                           \
        const float4 g_ = *(const float4*)(Gs + (tt_ >> 11) * 256 + colL);                                     \
        const float xa_ = __uint_as_float(XV.x << 16), xb_ = __uint_as_float(XV.x & 0xffff0000u);               \
        const float xc_ = __uint_as_float(XV.y << 16), xd_ = __uint_as_float(XV.y & 0xffff0000u);               \
          \
        const float oa_ = xa_ + g_.x * (((float)r4_[0] - 7.5f * sa_) * (ASV));                                  \
        const float ob_ = xb_ + g_.y * (((float)(r4_[1] - r4_[0]) * 0.0625f + 0.5f * sa_) * (ASV));             \
        const float oc_ = xc_ + g_.z * (((float)r4_[2] - 7.5f * sa_) * (ASV));                                  \
        const float od_ = xd_ + g_.w * (((float)(r4_[3] - r4_[2]) * 0.0625f + 0.5f * sa_) * (ASV));             \
        u32x2_t ov__; ov__.x = pack2bf(oa_, ob_); ov__.y = pack2bf(oc_, od_);                                   \
        bf16_t* op__ = (DOIT) ? XO + (size_t)tt_ * 1024 + col0 : (bf16_t*)(ws + OFF_PTRS + 4096) + lane * 4;   \
        __builtin_nontemporal_store(ov__, (u32x2_t*)op__);                                                      \
    }
    V_LOAD_E(E0, 0)
    peer_issue4(V4, E0[0].x, E0[0].y, coloff, q0);
    peer_issue4(V4, E0[0].z, E0[0].w, coloff, q1);
    peer_issue4(V4, E0[1].x, E0[1].y, coloff, q2);
    peer_issue4(V4, E0[1].z, E0[1].w, coloff, q3);
    V_LOAD_E(LE0, VCL(1))
    V_LOAD_M(la0, las0, lx0, 0)
    V_LOAD_E(LE1, VCL(2))
    V_LOAD_M(la1, las1, lx1, VCL(1))
    V_ROT(E0, a0, as0, x0, LE0, la0, las0, lx0)
    V_ROT(E1, a1, as1, x1, LE1, la1, las1, lx1)
#pragma unroll 1
    for (int i = 0; i < n; i += 2) {
        V_LOAD_E(LE0, VCL(i + 3))
        V_LOAD_M(la0, las0, lx0, VCL(i + 2))
        V_LOAD_E(LE1, VCL(i + 4))
        V_LOAD_M(la1, las1, lx1, VCL(i + 3))
        V_SECTION(i, E0, a0, as0, x0, true)
        V_SECTION(VCL(i + 1), E1, a1, as1, x1, (i + 1 < n))
        V_ROT(E0, a0, as0, x0, LE0, la0, las0, lx0)
        V_ROT(E1, a1, as1, x1, LE1, la1, las1, lx1)
    }
#undef VTOK
}

#define AK_LD 72
#define AV_LD 200
#define AP_LD 40
DI void phase_attn(const Params& p, char* ws, char* smem) {
    const bf16_t* Qa = (const bf16_t*)(ws + OFF_R3);
    const bf16_t* Ka = Qa + (size_t)T_TOK * 1024;
    const bf16_t* VT2 = Ka + (size_t)T_TOK * 128;
    bf16_t* ATT = (bf16_t*)(ws + OFF_R4);
    const int tid = get_tid(), lane = tid & 63, wave = tid >> 6;
    const int r = lane & 31, h = lane >> 5;
    bf16_t* Ks = (bf16_t*)smem;
    bf16_t* Vs = (bf16_t*)(smem + 27648);
    float* btab = (float*)(smem + 27648 + 25600);
    bf16_t* Pw = (bf16_t*)(smem + 27648 + 25600 + 4096) + (size_t)wave * 32 * AP_LD;
    for (int unit = blockIdx.x; unit < 1024; unit += gridDim.x) {
        const int kvh = unit & 1, qh = (unit >> 1) & 31, b = unit >> 6;
        const size_t tb = (size_t)b * SEQ;
        const int Qh = qh * 64;
        const int Kb = Qh - 128;
        __syncthreads();
#pragma unroll
        for (int q = 0; q < 6; ++q) {
            const int c = tid + 256 * q, row = c >> 3, ch = c & 7;
            int kpos = Kb + row; if (kpos < 0) kpos = 0;
            *(uint4*)(Ks + row * AK_LD + ch * 8) = *(const uint4*)(Ka + (tb + kpos) * 128 + kvh * 64 + ch * 8);
        }
#pragma unroll
        for (int q = 0; q < 6; ++q) {
            const int c = tid + 256 * q, row = c / 24, ch = c % 24;
            int kpos = Kb + ch * 8; if (kpos < 0) kpos = 0;
            *(uint4*)(Vs + row * AV_LD + ch * 8) = *(const uint4*)(VT2 + ((size_t)b * 128 + kvh * 64 + row) * 2048 + kpos);
        }
        for (int i = tid; i < 8 * 128; i += 256) {
            const int g = i >> 7, n = i & 127;
            int bk = n;
            if (n >= 16) {
                const float lr = logf((float)n / 16.f) / 2.0794415416798357f;
                bk = 16 + (int)(lr * 16.f);
                if (bk > 31) bk = 31;
            }
            btab[i] = p.rel_bias[bk * 16 + kvh * 8 + g];
        }
        __syncthreads();
        for (int sub = 0; sub < 4; ++sub) {
            const int g = wave * 2 + (sub >> 1), qs = sub & 1;
            const int hq = kvh * 8 + g;
            const int Q0 = Qh + qs * 32;
            const int K0 = Q0 - 128;
            const int kl0 = K0 - Kb;
            f32x16 sacc[5];
            zero_acc<5>(sacc);
            {
                const bf16_t* Bq = Qa + (tb + Q0 + r) * 1024 + hq * 64 + h * 8;
                bf16x8 bq[4];
#pragma unroll
                for (int ks = 0; ks < 4; ++ks) bq[ks] = *(const bf16x8*)(Bq + ks * 16);
#pragma unroll
                for (int ks = 0; ks < 4; ++ks)
#pragma unroll
                    for (int kt = 0; kt < 5; ++kt)
                        sacc[kt] = MFMA32(*(const bf16x8*)(Ks + (kl0 + kt * 32 + r) * AK_LD + ks * 16 + h * 8), bq[ks], sacc[kt]);
            }
            const float sink = p.sinks[hq];
            float mx = sink;
#pragma unroll
            for (int kt = 0; kt < 5; ++kt)
#pragma unroll
                for (int i = 0; i < 16; ++i) {
                    const int kpos = K0 + kt * 32 + crow(i, h);
                    const int dist = Q0 + r - kpos;
                    float lg = NEG_INF_F;
                    if (dist >= 0 && dist < 128 && kpos >= 0) lg = sacc[kt][i] * 0.125f + btab[g * 128 + dist];
                    sacc[kt][i] = lg;
                    mx = fmaxf(mx, lg);
                }
            mx = fmaxf(mx, __shfl_xor(mx, 32));
            float sum = 0.f;
#pragma unroll
            for (int kt = 0; kt < 5; ++kt)
#pragma unroll
                for (int i = 0; i < 16; ++i) {
                    const float e = (sacc[kt][i] > -1e29f) ? __expf(sacc[kt][i] - mx) : 0.f;
                    sacc[kt][i] = e;
                    sum += e;
                }
            sum += __shfl_xor(sum, 32);
            sum += __expf(sink - mx);
            const float inv = 1.f / sum;
            f32x16 oacc[2];
            zero_acc<2>(oacc);
#pragma unroll
            for (int kt = 0; kt < 5; ++kt) {
#pragma unroll
                for (int q4 = 0; q4 < 4; ++q4) {
                    uint2 o;
                    o.x = pack2bf(sacc[kt][q4 * 4 + 0] * inv, sacc[kt][q4 * 4 + 1] * inv);
                    o.y = pack2bf(sacc[kt][q4 * 4 + 2] * inv, sacc[kt][q4 * 4 + 3] * inv);
                    *(uint2*)(Pw + r * AP_LD + q4 * 8 + h * 4) = o;
                }
#pragma unroll
                for (int ks = 0; ks < 2; ++ks) {
                    const bf16x8 ap = *(const bf16x8*)(Pw + r * AP_LD + ks * 16 + h * 8);
#pragma unroll
                    for (int nt = 0; nt < 2; ++nt)
                        oacc[nt] = MFMA32(ap, *(const bf16x8*)(Vs + (nt * 32 + r) * AV_LD + kl0 + kt * 32 + ks * 16 + h * 8), oacc[nt]);
                }
            }
            {
                bf16_t* ab = ATT + (tb + Q0 + 4 * h) * 1024 + hq * 64 + r;
#pragma unroll
                for (int i4 = 0; i4 < 4; ++i4) {
                    bf16_t* a2 = ab + (size_t)i4 * 8 * 1024;
                    LAUNDER(a2);
#pragma unroll
                    for (int ii = 0; ii < 4; ++ii)
#pragma unroll
                        for (int nt = 0; nt < 2; ++nt) a2[ii * 1024 + nt * 32] = f2bf(oacc[nt][i4 * 4 + ii]);
                }
            }
        }
    }
    __syncthreads();
}

DI void phase_final(const Params& p, const bf16_t* __restrict__ X) {
    const int tid = get_tid(), lane = tid & 63, wave = tid >> 6;
    for (int t = blockIdx.x * 4 + wave; t < T_TOK; t += gridDim.x * 4) {
        float xv[16];
        float ss = 0.f;
#pragma unroll
        for (int i = 0; i < 4; ++i) {
            const uint2 q = *(const uint2*)(X + (size_t)t * 1024 + i * 256 + lane * 4);
            const float4 v = make_float4(__uint_as_float(q.x << 16), __uint_as_float(q.x & 0xffff0000u), __uint_as_float(q.y << 16), __uint_as_float(q.y & 0xffff0000u));
            xv[i * 4 + 0] = v.x; xv[i * 4 + 1] = v.y; xv[i * 4 + 2] = v.z; xv[i * 4 + 3] = v.w;
            ss += v.x * v.x + v.y * v.y + v.z * v.z + v.w * v.w;
        }
        ss = wave_sum(ss);
        const float rinv = rsqrtf(ss * (1.f / 1024.f) + 1e-6f);
#pragma unroll
        for (int i = 0; i < 4; ++i) {
            const int col = i * 256 + lane * 4;
            const float4 g4 = *(const float4*)(p.final_g + col);
            float4 o;
            o.x = xv[i * 4 + 0] * rinv * g4.x; o.y = xv[i * 4 + 1] * rinv * g4.y;
            o.z = xv[i * 4 + 2] * rinv * g4.z; o.w = xv[i * 4 + 3] * rinv * g4.w;
            *(float4*)(p.out + (size_t)t * 1024 + col) = o;
        }
    }
}

#define NPHASES 25
template <int PH>
DI void run_phase(const Params& pk, char* smem) {
    typedef __attribute__((address_space(1))) char gchar_t;
    gchar_t* wsg = (gchar_t*)pk.ws;
    asm volatile("" : "+s"(wsg));
    char* ws = (char*)wsg;
    Params p;
    if (PH == 0) {
        p = pk;
        if (threadIdx.x < 29) {
            const void* v = pk.x;
            switch (threadIdx.x) {
                case 0: v = pk.x; break; case 1: v = pk.c; break; case 2: v = pk.ada_w; break; case 3: v = pk.ada_b; break;
                case 4: v = pk.norm_g; break; case 5: v = pk.w_in; break; case 6: v = pk.b_if; break; case 7: v = pk.conv_w; break;
                case 8: v = pk.conv_b; break; case 9: v = pk.w_q; break; case 10: v = pk.w_k; break; case 11: v = pk.head_g; break;
                case 12: v = pk.skip; break; case 13: v = pk.pool_w; break; case 14: v = pk.pool_scale; break; case 15: v = pk.w_out; break;
                case 16: v = pk.w_qkv; break; case 17: v = pk.b_qkv; break; case 18: v = pk.sinks; break; case 19: v = pk.w_o; break;
                case 20: v = pk.b_o; break; case 21: v = pk.rel_bias; break; case 22: v = pk.peer_wq; break; case 23: v = pk.peer_keys; break;
                case 24: v = pk.peer_u; break; case 25: v = pk.peer_v; break; case 26: v = pk.final_g; break; case 27: v = pk.out; break;
                default: v = pk.ws; break;
            }
            ((const void**)(ws + OFF_PTRS))[threadIdx.x] = v;
        }
    } else {
        const float* const* tab = (const float* const*)(ws + OFF_PTRS);
        p.x = tab[0]; p.c = tab[1]; p.ada_w = tab[2]; p.ada_b = tab[3]; p.norm_g = tab[4]; p.w_in = tab[5]; p.b_if = tab[6]; p.conv_w = tab[7];
        p.conv_b = tab[8]; p.w_q = tab[9]; p.w_k = tab[10]; p.head_g = tab[11]; p.skip = tab[12]; p.pool_w = tab[13]; p.pool_scale = tab[14];
        p.w_out = tab[15]; p.w_qkv = tab[16]; p.b_qkv = tab[17]; p.sinks = tab[18]; p.w_o = tab[19]; p.b_o = tab[20]; p.rel_bias = tab[21];
        p.peer_wq = tab[22]; p.peer_keys = tab[23]; p.peer_u = tab[24]; p.peer_v = tab[25]; p.final_g = tab[26]; p.out = (float*)tab[27]; p.ws = ws;
    }
    bf16_t* X = (bf16_t*)(ws + OFF_R1);
    const float* mods = (const float*)(ws + OFF_MODS);
    if (PH == 0) phase_pre_mods(p, ws, smem);
    else if (PH == 1) { phase_adanorm<true, true, false>(p, ws, p.x, 0, smem); phase_pre_weights(p, ws, smem); }
    else if (PH == 2) { GemmArgs ga{}; ga.A = (const bf16_t*)(ws + OFF_R5 + 16ull * MiB); ga.Bt = (const bf16_t*)(ws + OFF_WINT); ga.N = 2048; ga.hs = (const float*)(ws + OFF_HS); ga.wsc = (const float*)(ws + OFF_WSC); phase_gemm<GM_INPROJ, true>(p, ws, ga, smem); }
    else if (PH == 3) {   }
    else if (PH == 4) phase_m1b(p, ws, smem);
    else if (PH == 5) phase_m2(p, ws);
    else if (PH == 6) phase_m3(p, ws, smem);
    else if (PH == 7) {
        GemmArgs ga{}; ga.A = (const bf16_t*)(ws + OFF_R4); ga.Bt = (const bf16_t*)(ws + OFF_WOUTT); ga.N = 1024;
        ga.xin = p.x; ga.xout = X; ga.gate = mods + (size_t)0 * 16 * 3072 + 2048; ga.bias = nullptr;
        phase_gemm<GM_RESID, false>(p, ws, ga, smem);
    }
    else if (PH == 8) phase_adanorm<false, true, true>(p, ws, X, 1, smem);
    else if (PH == 9) { GemmArgs ga{}; ga.A = (const bf16_t*)(ws + OFF_R5 + 16ull * MiB); ga.Bt = (const bf16_t*)(ws + OFF_WPQT); ga.N = 2048; ga.out = (bf16_t*)(ws + OFF_R3); ga.hs = (const float*)(ws + OFF_HS); ga.wsc = (const float*)(ws + OFF_WSC) + 3328; phase_gemm<GM_PLAIN, true>(p, ws, ga, smem); }
    else if (PH == 10) phase_topk(p, ws, 0, smem);
    else if (PH == 11) phase_peer_u(p, ws, 0);
    else if (PH == 12) phase_peer_act(p, ws, 0);
    else if (PH == 13) phase_peer_v<false>(p, ws, smem, 0);
    else if (PH == 14) phase_adanorm<false, true, true>(p, ws, X, 2, smem);
    else if (PH == 15) { GemmArgs ga{}; ga.A = (const bf16_t*)(ws + OFF_R5 + 16ull * MiB); ga.Bt = (const bf16_t*)(ws + OFF_WQKVT); ga.N = 1280; ga.hs = (const float*)(ws + OFF_HS); ga.wsc = (const float*)(ws + OFF_WSC) + 2048; phase_gemm<GM_QKV, true>(p, ws, ga, smem); }
    else if (PH == 16) phase_attn(p, ws, smem);
    else if (PH == 17 || PH == 27) {
        GemmArgs ga{}; ga.A = (const bf16_t*)(ws + OFF_R4); ga.Bt = (const bf16_t*)(ws + OFF_WOT); ga.N = 1024;
        ga.xin = X; ga.xout = (PH == 27) ? (bf16_t*)p.out : X; ga.gate = mods + (size_t)2 * 16 * 3072 + 2048; ga.bias = p.b_o;
        phase_gemm<GM_RESID_BF, false>(p, ws, ga, smem);
    }
    else if (PH == 18) phase_adanorm<false, true, true>(p, ws, X, 3, smem);
    else if (PH == 19) { GemmArgs ga{}; ga.A = (const bf16_t*)(ws + OFF_R5 + 16ull * MiB); ga.Bt = (const bf16_t*)(ws + OFF_WPQT + (size_t)2048 * 1024); ga.N = 2048; ga.out = (bf16_t*)(ws + OFF_R3); ga.hs = (const float*)(ws + OFF_HS); ga.wsc = (const float*)(ws + OFF_WSC) + 5376; phase_gemm<GM_PLAIN, true>(p, ws, ga, smem); }
    else if (PH == 20) phase_topk(p, ws, 1, smem);
    else if (PH == 21) phase_peer_u(p, ws, 1);
    else if (PH == 22) phase_peer_act(p, ws, 1);
    else if (PH == 23) phase_peer_v<false>(p, ws, smem, 1);
    else if (PH == 24) phase_final(p, X);
    else if (PH == 25) phase_peer_v<true>(p, ws, smem, 0);
    else if (PH == 26) phase_peer_v<true>(p, ws, smem, 1);
}

extern __shared__ __attribute__((aligned(16))) char dyn_smem[];

#define LDS_GEMM 73728
#define LDS_BYTES (LDS_GEMM + 16)

#if !ONE_LAUNCH
template <int PH>
__global__ void __launch_bounds__(256, 2) k_phase(Params p) { run_phase<PH>(p, dyn_smem); }

template <int PH>
static void launch_phase(const Params& p, int grid, hipStream_t stream) {
    (void)hipFuncSetAttribute((const void*)k_phase<PH>, hipFuncAttributeMaxDynamicSharedMemorySize, LDS_BYTES);
    hipLaunchKernelGGL(k_phase<PH>, dim3(grid), dim3(256), LDS_BYTES, stream, p);
}
template <int PH>
static void launch_all(const Params& p, int grid, hipStream_t stream) {
    launch_phase<PH>(p, grid, stream);
    if constexpr (PH + 1 < NPHASES) launch_all<PH + 1>(p, grid, stream);
}
#else
template <int PH>
DI void fused_from(const Params& p, volatile LAS unsigned* st) {
    run_phase<PH>(p, dyn_smem);
    if ((PROBE_MASK >> PH) & 1u) run_phase<(PH == 13) ? 25 : (PH == 23) ? 26 : (PH == 17) ? 27 : PH>(p, dyn_smem);
    if constexpr (PH + 1 < NPHASES && PH != 3) {
        { XcdBarrier bar_; bar_.bar = (unsigned*)(p.ws + OFF_BAR); bar_.x = xb_xcc_id(); bar_.st = st; xcd_barrier(bar_); }
        fused_from<PH + 1>(p, st);
    } else if constexpr (PH + 1 < NPHASES) {
        fused_from<PH + 1>(p, st);
    }
}
__global__ void __launch_bounds__(256, 2) k_fused(Params p) {
    volatile LAS unsigned* st = (volatile LAS unsigned*)(dyn_smem + LDS_GEMM);
    if (threadIdx.x == 0) { st[0] = 0u; st[1] = 0u; st[2] = 0u; st[3] = 0u; }
    __syncthreads();
    (void)xcd_barrier_post((unsigned*)(p.ws + OFF_BAR), st);
    fused_from<0>(p, st);
}
#endif

extern "C" void kernel_launch(void* const* d_in, const int* in_sizes, int n_in, void* d_out, int out_size, void* d_ws, size_t ws_size,
                              hipStream_t stream) {
    (void)in_sizes; (void)n_in; (void)out_size;
    Params p{};
    const float** pp = (const float**)&p;
    for (int i = 0; i < 27; ++i) pp[i] = (const float*)d_in[i];
    p.out = (float*)d_out;
    p.ws = (char*)d_ws;
    if (ws_size < WS_NEEDED) fprintf(stderr, "workspace too small: %zu < %llu\n", ws_size, (unsigned long long)WS_NEEDED);
#if !ONE_LAUNCH
    const int grid = 512;
    launch_all<0>(p, grid, stream);
#else
    static int grid = 0;
    if (!grid) {
        int dev = 0, cus = 0, per_cu = 0;
        (void)hipGetDevice(&dev);
        (void)hipDeviceGetAttribute(&cus, hipDeviceAttributeMultiprocessorCount, dev);
        (void)hipFuncSetAttribute((const void*)k_fused, hipFuncAttributeMaxDynamicSharedMemorySize, LDS_BYTES);
        (void)hipOccupancyMaxActiveBlocksPerMultiprocessor(&per_cu, (const void*)k_fused, 256, LDS_BYTES);
        if (per_cu < 1) per_cu = 1;
        if (cus < 1) cus = 256;
        grid = cus * (per_cu < 2 ? per_cu : 2);
    }
    (void)hipMemsetAsync(d_ws, 0, XCD_BAR_WORDS * sizeof(unsigned), stream);
    hipLaunchKernelGGL(k_fused, dim3(grid), dim3(256), LDS_BYTES, stream, p);
#endif
}
```

```cpp
#include <hip/hip_runtime.h>
#include <stdint.h>
#include <stdio.h>

#ifndef ONE_LAUNCH
#define ONE_LAUNCH 1
#endif
#ifndef PROBE_MASK
#define PROBE_MASK 0u
#endif

#define DI __device__ __forceinline__
typedef unsigned short bf16_t;
typedef __attribute__((ext_vector_type(8))) short bf16x8;
typedef __attribute__((ext_vector_type(16))) float f32x16;
typedef unsigned u32x4_t __attribute__((ext_vector_type(4)));
typedef float f32x4n_t __attribute__((ext_vector_type(4)));
typedef unsigned u32x2_t __attribute__((ext_vector_type(2)));
#define MFMA32(a, b, c) __builtin_amdgcn_mfma_f32_32x32x16_bf16((a), (b), (c), 0, 0, 0)

#define T_TOK 32768
#define SEQ 2048
#define NBATCH 16
#define DM 1024
#define NEG_INF_F (-1e30f)

#define MiB (1024ull * 1024ull)
#define OFF_BAR     0ull
#define OFF_MODS    (16ull * 1024)
#define OFF_WGT     (1ull * MiB)
#define OFF_IPRE    (OFF_WGT + 64ull * 1024)
#define OFF_LOGF    (OFF_IPRE + 512ull * 1024)
#define OFF_G       (OFF_LOGF + 512ull * 1024)
#define OFF_BV      (OFF_G + 512ull * 1024)
#define OFF_USC     (OFF_BV + 512ull * 1024)
#define OFF_ND      (OFF_USC + 64ull * 1024)
#define OFF_NIN     (OFF_ND + 512ull * 1024)
#define OFF_HS      (27ull * MiB)
#define OFF_PTRS    (27ull * MiB + 512ull * 1024)
#define OFF_AS      (27ull * MiB + 256ull * 1024)
#define OFF_WSC     (27ull * MiB + 768ull * 1024)
#define OFF_SC      (26ull * MiB)
#define OFF_WINT    (4ull * MiB)
#define OFF_WOUTT   (8ull * MiB)
#define OFF_WQKVT   (10ull * MiB)
#define OFF_WOT     (13ull * MiB)
#define OFF_WPQT    (15ull * MiB)
#define OFF_WQT     (23ull * MiB)
#define OFF_WKT     (OFF_WQT + 128ull * 1024)
#define OFF_PWT     (OFF_WKT + 128ull * 1024)
#define OFF_KEYS    (24ull * MiB)
#define OFF_R1      (32ull * MiB)
#define OFF_M       (OFF_R1 + 64ull * MiB)
#define OFF_R2      (160ull * MiB)
#define OFF_R3      (224ull * MiB)
#define OFF_R4      (352ull * MiB)
#define OFF_R5      (416ull * MiB)
#define WS_NEEDED   (512ull * MiB)

struct Params {
    const float *x, *c, *ada_w, *ada_b, *norm_g, *w_in, *b_if, *conv_w, *conv_b, *w_q, *w_k, *head_g, *skip, *pool_w,
        *pool_scale, *w_out, *w_qkv, *b_qkv, *sinks, *w_o, *b_o, *rel_bias, *peer_wq, *peer_keys, *peer_u, *peer_v, *final_g;
    float* out;
    char* ws;
};


#define XB_TMO      128
#define XB_XCNT(j)  (256  + 64 * (j))
#define XB_XSUB(j)  (1280 + 64 * (j))
#define XB_XGEN(j)  (2304 + 64 * (j))
#define XB_TOP      3328
#define XB_TOPGEN   3392
#define XCD_BAR_WORDS 3456
#define XB_SPIN_CAP (1u << 18)
#define LAS __attribute__((address_space(3)))

__device__ __forceinline__ unsigned xb_ld(unsigned* p)              { return __hip_atomic_load(p, __ATOMIC_RELAXED, __HIP_MEMORY_SCOPE_AGENT); }
__device__ __forceinline__ unsigned xb_add(unsigned* p, unsigned v) { return __hip_atomic_fetch_add(p, v, __ATOMIC_RELAXED, __HIP_MEMORY_SCOPE_AGENT); }
__device__ __forceinline__ unsigned xb_xcc_id() { return (unsigned)__builtin_amdgcn_s_getreg((3 << 11) | 20) & 0xFu; }
#define XB_SPIN(cond, bar) do { unsigned _sp = 0; while (cond) { __builtin_amdgcn_s_sleep(1); \
    if ((++_sp & 255u) == 0u) { if (xb_ld(&(bar)[XB_TMO])) break; if (_sp > XB_SPIN_CAP) { atomicAdd(&(bar)[XB_TMO], 1u); break; } } } } while (0)

struct XcdBarrier {
    unsigned* bar; unsigned x;
    volatile LAS unsigned* st;
};

__device__ __forceinline__ XcdBarrier xcd_barrier_post(unsigned* bar, volatile LAS unsigned* st) {
    XcdBarrier b; b.bar = bar; b.x = xb_xcc_id(); b.st = st;
    if (threadIdx.x == 0) (void)xb_add(&bar[XB_XCNT(b.x)], 1u);
    return b;
}
__device__ __forceinline__ void xcd_barrier_complete(unsigned* bar, unsigned x, unsigned& nloc, unsigned& nx) {
    const unsigned G = gridDim.x * gridDim.y * gridDim.z;
    unsigned sum, cnt, mine, sp = 0u;
    for (;;) {
        sum = 0u; cnt = 0u; mine = 0u;
#pragma unroll
        for (unsigned j = 0; j < 16; ++j) { const unsigned c = xb_ld(&bar[XB_XCNT(j)]); sum += c; cnt += (c > 0u) ? 1u : 0u; mine = (j == x) ? c : mine; }
        if (sum == G) break;
        __builtin_amdgcn_s_sleep(1);
        if ((++sp & 255u) == 0u) { if (xb_ld(&bar[XB_TMO])) break; if (sp > XB_SPIN_CAP) { atomicAdd(&bar[XB_TMO], 1u); break; } }
    }
    nloc = mine > 0u ? mine : 1u; nx = cnt > 0u ? cnt : 1u;
}
__device__ __forceinline__ void xcd_barrier(const XcdBarrier& b) {
    asm volatile("s_waitcnt vmcnt(0)" ::: "memory");
    __syncthreads();
    if (threadIdx.x == 0) {
        unsigned* bar = b.bar;
        __builtin_amdgcn_s_waitcnt(0);
        unsigned nloc = b.st[0], nx = b.st[1];
        if (nloc == 0u) { xcd_barrier_complete(bar, b.x, nloc, nx); b.st[0] = nloc; b.st[1] = nx; }
        const unsigned old = xb_add(&bar[XB_XSUB(b.x)], 1u);
        const unsigned gen = old / nloc;
        if (old + 1u == (gen + 1u) * nloc) {
            __builtin_amdgcn_fence(__ATOMIC_RELEASE, "agent");
            asm volatile("s_waitcnt vmcnt(0)" ::: "memory");
            const unsigned og = xb_add(&bar[XB_TOP], 1u);
            const unsigned tg = og / nx;
            if (og + 1u == (tg + 1u) * nx) xb_add(&bar[XB_TOPGEN], 1u);
            else XB_SPIN(xb_ld(&bar[XB_TOPGEN]) == tg, bar);
            __builtin_amdgcn_fence(__ATOMIC_ACQUIRE, "agent");
            xb_add(&bar[XB_XGEN(b.x)], 1u);
            asm volatile("s_waitcnt vmcnt(0)" ::: "memory");
        } else {
            XB_SPIN(xb_ld(&bar[XB_XGEN(b.x)]) == gen, bar);
            __builtin_amdgcn_fence(__ATOMIC_ACQUIRE, "agent");
            asm volatile("s_waitcnt vmcnt(0)" ::: "memory");
        }
    }
    __syncthreads();
}

DI bf16_t f2bf(float x) {
    unsigned u = __float_as_uint(x);
    u += 0x7fffu + ((u >> 16) & 1u);
    return (bf16_t)(u >> 16);
}
DI float bf2f(bf16_t h) { return __uint_as_float(((unsigned)h) << 16); }
DI unsigned pack2bf(float a, float b) { return (unsigned)f2bf(a) | ((unsigned)f2bf(b) << 16); }
DI int get_tid() { int t = (int)threadIdx.x; asm volatile("" : "+v"(t)); return t; }
DI int crow(int i, int h) { return (i & 3) + 8 * (i >> 2) + 4 * h; }
DI float wave_sum(float v) {
#pragma unroll
    for (int o = 32; o >= 1; o >>= 1) v += __shfl_xor(v, o);
    return v;
}
DI float wave_sum_dpp(float v) {
    v += __int_as_float(__builtin_amdgcn_mov_dpp(__float_as_int(v), 0xB1, 0xF, 0xF, true));
    v += __int_as_float(__builtin_amdgcn_mov_dpp(__float_as_int(v), 0x4E, 0xF, 0xF, true));
    v += __int_as_float(__builtin_amdgcn_mov_dpp(__float_as_int(v), 0x141, 0xF, 0xF, true));
    v += __int_as_float(__builtin_amdgcn_mov_dpp(__float_as_int(v), 0x140, 0xF, 0xF, true));
    return __int_as_float(__builtin_amdgcn_readlane(__float_as_int(v), 0)) + __int_as_float(__builtin_amdgcn_readlane(__float_as_int(v), 16)) +
           __int_as_float(__builtin_amdgcn_readlane(__float_as_int(v), 32)) + __int_as_float(__builtin_amdgcn_readlane(__float_as_int(v), 48));
}
DI float half_sum(float v) {
#pragma unroll
    for (int o = 16; o >= 1; o >>= 1) v += __shfl_xor(v, o);
    return v;
}
DI float half_max(float v) {
#pragma unroll
    for (int o = 16; o >= 1; o >>= 1) v = fmaxf(v, __shfl_xor(v, o));
    return v;
}
DI unsigned half_umax(unsigned v) {
#pragma unroll
    for (int o = 16; o >= 1; o >>= 1) { unsigned t = (unsigned)__shfl_xor((int)v, o); v = v > t ? v : t; }
    return v;
}
DI float sigmoidf_(float x) { return 1.f / (1.f + __expf(-x)); }
DI float siluf_(float x) { return x * sigmoidf_(x); }
DI float gelu_tanh(float x) {
    const float k0 = 0.7978845608028654f, k1 = 0.044715f;
    float u = k0 * (x + k1 * x * x * x);
    float t = 1.f - 2.f / (1.f + __expf(2.f * u));
    return 0.5f * x * (1.f + t);
}
DI float logsigmoidf_(float x) { return fminf(x, 0.f) - log1pf(__expf(-fabsf(x))); }

template <int N> DI void zero_acc(f32x16 (&acc)[N]) {
#pragma unroll
    for (int n = 0; n < N; ++n)
#pragma unroll
        for (int i = 0; i < 16; ++i) acc[n][i] = 0.f;
}

template <int NT, int KSTEPS, typename PA, typename PB>
DI void wave_mma(f32x16 (&acc)[NT], PA A, int lda, PB B, int ldb, int lane) {
    const int r = lane & 31, h = lane >> 5;
    bf16x8 a0, b0[NT], a1, b1[NT];
    a0 = *(const bf16x8*)(A + (size_t)r * lda + h * 8);
#pragma unroll
    for (int nt = 0; nt < NT; ++nt) b0[nt] = *(const bf16x8*)(B + (size_t)(nt * 32 + r) * ldb + h * 8);
#pragma unroll
    for (int ks = 0; ks < KSTEPS; ks += 2) {
        if (ks + 1 < KSTEPS) {
            a1 = *(const bf16x8*)(A + (size_t)r * lda + (ks + 1) * 16 + h * 8);
#pragma unroll
            for (int nt = 0; nt < NT; ++nt) b1[nt] = *(const bf16x8*)(B + (size_t)(nt * 32 + r) * ldb + (ks + 1) * 16 + h * 8);
        }
        asm volatile("" ::: "memory");
#pragma unroll
        for (int nt = 0; nt < NT; ++nt) acc[nt] = MFMA32(a0, b0[nt], acc[nt]);
        if (ks + 1 < KSTEPS) {
            if (ks + 2 < KSTEPS) {
                a0 = *(const bf16x8*)(A + (size_t)r * lda + (ks + 2) * 16 + h * 8);
#pragma unroll
                for (int nt = 0; nt < NT; ++nt) b0[nt] = *(const bf16x8*)(B + (size_t)(nt * 32 + r) * ldb + (ks + 2) * 16 + h * 8);
            }
            asm volatile("" ::: "memory");
#pragma unroll
            for (int nt = 0; nt < NT; ++nt) acc[nt] = MFMA32(a1, b1[nt], acc[nt]);
        }
    }
}

DI void phase_pre_mods(const Params& p, char* ws, char* smem) {
    float* cond = (float*)smem;
    float* mods = (float*)(ws + OFF_MODS);
    const int tid = get_tid();
    for (int unit = blockIdx.x; unit < 384; unit += gridDim.x) {
        const int lj = unit / 96, n0 = (unit % 96) * 32;
        __syncthreads();
        for (int i = tid; i < 16 * 1024; i += 256) cond[i] = siluf_(p.c[i]);
        __syncthreads();
        const int ksl = tid >> 5, col = tid & 31;
        const float* W = p.ada_w + (size_t)lj * 1024 * 3072 + n0 + col;
        float acc[16];
#pragma unroll
        for (int b = 0; b < 16; ++b) acc[b] = 0.f;
        for (int kk0 = 0; kk0 < 128; kk0 += 16) {
            float wv_[16];
#pragma unroll
            for (int q = 0; q < 16; ++q) wv_[q] = W[(size_t)(ksl * 128 + kk0 + q) * 3072];
#pragma unroll
            for (int q = 0; q < 16; ++q) {
                const int k = ksl * 128 + kk0 + q;
#pragma unroll
                for (int b = 0; b < 16; ++b) acc[b] += cond[b * 1024 + k] * wv_[q];
            }
        }
        __syncthreads();
        float* red = (float*)smem;
#pragma unroll
        for (int b = 0; b < 16; ++b) red[(ksl * 16 + b) * 32 + col] = acc[b];
        __syncthreads();
        for (int o = tid; o < 512; o += 256) {
            const int b = o >> 5, cc = o & 31;
            float s = 0.f;
#pragma unroll
            for (int q = 0; q < 8; ++q) s += red[(q * 16 + b) * 32 + cc];
            mods[((size_t)lj * 16 + b) * 3072 + n0 + cc] = s + p.ada_b[(size_t)lj * 3072 + n0 + cc];
        }
    }
    __syncthreads();
}

DI void transpose_job(const float* __restrict__ src, int ldsrc, int K, int N, bf16_t* __restrict__ dst, const float* nscale, float cscale,
                      int tile, float* tl) {
    const int tiles_n = N / 32;
    const int tk = tile / tiles_n, tn = tile % tiles_n;
    const int tid_ = get_tid();
    const int tx = tid_ & 31, ty = tid_ >> 5;
    __syncthreads();
#pragma unroll
    for (int q = 0; q < 4; ++q) {
        const int k = tk * 32 + ty + q * 8;
        tl[(ty + q * 8) * 33 + tx] = src[(size_t)k * ldsrc + tn * 32 + tx];
    }
    __syncthreads();
#pragma unroll
    for (int q = 0; q < 4; ++q) {
        const int n = tn * 32 + ty + q * 8;
        float v = tl[tx * 33 + ty + q * 8] * cscale;
        if (nscale) v *= nscale[n];
        dst[(size_t)n * K + tk * 32 + tx] = f2bf(v);
    }
}

DI void quant_job(const float* __restrict__ src, int ldsrc, unsigned char* __restrict__ dst, float* __restrict__ wsc, int n0, float* red) {
    const int tid = get_tid(), tx = tid & 31, ty = tid >> 5;
    const float* col = src + n0 + tx;
    float am = 0.f;
    for (int k = ty; k < 1024; k += 8) am = fmaxf(am, fabsf(col[(size_t)k * ldsrc]));
    __syncthreads();
    red[ty * 32 + tx] = am;
    __syncthreads();
#pragma unroll
    for (int q = 0; q < 8; ++q) am = fmaxf(am, red[q * 32 + tx]);
    const float sc = (am > 0.f) ? 127.f / am : 0.f;
    if (ty == 0) wsc[n0 + tx] = am * (1.f / 127.f);
    unsigned char* drow = dst + (size_t)(n0 + tx) * 1024 + ty * 128;
    for (int k4 = 0; k4 < 32; k4 += 4) {
        unsigned w[4];
#pragma unroll
        for (int q = 0; q < 4; ++q) {
            const int k = ty * 128 + (k4 + q) * 4;
            const int q0 = __float2int_rn(col[(size_t)(k + 0) * ldsrc] * sc), q1 = __float2int_rn(col[(size_t)(k + 1) * ldsrc] * sc);
            const int q2 = __float2int_rn(col[(size_t)(k + 2) * ldsrc] * sc), q3 = __float2int_rn(col[(size_t)(k + 3) * ldsrc] * sc);
            w[q] = ((unsigned)q0 & 0xffu) | (((unsigned)q1 & 0xffu) << 8) | (((unsigned)q2 & 0xffu) << 16) | (((unsigned)q3 & 0xffu) << 24);
        }
        *(uint4*)(drow + k4 * 4) = make_uint4(w[0], w[1], w[2], w[3]);
    }
}
DI void phase_pre_weights(const Params& p, char* ws, char* smem) {
    {
        float* red = (float*)smem;
        float* wsc = (float*)(ws + OFF_WSC);
        for (int j = blockIdx.x; j < 64 + 40 + 64 + 64; j += gridDim.x) {
            if (j < 64) quant_job(p.w_in, 2056, (unsigned char*)(ws + OFF_WINT), wsc, j * 32, red);
            else if (j < 104) quant_job(p.w_qkv, 1280, (unsigned char*)(ws + OFF_WQKVT), wsc + 2048, (j - 64) * 32, red);
            else if (j < 168) quant_job((const float*)(ws + OFF_M), 2048, (unsigned char*)(ws + OFF_WPQT), wsc + 3328, (j - 104) * 32, red);
            else quant_job((const float*)(ws + OFF_M) + (size_t)1024 * 2048, 2048, (unsigned char*)(ws + OFF_WPQT) + (size_t)2048 * 1024, wsc + 5376, (j - 168) * 32, red);
        }
        __syncthreads();
    }
    float* tl = (float*)smem;
    const int J1 = 32 * 32;
    const int J3 = 32 * 32;
    const int J6 = 4 * 16;
    const int J7 = 4 * 16;
    const int J8 = 4 * 16;
    const int total = J1 + J3 + J6 + J7 + J8;
    for (int j = blockIdx.x; j < total; j += gridDim.x) {
        int t = j;
        if (t < J1) { transpose_job(p.w_out, 1024, 1024, 1024, (bf16_t*)(ws + OFF_WOUTT), nullptr, 1.f, t, tl); continue; }
        t -= J1;
        if (t < J3) { transpose_job(p.w_o, 1024, 1024, 1024, (bf16_t*)(ws + OFF_WOT), nullptr, 1.f, t, tl); continue; }
        t -= J3;
        if (t < J6) { const int hh = t / 16; transpose_job(p.w_q + (size_t)hh * 16384, 128, 128, 128, (bf16_t*)(ws + OFF_WQT) + (size_t)hh * 16384, nullptr, 1.f, t % 16, tl); continue; }
        t -= J6;
        if (t < J7) { const int hh = t / 16; transpose_job(p.w_k + (size_t)hh * 16384, 128, 128, 128, (bf16_t*)(ws + OFF_WKT) + (size_t)hh * 16384, nullptr, 0.08838834764831845f, t % 16, tl); continue; }
        t -= J7;
        { const int g = t / 16; transpose_job(p.pool_w + (size_t)g * 16384, 128, 128, 128, (bf16_t*)(ws + OFF_PWT) + (size_t)g * 16384, p.pool_scale + g * 128, 1.f, t % 16, tl); }
    }
    const size_t gtid = (size_t)blockIdx.x * 256 + get_tid(), gsz = (size_t)gridDim.x * 256;
    bf16_t* keys = (bf16_t*)(ws + OFF_KEYS);
    for (size_t i = gtid; i < (size_t)2 * 8 * 2 * 128 * 128; i += gsz) keys[i] = f2bf(p.peer_keys[i]);
    __syncthreads();
}

template <bool GATES, bool WITH_H8, bool XBF>
DI void phase_adanorm(const Params& p, char* ws, const void* __restrict__ Xv, int lj, char* smem) {
    unsigned char* H8 = (unsigned char*)(ws + OFF_R5 + 16ull * MiB);
    const float* mods = (const float*)(ws + OFF_MODS) + (size_t)lj * 16 * 3072;
    const float* ng = p.norm_g + (size_t)lj * 1024;
    const int tid = get_tid(), lane = tid & 63, wave = tid >> 6;
    float* wg = (float*)smem;
    if (GATES) {
        __syncthreads();
        for (int i = tid; i < 8 * 1024; i += 256) { const int k = i >> 3, jn = i & 7; wg[jn * 1024 + k] = p.w_in[(size_t)k * 2056 + 2048 + jn]; }
        __syncthreads();
    }
    for (int unit = blockIdx.x; unit < T_TOK / 64; unit += gridDim.x) {
        const int row0 = unit * 64, b = row0 >> 11;
        float am[16], sh[16];
#pragma unroll
        for (int i = 0; i < 4; ++i) {
            const int col = i * 256 + lane * 4;
            const float4 g4 = *(const float4*)(ng + col);
            const float4 s4 = *(const float4*)(mods + (size_t)b * 3072 + col);
            const float4 c4 = *(const float4*)(mods + (size_t)b * 3072 + 1024 + col);
            am[i * 4 + 0] = g4.x * (1.f + c4.x); am[i * 4 + 1] = g4.y * (1.f + c4.y);
            am[i * 4 + 2] = g4.z * (1.f + c4.z); am[i * 4 + 3] = g4.w * (1.f + c4.w);
            sh[i * 4 + 0] = s4.x; sh[i * 4 + 1] = s4.y; sh[i * 4 + 2] = s4.z; sh[i * 4 + 3] = s4.w;
        }
        for (int rr = wave; rr < 64; rr += 4) {
            const int t = row0 + rr;
            float xv[16];
            float ss = 0.f;
#pragma unroll
            for (int i = 0; i < 4; ++i) {
                float4 v;
                if (XBF) {
                    const uint2 q = *(const uint2*)((const bf16_t*)Xv + (size_t)t * 1024 + i * 256 + lane * 4);
                    v = make_float4(__uint_as_float(q.x << 16), __uint_as_float(q.x & 0xffff0000u), __uint_as_float(q.y << 16), __uint_as_float(q.y & 0xffff0000u));
                } else v = *(const float4*)((const float*)Xv + (size_t)t * 1024 + i * 256 + lane * 4);
                xv[i * 4 + 0] = v.x; xv[i * 4 + 1] = v.y; xv[i * 4 + 2] = v.z; xv[i * 4 + 3] = v.w;
                ss += v.x * v.x + v.y * v.y + v.z * v.z + v.w * v.w;
            }
            ss = wave_sum(ss);
            const float rinv = rsqrtf(ss * (1.f / 1024.f) + 1e-6f);
            float hv[16];
#pragma unroll
            for (int i = 0; i < 16; ++i) hv[i] = xv[i] * rinv * am[i] + sh[i];
            if (WITH_H8) {
                float amx = 0.f;
#pragma unroll
                for (int i = 0; i < 16; ++i) amx = fmaxf(amx, fabsf(hv[i]));
#pragma unroll
                for (int o = 32; o >= 1; o >>= 1) amx = fmaxf(amx, __shfl_xor(amx, o));
                const float qs = (amx > 0.f) ? 127.f / amx : 0.f;
#pragma unroll
                for (int i = 0; i < 4; ++i) {
                    const int q0 = __float2int_rn(hv[i * 4 + 0] * qs), q1 = __float2int_rn(hv[i * 4 + 1] * qs);
                    const int q2 = __float2int_rn(hv[i * 4 + 2] * qs), q3 = __float2int_rn(hv[i * 4 + 3] * qs);
                    const unsigned w8 = ((unsigned)q0 & 0xffu) | (((unsigned)q1 & 0xffu) << 8) | (((unsigned)q2 & 0xffu) << 16) | (((unsigned)q3 & 0xffu) << 24);
                    *(unsigned*)(H8 + (size_t)t * 1024 + i * 256 + lane * 4) = w8;
                }
                if (lane == 0) ((float*)(ws + OFF_HS))[t] = amx * (1.f / 127.f);
            }
            if (GATES) {
                float vi = 0.f, vf = 0.f;
#pragma unroll 1
                for (int j = 0; j < 8; ++j) {
                    float s = 0.f;
#pragma unroll
                    for (int i = 0; i < 4; ++i) {
                        const float4 w4 = *(const float4*)(wg + j * 1024 + i * 256 + lane * 4);
                        s += hv[i * 4 + 0] * w4.x + hv[i * 4 + 1] * w4.y + hv[i * 4 + 2] * w4.z + hv[i * 4 + 3] * w4.w;
                    }
                    s = wave_sum(s);
                    if (lane == (j & 3)) { if (j < 4) vi = s; else vf = s; }
                }
                if (lane < 4) {
                    float* ipre = (float*)(ws + OFF_IPRE);
                    float* logf_ = (float*)(ws + OFF_LOGF);
                    ipre[(size_t)t * 4 + lane] = vi + p.b_if[lane];
                    logf_[(size_t)t * 4 + lane] = logsigmoidf_(vf + p.b_if[4 + lane]);
                }
            }
        }
    }
}

#define GM_INPROJ 0
#define GM_RESID  1
#define GM_RESID_BF 4
#define GM_PLAIN  2
#define GM_QKV    3
#define LDS_ROW 72

struct GemmArgs {
    const bf16_t* A; const bf16_t* Bt; int N;
    const float* hs; const float* wsc;
    const void* xin; bf16_t* xout; const float* gate; const float* bias;
    bf16_t* out;
};

#define CT_LD 132
typedef __attribute__((address_space(1))) char gch_t;
#define LAUNDER(ptr) do { gch_t* _g = (gch_t*)(ptr); asm volatile("" : "+v"(_g)); (ptr) = (decltype(ptr))(char*)_g; } while (0)
template <int MODE>
DI void gemm_epilogue(const Params& p, char* ws, const GemmArgs& ga, const f32x16 (&acc)[2][2], int m0, int n0, int tn, int wm, int wn, int tid, bool swapped, float* Ct, const f32x4n_t (&xi)[16]) {
    const int lane = tid & 63, r = lane & 31, h = lane >> 5;
    {
#pragma unroll
        for (int mt = 0; mt < 2; ++mt)
#pragma unroll
            for (int nt = 0; nt < 2; ++nt) {
                float* dst = Ct + (wm * 64 + mt * 32 + 4 * h) * CT_LD + wn * 64 + nt * 32 + r;
#pragma unroll
                for (int i = 0; i < 16; ++i) dst[((i & 3) + 8 * (i >> 2)) * CT_LD] = acc[mt][nt][i];
            }
    }
    __syncthreads();
    if (MODE == GM_RESID || MODE == GM_RESID_BF) {
        const int c4 = tid & 31, rr = tid >> 5;
        const int n = n0 + c4 * 4, b = m0 >> 11;
        const float4 g4 = *(const float4*)(ga.gate + (size_t)b * 3072 + n);
        float4 b4 = make_float4(0.f, 0.f, 0.f, 0.f);
        if (ga.bias) b4 = *(const float4*)(ga.bias + n);
        bf16_t* op = ga.xout + (size_t)(m0 + rr) * 1024 + n;
#pragma unroll
        for (int it = 0; it < 16; ++it) {
            const float4 c = *(const float4*)(Ct + (rr + 8 * it) * CT_LD + c4 * 4);
            float4 xq;
            if (MODE == GM_RESID_BF) {
                const unsigned q0 = __float_as_uint(xi[it].x), q1 = __float_as_uint(xi[it].y);
                xq = make_float4(__uint_as_float(q0 << 16), __uint_as_float(q0 & 0xffff0000u), __uint_as_float(q1 << 16), __uint_as_float(q1 & 0xffff0000u));
            } else xq = make_float4(xi[it].x, xi[it].y, xi[it].z, xi[it].w);
            float4 o;
            o.x = xq.x + g4.x * (c.x + b4.x); o.y = xq.y + g4.y * (c.y + b4.y);
            o.z = xq.z + g4.z * (c.z + b4.z); o.w = xq.w + g4.w * (c.w + b4.w);
            { u32x2_t ov_; ov_.x = pack2bf(o.x, o.y); ov_.y = pack2bf(o.z, o.w); __builtin_nontemporal_store(ov_, (u32x2_t*)(op + (size_t)it * 8 * 1024)); }
        }
    } else {
        const int c8 = tid & 15, rr = tid >> 4;
        bf16_t* dst; size_t rstride; const float* colbias = nullptr; const float* rowbias = nullptr;
        bf16_t* R3 = (bf16_t*)(ws + OFF_R3);
        const int b = m0 >> 11, s0 = m0 & 2047;
        if (MODE == GM_PLAIN) { dst = ga.out + (size_t)m0 * ga.N + n0; rstride = (size_t)ga.N; }
        else if (MODE == GM_INPROJ) {
            if (!swapped) { dst = R3 + (size_t)(tn >> 2) * T_TOK * 512 + (size_t)m0 * 512 + (n0 & 511); rstride = 512; }
            else { dst = R3 + (size_t)T_TOK * 512 + ((size_t)b * 512 + (n0 - 512)) * 2048 + s0; rstride = 2048; }
        } else {
            if (tn < 8) { dst = R3 + (size_t)m0 * 1024 + n0; rstride = 1024; colbias = p.b_qkv + n0; }
            else if (tn == 8) { dst = R3 + (size_t)T_TOK * 1024 + (size_t)m0 * 128; rstride = 128; colbias = p.b_qkv + n0; }
            else { dst = R3 + (size_t)T_TOK * 1024 + (size_t)T_TOK * 128 + (size_t)b * 128 * 2048 + s0; rstride = 2048; rowbias = p.b_qkv + 1152; }
        }
        const float* rowscale = nullptr; const float* colscale = nullptr;
        if (ga.hs) { rowscale = swapped ? ga.wsc + n0 : ga.hs + m0; colscale = swapped ? ga.hs + m0 : ga.wsc + n0; }
        float csv[8];
#pragma unroll
        for (int e = 0; e < 8; ++e) csv[e] = 1.f;
        if (colscale) {
            const float4 a = *(const float4*)(colscale + c8 * 8), bq = *(const float4*)(colscale + c8 * 8 + 4);
            csv[0] = a.x; csv[1] = a.y; csv[2] = a.z; csv[3] = a.w; csv[4] = bq.x; csv[5] = bq.y; csv[6] = bq.z; csv[7] = bq.w;
        }
        float cbv[8];
#pragma unroll
        for (int e = 0; e < 8; ++e) cbv[e] = 0.f;
        if (colbias) {
            const float4 a = *(const float4*)(colbias + c8 * 8), bq = *(const float4*)(colbias + c8 * 8 + 4);
            cbv[0] = a.x; cbv[1] = a.y; cbv[2] = a.z; cbv[3] = a.w; cbv[4] = bq.x; cbv[5] = bq.y; cbv[6] = bq.z; cbv[7] = bq.w;
        }
        bf16_t* dp = dst + (size_t)rr * rstride + c8 * 8;
#pragma unroll
        for (int it = 0; it < 8; ++it) {
            const int row = rr + 16 * it;
            const float4 c0 = *(const float4*)(Ct + row * CT_LD + c8 * 8);
            const float4 c1 = *(const float4*)(Ct + row * CT_LD + c8 * 8 + 4);
            float rbv = 0.f, rsv = 1.f;
            if (rowbias) rbv = rowbias[row];
            if (rowscale) rsv = rowscale[row];
            uint4 o;
            o.x = pack2bf(c0.x * rsv * csv[0] + cbv[0] + rbv, c0.y * rsv * csv[1] + cbv[1] + rbv);
            o.y = pack2bf(c0.z * rsv * csv[2] + cbv[2] + rbv, c0.w * rsv * csv[3] + cbv[3] + rbv);
            o.z = pack2bf(c1.x * rsv * csv[4] + cbv[4] + rbv, c1.y * rsv * csv[5] + cbv[5] + rbv);
            o.w = pack2bf(c1.z * rsv * csv[6] + cbv[6] + rbv, c1.w * rsv * csv[7] + cbv[7] + rbv);
            { u32x4_t ov_; ov_.x = o.x; ov_.y = o.y; ov_.z = o.z; ov_.w = o.w; __builtin_nontemporal_store(ov_, (u32x4_t*)(dp + (size_t)it * 16 * rstride)); }
        }
    }
    __syncthreads();
}

#define GT_BYTES 16384
typedef int i32x4_t __attribute__((ext_vector_type(4)));
typedef int i32x16_t __attribute__((ext_vector_type(16)));
template <int MODE, bool I8>
DI void phase_gemm(const Params& p, char* ws, const GemmArgs& ga, char* smem) {
    const int tid = get_tid(), lane = tid & 63, wave = tid >> 6;
    const int wm = wave >> 1, wn = wave & 1;
    const int r = lane & 31, h = lane >> 5;
    const int NT = ga.N / 128;
    const int total = 256 * NT;
    constexpr int RS = I8 ? 1024 : 2048;
    constexpr int NK = I8 ? 8 : 16;
    const int srow = wave * 8 + (lane >> 3);
    const int scg = (lane & 7) ^ ((((wave & 1) << 2) + (lane >> 4)) & 7);
    const size_t soff = (size_t)srow * RS + scg * 16;
    const int fsw = (r >> 1) & 7;
    int fo[4];
#pragma unroll
    for (int ks = 0; ks < 4; ++ks) fo[ks] = ((ks * 2 + h) ^ fsw) * 16;
    for (int ti = blockIdx.x; ti < total; ti += gridDim.x) {
        const int label = ti & 7, j = ti >> 3;
        const int tm = label * 32 + j / NT, tn = j % NT;
        const int m0 = tm * 128, n0 = tn * 128;
        bool swapped = false;
        if (MODE == GM_INPROJ) swapped = (tn >= 4 && tn < 8);
        if (MODE == GM_QKV) swapped = (tn == 9);
        const char* Ag = (const char*)ga.A + (size_t)m0 * RS + soff;
        const char* Bg = (const char*)ga.Bt + (size_t)n0 * RS + soff;
        f32x16 acc[2][2];
        i32x16_t acci[2][2];
#pragma unroll
        for (int a = 0; a < 2; ++a) {
            zero_acc<2>(acc[a]);
#pragma unroll
            for (int b2 = 0; b2 < 2; ++b2)
#pragma unroll
                for (int i = 0; i < 16; ++i) acci[a][b2][i] = 0;
        }
#define GEMM_STAGE(BUF, KT)                                                                                           \
        _Pragma("unroll") for (int i = 0; i < 4; ++i) {                                                                \
            __builtin_amdgcn_global_load_lds((const unsigned*)(Ag + (size_t)i * 32 * RS + (KT) * 128),                \
                                             (unsigned*)(smem + (BUF) * 2 * GT_BYTES + (i * 4 + wave) * 1024), 16, 0, 0); \
            __builtin_amdgcn_global_load_lds((const unsigned*)(Bg + (size_t)i * 32 * RS + (KT) * 128),                \
                                             (unsigned*)(smem + (BUF) * 2 * GT_BYTES + GT_BYTES + (i * 4 + wave) * 1024), 16, 0, 0); \
        }
        f32x4n_t xi[16];
        if (MODE == GM_RESID) {
            const float* xp = (const float*)ga.xin + (size_t)(m0 + (tid >> 5)) * 1024 + n0 + (tid & 31) * 4;
#pragma unroll
            for (int it = 0; it < 16; ++it) xi[it] = __builtin_nontemporal_load((const f32x4n_t*)(xp + (size_t)it * 8 * 1024));
        }
        if (MODE == GM_RESID_BF) {
            const bf16_t* xp = (const bf16_t*)ga.xin + (size_t)(m0 + (tid >> 5)) * 1024 + n0 + (tid & 31) * 4;
#pragma unroll
            for (int it = 0; it < 16; ++it) {
                const u32x2_t q = __builtin_nontemporal_load((const u32x2_t*)(xp + (size_t)it * 8 * 1024));
                xi[it].x = __uint_as_float(q.x); xi[it].y = __uint_as_float(q.y);
            }
        }
        GEMM_STAGE(0, 0)
        asm volatile("s_waitcnt vmcnt(0)" ::: "memory");
        __syncthreads();
        for (int kt = 0; kt < NK; ++kt) {
            const int cur = kt & 1;
            if (kt < NK - 1) { GEMM_STAGE(cur ^ 1, kt + 1) }
            const char* At = smem + cur * 2 * GT_BYTES + (swapped ? GT_BYTES : 0) + (wm * 64 + r) * 128;
            const char* Bt2 = smem + cur * 2 * GT_BYTES + (swapped ? 0 : GT_BYTES) + (wn * 64 + r) * 128;
#pragma unroll
            for (int ks = 0; ks < 4; ++ks) {
                if (I8) {
                    i32x4_t af[2], bfr[2];
                    af[0] = *(const i32x4_t*)(At + fo[ks]);
                    af[1] = *(const i32x4_t*)(At + 32 * 128 + fo[ks]);
                    bfr[0] = *(const i32x4_t*)(Bt2 + fo[ks]);
                    bfr[1] = *(const i32x4_t*)(Bt2 + 32 * 128 + fo[ks]);
#pragma unroll
                    for (int mt = 0; mt < 2; ++mt)
#pragma unroll
                        for (int nt = 0; nt < 2; ++nt) acci[mt][nt] = __builtin_amdgcn_mfma_i32_32x32x32_i8(af[mt], bfr[nt], acci[mt][nt], 0, 0, 0);
                } else {
                    bf16x8 af[2], bfr[2];
                    af[0] = *(const bf16x8*)(At + fo[ks]);
                    af[1] = *(const bf16x8*)(At + 32 * 128 + fo[ks]);
                    bfr[0] = *(const bf16x8*)(Bt2 + fo[ks]);
                    bfr[1] = *(const bf16x8*)(Bt2 + 32 * 128 + fo[ks]);
#pragma unroll
                    for (int mt = 0; mt < 2; ++mt)
#pragma unroll
                        for (int nt = 0; nt < 2; ++nt) acc[mt][nt] = MFMA32(af[mt], bfr[nt], acc[mt][nt]);
                }
            }
            asm volatile("s_waitcnt vmcnt(0) lgkmcnt(0)" ::: "memory");
            __syncthreads();
        }
        if (I8) {
#pragma unroll
            for (int mt = 0; mt < 2; ++mt)
#pragma unroll
                for (int nt = 0; nt < 2; ++nt)
#pragma unroll
                    for (int i = 0; i < 16; ++i) acc[mt][nt][i] = (float)acci[mt][nt][i];
        }
        gemm_epilogue<MODE>(p, ws, ga, acc, m0, n0, tn, wm, wn, tid, swapped, (float*)smem, xi);
    }
}

#define KW_LD 136
DI void phase_m1b(const Params& p, char* ws, char* smem) {
    const bf16_t* VT = (const bf16_t*)(ws + OFF_R3) + (size_t)T_TOK * 512;
    bf16_t* Qm = (bf16_t*)(ws + OFF_R1);
    bf16_t* Km = (bf16_t*)(ws + OFF_R1 + 32ull * MiB);
    float* DT = (float*)(ws + OFF_R5);
    const bf16_t* WqT = (const bf16_t*)(ws + OFF_WQT);
    const bf16_t* WkT = (const bf16_t*)(ws + OFF_WKT);
    const float* ipre = (const float*)(ws + OFF_IPRE);
    const float* logf_ = (const float*)(ws + OFF_LOGF);
    float* Gc = (float*)(ws + OFF_G);
    float* Bv = (float*)(ws + OFF_BV);
    float* usc = (float*)(ws + OFF_USC);
    float* ND = (float*)(ws + OFF_ND);
    bf16_t* KwT = (bf16_t*)smem;
    float* wv = (float*)(smem + 128 * KW_LD * 2);
    bf16_t* CMs = (bf16_t*)(smem + 128 * KW_LD * 2 + 512);
    bf16_t* CMg = (bf16_t*)(ws + OFF_R5 + 64ull * MiB);
    const bf16_t* UM = (const bf16_t*)(ws + OFF_R3);
    const int tid = get_tid(), lane = tid & 63, wave = tid >> 6;
    const int r = lane & 31, h = lane >> 5;
    const int cvc = tid & 15, csub = tid >> 4;
    for (int unit = blockIdx.x; unit < 1024; unit += gridDim.x) {
        const int c = unit & 15, hd = (unit >> 4) & 3, b = unit >> 6;
        const size_t t0 = (size_t)b * SEQ + c * 128;
        __syncthreads();
        {
            const int ch0 = hd * 128 + cvc * 8;
            float cw[4][8], cb[8];
#pragma unroll
            for (int jx = 0; jx < 4; ++jx) {
                const float4 a0 = *(const float4*)(p.conv_w + jx * 512 + ch0), a1 = *(const float4*)(p.conv_w + jx * 512 + ch0 + 4);
                cw[jx][0] = a0.x; cw[jx][1] = a0.y; cw[jx][2] = a0.z; cw[jx][3] = a0.w; cw[jx][4] = a1.x; cw[jx][5] = a1.y; cw[jx][6] = a1.z; cw[jx][7] = a1.w;
            }
            {
                const float4 a0 = *(const float4*)(p.conv_b + ch0), a1 = *(const float4*)(p.conv_b + ch0 + 4);
                cb[0] = a0.x; cb[1] = a0.y; cb[2] = a0.z; cb[3] = a0.w; cb[4] = a1.x; cb[5] = a1.y; cb[6] = a1.z; cb[7] = a1.w;
            }
            u32x4_t raw[11];
#pragma unroll
            for (int q = 0; q < 11; ++q) {
                const int sq = c * 128 + csub * 8 + q - 3;
                raw[q] = (u32x4_t){0u, 0u, 0u, 0u};
                if (sq >= 0) raw[q] = *(const u32x4_t*)(UM + ((size_t)b * SEQ + sq) * 512 + ch0);
            }
            float hist[3][8];
#pragma unroll
            for (int q = 0; q < 3; ++q) {
                const unsigned w[4] = {raw[q].x, raw[q].y, raw[q].z, raw[q].w};
#pragma unroll
                for (int e = 0; e < 4; ++e) { hist[q][2 * e] = __uint_as_float(w[e] << 16); hist[q][2 * e + 1] = __uint_as_float(w[e] & 0xffff0000u); }
            }
#pragma unroll
            for (int q = 0; q < 8; ++q) {
                const unsigned w[4] = {raw[q + 3].x, raw[q + 3].y, raw[q + 3].z, raw[q + 3].w};
                float cur[8], o[8];
#pragma unroll
                for (int e = 0; e < 4; ++e) { cur[2 * e] = __uint_as_float(w[e] << 16); cur[2 * e + 1] = __uint_as_float(w[e] & 0xffff0000u); }
#pragma unroll
                for (int e = 0; e < 8; ++e) {
                    const float a = cw[0][e] * hist[0][e] + cw[1][e] * hist[1][e] + cw[2][e] * hist[2][e] + cw[3][e] * cur[e] + cb[e];
                    o[e] = siluf_(a);
                    hist[0][e] = hist[1][e]; hist[1][e] = hist[2][e]; hist[2][e] = cur[e];
                }
                u32x4_t ov;
                ov.x = pack2bf(o[0], o[1]); ov.y = pack2bf(o[2], o[3]); ov.z = pack2bf(o[4], o[5]); ov.w = pack2bf(o[6], o[7]);
                const int sl_ = csub * 8 + q;
                *(u32x4_t*)(CMs + sl_ * KW_LD + cvc * 8) = ov;
                *(u32x4_t*)(CMg + (t0 + sl_) * 512 + ch0) = ov;
            }
        }
        if (wave == 0) {
            const float i0 = ipre[(t0 + 2 * lane) * 4 + hd], i1 = ipre[(t0 + 2 * lane + 1) * 4 + hd];
            const float f0 = logf_[(t0 + 2 * lane) * 4 + hd], f1 = logf_[(t0 + 2 * lane + 1) * 4 + hd];
            float s = f0 + f1;
#pragma unroll
            for (int d = 1; d < 64; d <<= 1) { const float t = __shfl_up(s, d); if (lane >= d) s += t; }
            const float g1 = s, g0 = s - f1;
            const float gtot = __shfl(s, 63);
            const float b0 = i0 - g0, b1 = i1 - g1;
            float bm = fmaxf(b0, b1);
#pragma unroll
            for (int o = 32; o >= 1; o >>= 1) bm = fmaxf(bm, __shfl_xor(bm, o));
            const float Mc = gtot + bm;
            wv[2 * lane] = __expf(b0 - bm);
            wv[2 * lane + 1] = __expf(b1 - bm);
            Gc[(t0 + 2 * lane) * 4 + hd] = g0; Gc[(t0 + 2 * lane + 1) * 4 + hd] = g1;
            Bv[(t0 + 2 * lane) * 4 + hd] = b0; Bv[(t0 + 2 * lane + 1) * 4 + hd] = b1;
            if (lane == 0) { usc[unit * 4 + 0] = Mc; usc[unit * 4 + 1] = gtot; }
        }
        __syncthreads();
        const bf16_t* Acm = CMs;
        {
            f32x16 acc[4];
            zero_acc<4>(acc);
            wave_mma<4, 8>(acc, Acm + (wave * 32) * KW_LD, KW_LD, WqT + (size_t)hd * 16384, 128, lane);
            {
                bf16_t* qb = Qm + (t0 + wave * 32 + 4 * h) * 512 + hd * 128 + r;
#pragma unroll
                for (int i4 = 0; i4 < 4; ++i4) {
                    bf16_t* q2 = qb + (size_t)i4 * 8 * 512;
                    LAUNDER(q2);
#pragma unroll
                    for (int ii = 0; ii < 4; ++ii)
#pragma unroll
                        for (int nt = 0; nt < 4; ++nt) q2[ii * 512 + nt * 32] = f2bf(acc[nt][i4 * 4 + ii]);
                }
            }
            zero_acc<4>(acc);
            wave_mma<4, 8>(acc, Acm + (wave * 32) * KW_LD, KW_LD, WkT + (size_t)hd * 16384, 128, lane);
            {
                bf16_t* qb = Km + (t0 + wave * 32 + 4 * h) * 512 + hd * 128 + r;
#pragma unroll
                for (int i4 = 0; i4 < 4; ++i4) {
                    bf16_t* q2 = qb + (size_t)i4 * 8 * 512;
                    LAUNDER(q2);
#pragma unroll
                    for (int ii = 0; ii < 4; ++ii)
#pragma unroll
                        for (int nt = 0; nt < 4; ++nt) q2[ii * 512 + nt * 32] = f2bf(acc[nt][i4 * 4 + ii]);
                }
            }
        }
        {
            f32x16 acc[4];
            zero_acc<4>(acc);
            wave_mma<4, 8>(acc, WkT + (size_t)hd * 16384 + (size_t)(wave * 32) * 128, 128, Acm, KW_LD, lane);
#pragma unroll
            for (int nt = 0; nt < 4; ++nt) {
                const float w = wv[nt * 32 + r];
#pragma unroll
                for (int i = 0; i < 16; ++i) KwT[(wave * 32 + crow(i, h)) * KW_LD + nt * 32 + r] = f2bf(acc[nt][i] * w);
            }
        }
        __syncthreads();
        if (tid < 128) {
            float s = 0.f;
            for (int q = 0; q < 128; ++q) s += bf2f(KwT[tid * KW_LD + q]);
            ND[(size_t)unit * 128 + tid] = s;
        }
        {
            f32x16 acc[4];
            zero_acc<4>(acc);
            const bf16_t* Av = VT + ((size_t)b * 512 + hd * 128 + wave * 32) * 2048 + c * 128;
            wave_mma<4, 8>(acc, Av, 2048, KwT, KW_LD, lane);
            float* dst = DT + (size_t)unit * 16384 + (wave * 32 + 4 * h) * 128 + r;
#pragma unroll
            for (int i4 = 0; i4 < 4; ++i4) {
                float* d2 = dst + i4 * 8 * 128;
                LAUNDER(d2);
#pragma unroll
                for (int ii = 0; ii < 4; ++ii)
#pragma unroll
                    for (int nt = 0; nt < 4; ++nt) d2[ii * 128 + nt * 32] = acc[nt][i4 * 4 + ii];
            }
        }
    }
    __syncthreads();
}

DI void phase_m2(const Params& p, char* ws) {
    (void)p;
    const float* DT = (const float*)(ws + OFF_R5);
    bf16_t* Cin = (bf16_t*)(ws + OFF_R2);
    float* usc = (float*)(ws + OFF_USC);
    const float* ND = (const float*)(ws + OFF_ND);
    float* NIN = (float*)(ws + OFF_NIN);
    const size_t gtid = (size_t)blockIdx.x * 256 + get_tid(), gsz = (size_t)gridDim.x * 256;
    const size_t total = (size_t)64 * (16384 + 128);
    for (size_t it = gtid; it < total; it += gsz) {
        const int bh = (int)(it / (16384 + 128));
        const int idx = (int)(it % (16384 + 128));
        const bool isC = idx < 16384;
        const float* src = isC ? DT + (size_t)bh * 16 * 16384 + idx : ND + (size_t)bh * 16 * 128 + (idx - 16384);
        const size_t cstride = isC ? 16384 : 128;
        float dv[16], dec[16], sc[16];
#pragma unroll
        for (int c = 0; c < 16; ++c) dv[c] = src[(size_t)c * cstride];
        float m = NEG_INF_F;
#pragma unroll
        for (int c = 0; c < 16; ++c) {
            const int unit = bh * 16 + c;
            const float Mc = usc[unit * 4 + 0], gt = usc[unit * 4 + 1];
            const float mnew = fmaxf(gt + m, Mc);
            dec[c] = __expf(gt + m - mnew); sc[c] = __expf(Mc - mnew);
            if (idx == 16384) usc[unit * 4 + 2] = m;
            m = mnew;
        }
        float st = 0.f;
#pragma unroll
        for (int c = 0; c < 16; ++c) {
            const int unit = bh * 16 + c;
            if (isC) Cin[(size_t)unit * 16384 + idx] = f2bf(st);
            else NIN[(size_t)unit * 128 + (idx - 16384)] = st;
            st = dec[c] * st + sc[c] * dv[c];
        }
    }
}

template <int NT, int KSTEPS>
DI void wave_mma_regA_ldsB(f32x16 (&acc)[NT], const bf16x8 (&af)[KSTEPS], const bf16_t* B, int ldb, int lane) {
    const int r = lane & 31, h = lane >> 5;
#pragma unroll
    for (int ks = 0; ks < KSTEPS; ++ks) {
#pragma unroll
        for (int nt = 0; nt < NT; ++nt) acc[nt] = MFMA32(af[ks], *(const bf16x8*)(B + (nt * 32 + r) * ldb + ks * 16 + h * 8), acc[nt]);
        if (ks & 1) __builtin_amdgcn_sched_barrier(0);
    }
}
template <int NT, int KSTEPS>
DI void wave_mma_ldsAB(f32x16 (&acc)[NT], const bf16_t* A, int lda, const bf16_t* B, int ldb, int lane) {
    const int r = lane & 31, h = lane >> 5;
#pragma unroll
    for (int ks = 0; ks < KSTEPS; ++ks) {
        const bf16x8 a = *(const bf16x8*)(A + r * lda + ks * 16 + h * 8);
#pragma unroll
        for (int nt = 0; nt < NT; ++nt) acc[nt] = MFMA32(a, *(const bf16x8*)(B + (nt * 32 + r) * ldb + ks * 16 + h * 8), acc[nt]);
        if (ks & 1) asm volatile("" ::: "memory");
    }
}
DI void phase_m3(const Params& p, char* ws, char* smem) {
    const bf16_t* R3 = (const bf16_t*)(ws + OFF_R3);
    const bf16_t* VT = R3 + (size_t)T_TOK * 512;
    const bf16_t* Zb = R3 + (size_t)2 * T_TOK * 512;
    const bf16_t* CM = (const bf16_t*)(ws + OFF_R5 + 64ull * MiB);
    const bf16_t* Qm = (const bf16_t*)(ws + OFF_R1);
    const bf16_t* Km = (const bf16_t*)(ws + OFF_R1 + 32ull * MiB);
    const bf16_t* Cin = (const bf16_t*)(ws + OFF_R2);
    const bf16_t* PWT = (const bf16_t*)(ws + OFF_PWT);
    const float* Gc = (const float*)(ws + OFF_G);
    const float* Bv = (const float*)(ws + OFF_BV);
    const float* usc = (const float*)(ws + OFF_USC);
    const float* NIN = (const float*)(ws + OFF_NIN);
    bf16_t* MIX = (bf16_t*)(ws + OFF_R4);
    const int tid = get_tid(), lane = tid & 63, wave = tid >> 6;
    const int r = lane & 31, h = lane >> 5;
    bf16_t* Sp = (bf16_t*)smem + (size_t)wave * 32 * KW_LD;
    bf16_t* OPB = (bf16_t*)(smem + 4 * 32 * KW_LD * 2);
    float* fb = (float*)(smem + 2 * 4 * 32 * KW_LD * 2);
    float* gs = fb;
    float* bs = fb + 128;
    float* mxs = fb + 256;
    float* nin = fb + 384;
    float* qns = fb + 512;
    const int srow = tid >> 4, sch = tid & 15;
    for (int u2 = blockIdx.x; u2 < 1024; u2 += gridDim.x) {
        const int g = u2 & 3, c = (u2 >> 2) & 15, b = u2 >> 6;
        const size_t t0 = (size_t)b * SEQ + c * 128;
        u32x4_t R[8];
#pragma unroll
        for (int q = 0; q < 8; ++q) R[q] = *(const u32x4_t*)(PWT + (size_t)g * 16384 + (size_t)(srow + 16 * q) * 128 + sch * 8);
        __syncthreads();
#pragma unroll
        for (int q = 0; q < 8; ++q) *(u32x4_t*)(OPB + (srow + 16 * q) * KW_LD + sch * 8) = R[q];
        {
            const bf16_t* UP = (const bf16_t*)(ws + OFF_R3) + (size_t)3 * T_TOK * 512;
            const int pvc = tid & 15, psub = tid >> 4;
            const int ch0 = g * 128 + pvc * 8;
            const int W = 2 << g;
            const int s0 = c * 128 + psub * 8;
            const size_t tbase = (size_t)b * SEQ;
            float sum[8];
#pragma unroll
            for (int e = 0; e < 8; ++e) sum[e] = 0.f;
            for (int q = 1; q < W; ++q) {
                const int sq = s0 - q;
                if (sq >= 0) {
                    const u32x4_t rw = *(const u32x4_t*)(UP + (tbase + sq) * 512 + ch0);
                    const unsigned w[4] = {rw.x, rw.y, rw.z, rw.w};
#pragma unroll
                    for (int e = 0; e < 4; ++e) { sum[2 * e] += __uint_as_float(w[e] << 16); sum[2 * e + 1] += __uint_as_float(w[e] & 0xffff0000u); }
                }
            }
            u32x4_t rawb[8], rlb[8];
#pragma unroll
            for (int q = 0; q < 8; ++q) {
                const int sq = s0 + q;
                rawb[q] = *(const u32x4_t*)(UP + (tbase + sq) * 512 + ch0);
                const int sl_ = sq - W + 1;
                rlb[q] = (u32x4_t){0u, 0u, 0u, 0u};
                if (sl_ >= 0) rlb[q] = *(const u32x4_t*)(UP + (tbase + sl_) * 512 + ch0);
            }
#pragma unroll
            for (int q = 0; q < 8; ++q) {
                const int sq = s0 + q;
                const unsigned w[4] = {rawb[q].x, rawb[q].y, rawb[q].z, rawb[q].w};
                float cur[8], o[8];
#pragma unroll
                for (int e = 0; e < 4; ++e) { cur[2 * e] = __uint_as_float(w[e] << 16); cur[2 * e + 1] = __uint_as_float(w[e] & 0xffff0000u); }
                const int cnt = (sq + 1 < W) ? (sq + 1) : W;
                const float inv = 1.f / (float)cnt;
#pragma unroll
                for (int e = 0; e < 8; ++e) { sum[e] += cur[e]; o[e] = sum[e] * inv - cur[e]; }
                u32x4_t ov;
                ov.x = pack2bf(o[0], o[1]); ov.y = pack2bf(o[2], o[3]); ov.z = pack2bf(o[4], o[5]); ov.w = pack2bf(o[6], o[7]);
                *(u32x4_t*)((bf16_t*)smem + (psub * 8 + q) * KW_LD + pvc * 8) = ov;
                const unsigned wl[4] = {rlb[q].x, rlb[q].y, rlb[q].z, rlb[q].w};
#pragma unroll
                for (int e = 0; e < 4; ++e) { sum[2 * e] -= __uint_as_float(wl[e] << 16); sum[2 * e + 1] -= __uint_as_float(wl[e] & 0xffff0000u); }
            }
        }
        __syncthreads();
        f32x16 acc[4];
        zero_acc<4>(acc);
        wave_mma_ldsAB<4, 8>(acc, (const bf16_t*)smem + wave * 32 * KW_LD, KW_LD, OPB, KW_LD, lane);
        bf16_t* mb = MIX + (t0 + wave * 32 + 4 * h) * 1024 + 512 + g * 128 + r;
#pragma unroll
        for (int i4 = 0; i4 < 4; ++i4) {
            bf16_t* m2 = mb + (size_t)i4 * 8 * 1024;
            LAUNDER(m2);
#pragma unroll
            for (int ii = 0; ii < 4; ++ii)
#pragma unroll
                for (int nt = 0; nt < 4; ++nt) m2[ii * 1024 + nt * 32] = f2bf(acc[nt][i4 * 4 + ii]);
        }
    }
    for (int unit = blockIdx.x; unit < 1024; unit += gridDim.x) {
        const int c = unit & 15, hd = (unit >> 4) & 3, b = unit >> 6;
        const size_t t0 = (size_t)b * SEQ + c * 128;
        const float m_in = usc[unit * 4 + 2];
        const int l0 = wave * 32;
        bf16x8 qf[8];
#pragma unroll
        for (int ks = 0; ks < 8; ++ks) qf[ks] = *(const bf16x8*)(Qm + (t0 + l0 + r) * 512 + hd * 128 + ks * 16 + h * 8);
        __syncthreads();
        if (wave == 0) {
            const float b0 = Bv[(t0 + 2 * lane) * 4 + hd], b1 = Bv[(t0 + 2 * lane + 1) * 4 + hd];
            float s = fmaxf(b0, b1);
#pragma unroll
            for (int d = 1; d < 64; d <<= 1) { const float t = __shfl_up(s, d); if (lane >= d) s = fmaxf(s, t); }
            float prev = __shfl_up(s, 1);
            if (lane == 0) prev = NEG_INF_F;
            const float pm0 = fmaxf(prev, b0), pm1 = s;
            bs[2 * lane] = b0; bs[2 * lane + 1] = b1;
            mxs[2 * lane] = fmaxf(m_in, pm0); mxs[2 * lane + 1] = fmaxf(m_in, pm1);
        } else if (wave == 1) {
            gs[2 * lane] = Gc[(t0 + 2 * lane) * 4 + hd]; gs[2 * lane + 1] = Gc[(t0 + 2 * lane + 1) * 4 + hd];
            nin[2 * lane] = NIN[(size_t)unit * 128 + 2 * lane]; nin[2 * lane + 1] = NIN[(size_t)unit * 128 + 2 * lane + 1];
        }
        {
            u32x4_t R[8];
#pragma unroll
            for (int q = 0; q < 8; ++q) R[q] = *(const u32x4_t*)(Km + (t0 + srow + 16 * q) * 512 + hd * 128 + sch * 8);
#pragma unroll
            for (int q = 0; q < 8; ++q) *(u32x4_t*)(OPB + (srow + 16 * q) * KW_LD + sch * 8) = R[q];
        }
        __syncthreads();
        if (lane < 32) {
            const bf16_t* qr = Qm + (t0 + l0 + lane) * 512 + hd * 128;
            float s = 0.f;
            for (int d8 = 0; d8 < 16; ++d8) {
                const uint4 raw = *(const uint4*)(qr + d8 * 8);
                const unsigned w[4] = {raw.x, raw.y, raw.z, raw.w};
#pragma unroll
                for (int e = 0; e < 4; ++e) s += bf2f((bf16_t)(w[e] & 0xffff)) * nin[d8 * 8 + 2 * e] + bf2f((bf16_t)(w[e] >> 16)) * nin[d8 * 8 + 2 * e + 1];
            }
            qns[wave * 32 + lane] = s;
        }
        float den2[16];
        {
            f32x16 acc[4];
            zero_acc<4>(acc);
            wave_mma_regA_ldsB<4, 8>(acc, qf, OPB, KW_LD, lane);
#pragma unroll
            for (int i = 0; i < 16; ++i) {
                const int l = l0 + crow(i, h);
                const float mxl = mxs[l];
                float rs = 0.f;
#pragma unroll
                for (int nt = 0; nt < 4; ++nt) {
                    const int sx = nt * 32 + r;
                    float v = 0.f;
                    if (sx <= l) v = acc[nt][i] * __expf(fminf(bs[sx] - mxl, 0.f));
                    rs += v;
                    Sp[crow(i, h) * KW_LD + sx] = f2bf(v);
                }
                den2[i] = half_sum(rs);
            }
        }
#pragma unroll
        for (int ks = 0; ks < 8; ++ks) qf[ks] = *(const bf16x8*)(Qm + (t0 + l0 + r) * 512 + hd * 128 + ks * 16 + h * 8);
        __syncthreads();
        {
            u32x4_t R[8];
#pragma unroll
            for (int q = 0; q < 8; ++q) R[q] = *(const u32x4_t*)(Cin + (size_t)unit * 16384 + (size_t)(srow + 16 * q) * 128 + sch * 8);
#pragma unroll
            for (int q = 0; q < 8; ++q) *(u32x4_t*)(OPB + (srow + 16 * q) * KW_LD + sch * 8) = R[q];
        }
        __syncthreads();
        f32x16 acc[4];
        zero_acc<4>(acc);
        wave_mma_regA_ldsB<4, 8>(acc, qf, OPB, KW_LD, lane);
#pragma unroll
        for (int i = 0; i < 16; ++i) {
            const int l = l0 + crow(i, h);
            const float inter_i = __expf(m_in - mxs[l]);
#pragma unroll
            for (int nt = 0; nt < 4; ++nt) acc[nt][i] *= inter_i;
        }
        __syncthreads();
        {
            u32x4_t R[8];
#pragma unroll
            for (int q = 0; q < 8; ++q) R[q] = *(const u32x4_t*)(VT + ((size_t)b * 512 + hd * 128 + srow + 16 * q) * 2048 + c * 128 + sch * 8);
#pragma unroll
            for (int q = 0; q < 8; ++q) *(u32x4_t*)(OPB + (srow + 16 * q) * KW_LD + sch * 8) = R[q];
        }
        __syncthreads();
        wave_mma_ldsAB<4, 8>(acc, Sp, KW_LD, OPB, KW_LD, lane);
#pragma unroll
        for (int i = 0; i < 16; ++i) {
            const int lr = crow(i, h), l = l0 + lr;
            const float den = __expf(m_in - mxs[l]) * qns[wave * 32 + lr] + den2[i];
            const float mrow = gs[l] + mxs[l];
            const float dn = fmaxf(fabsf(den), __expf(-mrow)) + 1e-6f;
            const float inv = 1.f / dn;
            float hv[4];
            float sm = 0.f;
#pragma unroll
            for (int nt = 0; nt < 4; ++nt) { hv[nt] = acc[nt][i] * inv; sm += hv[nt]; }
            const float mu = half_sum(sm) * (1.f / 128.f);
            float sq = 0.f;
#pragma unroll
            for (int nt = 0; nt < 4; ++nt) { const float d = hv[nt] - mu; sq += d * d; }
            const float var = half_sum(sq) * (1.f / 128.f);
            const float rstd = rsqrtf(var + 1e-6f);
#pragma unroll
            for (int nt = 0; nt < 4; ++nt) Sp[lr * KW_LD + nt * 32 + r] = f2bf((hv[nt] - mu) * rstd);
        }
        {
            const int c8 = lane & 15;
            const bf16_t* zrow = Zb + (t0 + l0 + (lane >> 4)) * 512 + hd * 128 + c8 * 8;
            const bf16_t* crow_ = CM + (t0 + l0 + (lane >> 4)) * 512 + hd * 128 + c8 * 8;
            bf16_t* mrow = MIX + (t0 + l0 + (lane >> 4)) * 1024 + hd * 128 + c8 * 8;
            const float* hgp = p.head_g + hd * 128 + c8 * 8;
            const float* skp = p.skip + hd * 128 + c8 * 8;
            LAUNDER(zrow); LAUNDER(crow_); LAUNDER(mrow); LAUNDER(hgp); LAUNDER(skp);
            const float4 hgA = *(const float4*)(hgp), hgB = *(const float4*)(hgp + 4);
            const float4 skA = *(const float4*)(skp), skB = *(const float4*)(skp + 4);
#pragma unroll
            for (int hb = 0; hb < 2; ++hb) {
                uint4 zq[4], cq[4];
#pragma unroll
                for (int it = 0; it < 4; ++it) {
                    zq[it] = *(const uint4*)(zrow + (size_t)(hb * 4 + it) * 4 * 512);
                    cq[it] = *(const uint4*)(crow_ + (size_t)(hb * 4 + it) * 4 * 512);
                }
#pragma unroll
                for (int it = 0; it < 4; ++it) {
                    const int row = (hb * 4 + it) * 4 + (lane >> 4);
                    const uint4 hq = *(const uint4*)(Sp + row * KW_LD + c8 * 8);
#define M3_GATE(HW, ZW, CW, G0, G1, S0, S1, OUTW)                                                             \
                    {                                                                                           \
                        const float h0_ = __uint_as_float((HW) << 16), h1_ = __uint_as_float((HW) & 0xffff0000u); \
                        const float z0_ = __uint_as_float((ZW) << 16), z1_ = __uint_as_float((ZW) & 0xffff0000u); \
                        const float m0_ = __uint_as_float((CW) << 16), m1_ = __uint_as_float((CW) & 0xffff0000u); \
                        OUTW = pack2bf(sigmoidf_(z0_) * (h0_ * (G0) + (S0) * m0_), sigmoidf_(z1_) * (h1_ * (G1) + (S1) * m1_)); \
                    }
                    uint4 ov;
                    M3_GATE(hq.x, zq[it].x, cq[it].x, hgA.x, hgA.y, skA.x, skA.y, ov.x)
                    M3_GATE(hq.y, zq[it].y, cq[it].y, hgA.z, hgA.w, skA.z, skA.w, ov.y)
                    M3_GATE(hq.z, zq[it].z, cq[it].z, hgB.x, hgB.y, skB.x, skB.y, ov.z)
                    M3_GATE(hq.w, zq[it].w, cq[it].w, hgB.z, hgB.w, skB.z, skB.w, ov.w)
                    *(uint4*)(mrow + (size_t)(hb * 4 + it) * 4 * 1024) = ov;
                }
                asm volatile("" ::: "memory");
            }
        }
    }
    __syncthreads();
}

DI void phase_pre_scoremat(const Params& p, char* ws, char* smem) {
    bf16_t* As = (bf16_t*)smem;
    bf16_t* Bs = (bf16_t*)(smem + 128 * KW_LD * 2);
    float* M = (float*)(ws + OFF_M);
    const int tid = get_tid(), lane = tid & 63, wave = tid >> 6, r = lane & 31, h = lane >> 5;
    for (int u = (int)gridDim.x - 1 - (int)blockIdx.x; u < 256; u += gridDim.x) {
        const int layer = u >> 7, hp = (u >> 3) & 15, c0 = (u & 7) * 128;
        __syncthreads();
        for (int i = tid; i < 128 * 32; i += 256) {
            const int row = i >> 5, ch = i & 31;
            const float4 v = *(const float4*)(p.peer_wq + ((size_t)layer * 1024 + c0 + row) * 2048 + hp * 128 + ch * 4);
            *(uint2*)(As + row * KW_LD + ch * 4) = make_uint2(pack2bf(v.x, v.y), pack2bf(v.z, v.w));
            const float4 w = *(const float4*)(p.peer_keys + (((size_t)layer * 16 + hp) * 128 + row) * 128 + ch * 4);
            *(uint2*)(Bs + row * KW_LD + ch * 4) = make_uint2(pack2bf(w.x, w.y), pack2bf(w.z, w.w));
        }
        __syncthreads();
        f32x16 acc[4];
        zero_acc<4>(acc);
        wave_mma_ldsAB<4, 8>(acc, As + wave * 32 * KW_LD, KW_LD, Bs, KW_LD, lane);
        float* mb = M + ((size_t)layer * 1024 + c0 + wave * 32 + 4 * h) * 2048 + hp * 128 + r;
#pragma unroll
        for (int i4 = 0; i4 < 4; ++i4) {
            float* m2 = mb + (size_t)i4 * 8 * 2048;
            LAUNDER(m2);
#pragma unroll
            for (int ii = 0; ii < 4; ++ii)
#pragma unroll
                for (int nt = 0; nt < 4; ++nt) m2[ii * 2048 + nt * 32] = acc[nt][i4 * 4 + ii];
        }
    }
    __syncthreads();
}

DI unsigned f2ord(float x) { const unsigned u = __float_as_uint(x); return (u & 0x80000000u) ? ~u : (u | 0x80000000u); }
DI float ord2f(unsigned k) { const unsigned u = (k & 0x80000000u) ? (k & 0x7fffffffu) : ~k; return __uint_as_float(u); }

DI void convert_row_load(const Params& p, int layer, int row, int lane, float (&v)[16]) {
    const int tab = row >> 14, e = row & 16383;
    const float* src = (tab ? p.peer_v : p.peer_u) + ((size_t)layer * 16384 + e) * 1024 + lane * 16;
#pragma unroll
    for (int i = 0; i < 4; ++i) {
        const f32x4n_t q = __builtin_nontemporal_load((const f32x4n_t*)(src + i * 4));
        v[i * 4 + 0] = q.x; v[i * 4 + 1] = q.y; v[i * 4 + 2] = q.z; v[i * 4 + 3] = q.w;
    }
}
#define TAB_V_OFF (8ull * MiB)
DI void convert_row_finish(char* ws, int layer, int row, int lane, const float (&v)[16]) {
    unsigned char* T8 = (unsigned char*)(ws + OFF_R4);
    float2* SC = (float2*)(ws + OFF_SC) + (size_t)layer * 16384;
    const int tab = row >> 14, e = row & 16383;
    float am = 0.f, ss = 0.f;
#pragma unroll
    for (int i = 0; i < 16; ++i) { am = fmaxf(am, fabsf(v[i])); ss += v[i] * v[i]; }
#pragma unroll
    for (int o = 32; o >= 1; o >>= 1) { am = fmaxf(am, __shfl_xor(am, o)); ss += __shfl_xor(ss, o); }
    const float step = fminf(0.3352f * sqrtf(ss * (1.f / 1024.f)), am * (1.f / 7.5f));
    const float sc = (step > 0.f) ? 1.f / step : 0.f;
    unsigned w[2];
#pragma unroll
    for (int j = 0; j < 2; ++j) {
        unsigned acc = 0;
#pragma unroll
        for (int k = 0; k < 8; ++k) {
            int n = (int)floorf(v[j * 8 + k] * sc) + 8;
            n = n < 0 ? 0 : (n > 15 ? 15 : n);
            const int nibU = (k < 4) ? 2 * k : 2 * (k - 4) + 1;
            const int pos = (tab == 0) ? nibU : k;
            acc |= (unsigned)((pos & 1) ? (n ^ 8) : n) << (4 * pos);
        }
        w[j] = acc;
    }
    *(uint2*)(T8 + (tab ? TAB_V_OFF : 0) + (size_t)(lane >> 4) * (16384 * 128) + (size_t)e * 128 + (lane & 15) * 8) = make_uint2(w[0], w[1]);
    if (lane == 0) { if (tab == 0) SC[e].x = step * (1.f / 16.f); else SC[e].y = step; }
}

typedef float f32x4 __attribute__((ext_vector_type(4)));
#define MFMA16(a, b, c) __builtin_amdgcn_mfma_f32_16x16x32_bf16((a), (b), (c), 0, 0, 0)
#define DPPU(v, ctrl) ((unsigned)__builtin_amdgcn_mov_dpp((int)(v), (ctrl), 0xF, 0xF, true))
DI unsigned umax_(unsigned a, unsigned b) { return a > b ? a : b; }
DI unsigned row16_umax(unsigned v) {
    v = umax_(v, DPPU(v, 0xB1)); v = umax_(v, DPPU(v, 0x4E)); v = umax_(v, DPPU(v, 0x141)); v = umax_(v, DPPU(v, 0x140));
    return v;
}
DI float row16_sum(float v) {
    v += __int_as_float(__builtin_amdgcn_mov_dpp(__float_as_int(v), 0xB1, 0xF, 0xF, true));
    v += __int_as_float(__builtin_amdgcn_mov_dpp(__float_as_int(v), 0x4E, 0xF, 0xF, true));
    v += __int_as_float(__builtin_amdgcn_mov_dpp(__float_as_int(v), 0x141, 0xF, 0xF, true));
    v += __int_as_float(__builtin_amdgcn_mov_dpp(__float_as_int(v), 0x140, 0xF, 0xF, true));
    return v;
}
DI void cand_pair(int c, int& ia, int& ib) {
    if (c < 16) { ia = 0; ib = c; }
    else if (c < 24) { ia = 1; ib = c - 16; }
    else if (c < 29) { ia = 2; ib = c - 24; }
    else if (c < 33) { ia = 3; ib = c - 29; }
    else if (c < 36) { ia = 4; ib = c - 33; }
    else if (c < 38) { ia = 5; ib = c - 36; }
    else if (c < 40) { ia = 6; ib = c - 38; }
    else if (c < 42) { ia = 7; ib = c - 40; }
    else { ia = c - 34; ib = 0; }
}
DI void phase_topk(const Params& p, char* ws, int layer, char* smem) {
    const bf16_t* Sc = (const bf16_t*)(ws + OFF_R3);
    unsigned* LIST = (unsigned*)(ws + OFF_R5);
    const int tid = get_tid(), lane = tid & 63, wave = tid >> 6;
    const int c16 = lane & 15, q4 = lane >> 4, rowbase = lane & 48;
    int ca[4], cb[4];
#pragma unroll
    for (int q = 0; q < 4; ++q) cand_pair(c16 + 16 * q, ca[q], cb[q]);
    const int hd = (int)blockIdx.x & 7;
    const int nblk = ((int)gridDim.x - hd + 7) >> 3;
    const int wv = ((int)blockIdx.x >> 3) * 4 + wave, nwv = nblk * 4;
    __syncthreads();
    const int gw = (int)blockIdx.x * 4 + wave, ngw = (int)gridDim.x * 4;
    int crow_i = gw;
    u32x4_t sfc[2][4], sfn[2][4];
    {
        const int tl0 = wv < T_TOK / 16 ? wv : T_TOK / 16 - 1;
#pragma unroll
        for (int pp = 0; pp < 2; ++pp)
#pragma unroll
            for (int rg = 0; rg < 4; ++rg) sfc[pp][rg] = *(const u32x4_t*)(Sc + ((size_t)tl0 * 16 + q4 * 4 + rg) * 2048 + (hd * 2 + pp) * 128 + c16 * 8);
    }
    for (int tile = wv; tile < T_TOK / 16; tile += nwv) {
        const size_t t0 = (size_t)tile * 16;
        {
            const int tnx = (tile + nwv < T_TOK / 16) ? tile + nwv : T_TOK / 16 - 1;
#pragma unroll
            for (int pp = 0; pp < 2; ++pp)
#pragma unroll
                for (int rg = 0; rg < 4; ++rg) sfn[pp][rg] = *(const u32x4_t*)(Sc + ((size_t)tnx * 16 + q4 * 4 + rg) * 2048 + (hd * 2 + pp) * 128 + c16 * 8);
        }
        float cva[16], cvb[16];
        const int cr0 = crow_i < 32768 ? crow_i : 32767, cr1 = crow_i + ngw < 32768 ? crow_i + ngw : 32767;
        convert_row_load(p, layer, cr0, lane, cva);
        convert_row_load(p, layer, cr1, lane, cvb);
        crow_i += 2 * ngw;
        unsigned top[2][4];
#pragma unroll
        for (int pp = 0; pp < 2; ++pp) {
            unsigned kk[8][4];
#pragma unroll
            for (int rg = 0; rg < 4; ++rg) {
                const unsigned w[4] = {sfc[pp][rg].x, sfc[pp][rg].y, sfc[pp][rg].z, sfc[pp][rg].w};
#pragma unroll
                for (int e = 0; e < 4; ++e) {
                    kk[2 * e][rg] = (f2ord(__uint_as_float(w[e] << 16)) & ~127u) | (unsigned)(127 - (c16 * 8 + 2 * e));
                    kk[2 * e + 1][rg] = (f2ord(__uint_as_float(w[e] & 0xffff0000u)) & ~127u) | (unsigned)(127 - (c16 * 8 + 2 * e + 1));
                }
            }
#pragma unroll
            for (int rg = 0; rg < 4; ++rg) top[pp][rg] = 0u;
#define CE8(a, b) { const unsigned hi_ = umax_(kk[a][rg], kk[b][rg]); const unsigned lo_ = kk[a][rg] < kk[b][rg] ? kk[a][rg] : kk[b][rg]; kk[a][rg] = hi_; kk[b][rg] = lo_; }
#pragma unroll
            for (int rg = 0; rg < 4; ++rg) {
                CE8(0, 1) CE8(2, 3) CE8(4, 5) CE8(6, 7) CE8(0, 2) CE8(1, 3) CE8(4, 6) CE8(5, 7) CE8(1, 2) CE8(5, 6)
                CE8(0, 4) CE8(3, 7) CE8(1, 5) CE8(2, 6) CE8(1, 4) CE8(3, 6) CE8(2, 4) CE8(3, 5) CE8(3, 4)
            }
            unsigned* hl = (unsigned*)smem + wave * (4 * 64 * 9);
            unsigned head[4], haddr[4];
#pragma unroll
            for (int rg = 0; rg < 4; ++rg) {
                unsigned* hp_ = hl + (rg * 64 + lane) * 9;
#pragma unroll
                for (int j = 0; j < 8; ++j) hp_[j] = kk[j][rg];
                hp_[8] = 0u;
                head[rg] = kk[0][rg];
                haddr[rg] = (unsigned)((rg * 64 + lane) * 9) * 4u;
            }
#pragma unroll 1
            for (int it = 0; it < 16; ++it) {
#pragma unroll
                for (int rg = 0; rg < 4; ++rg) {
                    const unsigned m = row16_umax(head[rg]);
                    if (c16 == it) top[pp][rg] = m;
                    haddr[rg] += (head[rg] == m) ? 4u : 0u;
                    head[rg] = *(const unsigned*)((const char*)hl + haddr[rg]);
                }
            }
        }
        unsigned ck[4][4], win[4];
#pragma unroll
        for (int rg = 0; rg < 4; ++rg) {
            const float va = ord2f(top[0][rg] & ~127u), vb = ord2f(top[1][rg] & ~127u);
#pragma unroll
            for (int q = 0; q < 4; ++q) {
                const float a = __shfl(va, rowbase + ca[q]);
                const float bq = __shfl(vb, rowbase + cb[q]);
                const int c = c16 + 16 * q;
                ck[q][rg] = (c < 50) ? ((f2ord(a + bq) & ~63u) | (unsigned)(63 - c)) : 0u;
            }
            win[rg] = 0u;
        }
#define CE4(a, b) { const unsigned hi_ = umax_(ck[a][rg], ck[b][rg]); const unsigned lo_ = ck[a][rg] < ck[b][rg] ? ck[a][rg] : ck[b][rg]; ck[a][rg] = hi_; ck[b][rg] = lo_; }
#pragma unroll
        for (int rg = 0; rg < 4; ++rg) { CE4(0, 1) CE4(2, 3) CE4(0, 2) CE4(1, 3) CE4(1, 2) }
#pragma unroll 1
        for (int it = 0; it < 16; ++it) {
#pragma unroll
            for (int rg = 0; rg < 4; ++rg) {
                const unsigned m = row16_umax(ck[0][rg]);
                if (c16 == it) win[rg] = m;
                const bool won = (ck[0][rg] == m);
                ck[0][rg] = won ? ck[1][rg] : ck[0][rg];
                ck[1][rg] = won ? ck[2][rg] : ck[1][rg];
                ck[2][rg] = won ? ck[3][rg] : ck[2][rg];
                ck[3][rg] = won ? 0u : ck[3][rg];
            }
        }
#pragma unroll
        for (int rg = 0; rg < 4; ++rg) {
            int ia, ib;
            cand_pair(63 - (int)(win[rg] & 63u), ia, ib);
            ia &= 15; ib &= 15;
            const unsigned ta = (unsigned)__shfl((int)top[0][rg], rowbase + ia);
            const unsigned tb = (unsigned)__shfl((int)top[1][rg], rowbase + ib);
            const int e = (127 - (int)(ta & 127u)) * 128 + (127 - (int)(tb & 127u));
            const float cv = ord2f(win[rg] & ~63u);
            const float cmax = __shfl(cv, rowbase);
            const float ex = __expf(cv - cmax);
            const float den = row16_sum(ex);
            const float g = ex / den;
            const size_t t = t0 + q4 * 4 + rg;
            ((unsigned short*)LIST)[t * 128 + hd * 16 + c16] = (unsigned short)e;
            ((unsigned short*)LIST)[(size_t)T_TOK * 128 + t * 128 + hd * 16 + c16] = f2bf(g);
        }
        convert_row_finish(ws, layer, cr0, lane, cva);
        convert_row_finish(ws, layer, cr1, lane, cvb);
#pragma unroll
        for (int pp = 0; pp < 2; ++pp)
#pragma unroll
            for (int rg = 0; rg < 4; ++rg) sfc[pp][rg] = sfn[pp][rg];
    }
    for (; crow_i < 32768; crow_i += ngw) {
        float cv[16];
        convert_row_load(p, layer, crow_i, lane, cv);
        convert_row_finish(ws, layer, crow_i, lane, cv);
    }
}

typedef float f32x2 __attribute__((ext_vector_type(2)));
DI void fp8x16_to_f32(const uint4& q, float (&f)[16]) {
    const unsigned w[4] = {q.x, q.y, q.z, q.w};
#pragma unroll
    for (int i = 0; i < 4; ++i) {
        const f32x2 lo = __builtin_amdgcn_cvt_pk_f32_fp8((int)w[i], false);
        const f32x2 hi = __builtin_amdgcn_cvt_pk_f32_fp8((int)w[i], true);
        f[i * 4 + 0] = lo.x; f[i * 4 + 1] = lo.y; f[i * 4 + 2] = hi.x; f[i * 4 + 3] = hi.y;
    }
}

DI uint4 nt_load_u4(const void* ptr) { const u32x4_t v = __builtin_nontemporal_load((const u32x4_t*)ptr); return make_uint4(v.x, v.y, v.z, v.w); }
DI float4 nt_load_f4(const void* ptr) { const f32x4n_t v = __builtin_nontemporal_load((const f32x4n_t*)ptr); return make_float4(v.x, v.y, v.z, v.w); }
DI void slice_assign(int& x, int& wv, int& nwv) {
    const int G = (int)gridDim.x;
    x = (int)blockIdx.x & 7;
    const int nblk = (G - x + 7) >> 3;
    wv = ((int)blockIdx.x >> 3) * 4 + (get_tid() >> 6);
    nwv = nblk * 4;
}
DI void peer_issue(const unsigned char* tab, const uint4 (&E)[2], int half, unsigned coloff, uint4 (&buf)[8]) {
    const uint4 ea = half ? E[1] : E[0];
    unsigned w4[4] = {ea.x, ea.y, ea.z, ea.w};
    asm volatile("" : "+v"(w4[0]), "+v"(w4[1]), "+v"(w4[2]), "+v"(w4[3]));
#pragma unroll
    for (int j = 0; j < 8; ++j) {
        const unsigned e = (j & 1) ? (w4[j >> 1] >> 16) : (w4[j >> 1] & 0xffffu);
        buf[j] = *(const uint4*)(tab + (e * 128u + coloff));
    }
}
DI void slice_assign4(int& x, int& wv, int& nwv) {
    const int G = (int)gridDim.x, L = (int)blockIdx.x & 7;
    x = L & 3;
    const int nb_lo = (G - x + 7) >> 3, nb_hi = (G - (x + 4) + 7) >> 3;
    wv = ((L >> 2) ? nb_lo * 4 : 0) + ((int)blockIdx.x >> 3) * 4 + (get_tid() >> 6);
    nwv = (nb_lo + nb_hi) * 4;
}
DI void peer_u_compute(const uint4 (&buf)[8], const uint4& hA_in, const uint4& hB_in, int init, int c, int& keep) {
    unsigned h0 = hA_in.x, h1 = hA_in.y, h2 = hA_in.z, h3 = hA_in.w, h4 = hB_in.x, h5 = hB_in.y, h6 = hB_in.z, h7 = hB_in.w;
    asm volatile("" : "+v"(h0), "+v"(h1), "+v"(h2), "+v"(h3), "+v"(h4), "+v"(h5), "+v"(h6), "+v"(h7), "+v"(keep), "+v"(init));
    const unsigned ML = 0x0F0F0F0Fu, MH = 0xF0F0F0F0u;
#pragma unroll
    for (int j = 0; j < 8; ++j) {
        int accL, accH;
        asm("v_dot4_i32_i8 %0, %1, %2, 0" : "=v"(accL) : "v"(buf[j].x & ML), "v"(h0));
        asm("v_dot4_i32_i8 %0, %1, %2, %3" : "=v"(accH) : "v"(buf[j].x & MH), "v"(h1), "v"(init));
        accL = __builtin_amdgcn_sdot4((int)(buf[j].y & ML), (int)h2, accL, false);
        accH = __builtin_amdgcn_sdot4((int)(buf[j].y & MH), (int)h3, accH, false);
        accL = __builtin_amdgcn_sdot4((int)(buf[j].z & ML), (int)h4, accL, false);
        accH = __builtin_amdgcn_sdot4((int)(buf[j].z & MH), (int)h5, accH, false);
        accL = __builtin_amdgcn_sdot4((int)(buf[j].w & ML), (int)h6, accL, false);
        accH = __builtin_amdgcn_sdot4((int)(buf[j].w & MH), (int)h7, accH, false);
        int acc = accL * 16 + accH;
        acc += __builtin_amdgcn_mov_dpp(acc, 0xB1, 0xF, 0xF, true);
        acc += __builtin_amdgcn_mov_dpp(acc, 0x4E, 0xF, 0xF, true);
        acc += __builtin_amdgcn_mov_dpp(acc, 0x141, 0xF, 0xF, true);
        if (c == j) keep = acc;
    }
    asm volatile("" : "+v"(keep));
}
DI int peer_u_init(const uint4& hA, const uint4& hB) {
    int sl_ = __builtin_amdgcn_sdot4((int)hA.x, 0x01010101, 0, false);
    int sh_ = __builtin_amdgcn_sdot4((int)hA.y, 0x01010101, 0, false);
    sl_ = __builtin_amdgcn_sdot4((int)hA.z, 0x01010101, sl_, false);
    sh_ = __builtin_amdgcn_sdot4((int)hA.w, 0x01010101, sh_, false);
    sl_ = __builtin_amdgcn_sdot4((int)hB.x, 0x01010101, sl_, false);
    sh_ = __builtin_amdgcn_sdot4((int)hB.y, 0x01010101, sh_, false);
    sl_ = __builtin_amdgcn_sdot4((int)hB.z, 0x01010101, sl_, false);
    sh_ = __builtin_amdgcn_sdot4((int)hB.w, 0x01010101, sh_, false);
    return 8 * sh_ - 120 * sl_;
}
DI void phase_peer_u(const Params& p, char* ws, int layer) {
    (void)p; (void)layer;
    const unsigned char* H8 = (const unsigned char*)(ws + OFF_R5 + 16ull * MiB);
    const unsigned* LIST = (const unsigned*)(ws + OFF_R5);
    const unsigned char* U4 = (const unsigned char*)(ws + OFF_R4);
    int* PART = (int*)(ws + OFF_R3);
    const int lane = get_tid() & 63;
    const int sl = lane >> 3, c = lane & 7;
    int x, wv, nwv;
    slice_assign4(x, wv, nwv);
    const unsigned coloff = (unsigned)x * (16384u * 128u) + (unsigned)c * 16u;
    const int n = (T_TOK - wv + nwv - 1) / nwv;
    if (n <= 0) return;
    const unsigned short* EID = (const unsigned short*)LIST;
    uint4 E0[2], E1[2], LE0[2], LE1[2], hA0, hB0, hA1, hB1, lhA0, lhB0, lhA1, lhB1, b0[8], b1[8], b2[8], b3[8];
    int in0, in1;
#define UTOK(I) ((unsigned)wv + __umul24((unsigned)(I), (unsigned)nwv))
#define U_LOAD_E(E, I) { const size_t t_ = UTOK(I); E[0] = nt_load_u4(EID + t_ * 128 + sl * 16); E[1] = nt_load_u4(EID + t_ * 128 + sl * 16 + 8); }
#define U_LOAD_H(HA, HB, I) { const size_t t_ = UTOK(I); HA = nt_load_u4(H8 + t_ * 1024 + x * 256 + c * 32); HB = nt_load_u4(H8 + t_ * 1024 + x * 256 + c * 32 + 16); }
#define U_STORE(I, K0, K1) { int* dst_ = PART + ((size_t)x * T_TOK + UTOK(I)) * 128 + sl * 16 + c; __builtin_nontemporal_store(K0, dst_); __builtin_nontemporal_store(K1, dst_ + 8); }
#define U_ROT(E, HA, HB, INI, LE, LHA, LHB)                                                                    \
    {                                                                                                           \
        asm volatile("" : "+v"(LE[0].x), "+v"(LE[0].y), "+v"(LE[0].z), "+v"(LE[0].w), "+v"(LE[1].x), "+v"(LE[1].y), "+v"(LE[1].z), "+v"(LE[1].w)); \
        asm volatile("" : "+v"(LHA.x), "+v"(LHA.y), "+v"(LHA.z), "+v"(LHA.w), "+v"(LHB.x), "+v"(LHB.y), "+v"(LHB.z), "+v"(LHB.w)); \
        E[0] = LE[0]; E[1] = LE[1]; HA = LHA; HB = LHB; INI = peer_u_init(LHA, LHB);                            \
    }
#define UCL(I) ((I) < n ? (I) : n - 1)
    U_LOAD_E(E0, 0)
    U_LOAD_E(E1, UCL(1))
    peer_issue(U4, E0, 0, coloff, b0);
    peer_issue(U4, E0, 1, coloff, b1);
    peer_issue(U4, E1, 0, coloff, b2);
    peer_issue(U4, E1, 1, coloff, b3);
    U_LOAD_E(LE0, UCL(2)) U_LOAD_H(lhA0, lhB0, 0)
    U_LOAD_E(LE1, UCL(3)) U_LOAD_H(lhA1, lhB1, UCL(1))
    U_ROT(E0, hA0, hB0, in0, LE0, lhA0, lhB0)
    U_ROT(E1, hA1, hB1, in1, LE1, lhA1, lhB1)
#pragma unroll 1
    for (int i = 0; i < n; i += 2) {
        U_LOAD_E(LE0, UCL(i + 4)) U_LOAD_H(lhA0, lhB0, UCL(i + 2))
        U_LOAD_E(LE1, UCL(i + 5)) U_LOAD_H(lhA1, lhB1, UCL(i + 3))
        {
            int k0 = 0, k1 = 0;
            peer_u_compute(b0, hA0, hB0, in0, c, k0);
            peer_issue(U4, E0, 0, coloff, b0);
            peer_u_compute(b1, hA0, hB0, in0, c, k1);
            peer_issue(U4, E0, 1, coloff, b1);
            U_STORE(i, k0, k1)
        }
        {
            int k0 = 0, k1 = 0;
            peer_u_compute(b2, hA1, hB1, in1, c, k0);
            peer_issue(U4, E1, 0, coloff, b2);
            peer_u_compute(b3, hA1, hB1, in1, c, k1);
            peer_issue(U4, E1, 1, coloff, b3);
            U_STORE(UCL(i + 1), k0, k1)
        }
        U_ROT(E0, hA0, hB0, in0, LE0, lhA0, lhB0)
        U_ROT(E1, hA1, hB1, in1, LE1, lhA1, lhB1)
    }
#undef UTOK
}

DI void phase_peer_act(const Params& p, char* ws, int layer) {
    (void)p;
    const unsigned short* EID = (const unsigned short*)(ws + OFF_R5);
    const unsigned short* GW = EID + (size_t)T_TOK * 128;
    const int* PART = (const int*)(ws + OFF_R3);
    unsigned short* ACT8 = (unsigned short*)(ws + OFF_R2);
    float* AS = (float*)(ws + OFF_AS);
    const float2* SC = (const float2*)(ws + OFF_SC) + (size_t)layer * 16384;
    const float* HS = (const float*)(ws + OFF_HS);
    const int tid = get_tid(), lane = tid & 63, wave = tid >> 6;
    for (int tb = (blockIdx.x * 4 + wave) * 4; tb < T_TOK; tb += gridDim.x * 16) {
        uint2 q[4][4];
        unsigned ew[4], gw[4];
        float hs[4];
#pragma unroll
        for (int u = 0; u < 4; ++u) {
            const size_t i = (size_t)(tb + u) * 128 + 2 * lane;
#pragma unroll
            for (int x = 0; x < 4; ++x) q[u][x] = *(const uint2*)(PART + (size_t)x * T_TOK * 128 + i);
            ew[u] = *(const unsigned*)(EID + i); gw[u] = *(const unsigned*)(GW + i);
            hs[u] = HS[tb + u];
        }
        float2 c0[4], c1[4];
#pragma unroll
        for (int u = 0; u < 4; ++u) { c0[u] = SC[ew[u] & 0xffffu]; c1[u] = SC[ew[u] >> 16]; }
        float a0[4], a1[4], am[4];
#pragma unroll
        for (int u = 0; u < 4; ++u) {
            const int s0 = (int)q[u][0].x + (int)q[u][1].x + (int)q[u][2].x + (int)q[u][3].x;
            const int s1 = (int)q[u][0].y + (int)q[u][1].y + (int)q[u][2].y + (int)q[u][3].y;
            a0[u] = gelu_tanh((float)s0 * c0[u].x * hs[u]) * __uint_as_float(gw[u] << 16) * c0[u].y;
            a1[u] = gelu_tanh((float)s1 * c1[u].x * hs[u]) * __uint_as_float(gw[u] & 0xffff0000u) * c1[u].y;
            am[u] = fmaxf(fabsf(a0[u]), fabsf(a1[u]));
        }
#pragma unroll
        for (int o = 32; o >= 1; o >>= 1) {
#pragma unroll
            for (int u = 0; u < 4; ++u) am[u] = fmaxf(am[u], __shfl_xor(am[u], o));
        }
#pragma unroll
        for (int u = 0; u < 4; ++u) {
            const float qs = (am[u] > 0.f) ? 127.f / am[u] : 0.f;
            const int q0 = __float2int_rn(a0[u] * qs), q1 = __float2int_rn(a1[u] * qs);
            ACT8[(size_t)(tb + u) * 64 + lane] = (unsigned short)(((unsigned)q0 & 0xffu) | (((unsigned)q1 & 0xffu) << 8));
            if (lane == 0) AS[tb + u] = am[u] * (1.f / 127.f);
        }
    }
}

template <bool FIRST>
DI void peer_v_compute(const uint4 (&buf)[4], unsigned a4, int (&out)[32]) {
    unsigned sA = 0x05010400u, sB = 0x07030602u, sC = 0x05040100u, sD = 0x07060302u;
    asm volatile("" : "+s"(sA), "+s"(sB), "+s"(sC), "+s"(sD));
    const unsigned M = 0x0F0F0F0Fu;
    const unsigned r0[4] = {buf[0].x, buf[0].y, buf[0].z, buf[0].w}, r1[4] = {buf[1].x, buf[1].y, buf[1].z, buf[1].w};
    const unsigned r2[4] = {buf[2].x, buf[2].y, buf[2].z, buf[2].w}, r3[4] = {buf[3].x, buf[3].y, buf[3].z, buf[3].w};
#pragma unroll
    for (int d = 0; d < 4; ++d) {
        const unsigned t01l = __builtin_amdgcn_perm(r1[d], r0[d], sA);
        const unsigned t01h = __builtin_amdgcn_perm(r1[d], r0[d], sB);
        const unsigned t23l = __builtin_amdgcn_perm(r3[d], r2[d], sA);
        const unsigned t23h = __builtin_amdgcn_perm(r3[d], r2[d], sB);
        unsigned T[4];
        T[0] = __builtin_amdgcn_perm(t23l, t01l, sC);
        T[1] = __builtin_amdgcn_perm(t23l, t01l, sD);
        T[2] = __builtin_amdgcn_perm(t23h, t01h, sC);
        T[3] = __builtin_amdgcn_perm(t23h, t01h, sD);
#pragma unroll
        for (int m = 0; m < 4; ++m) {
            if (FIRST) {
                asm("v_dot4_i32_i8 %0, %1, %2, 0" : "=v"(out[8 * d + 2 * m]) : "v"(T[m] & M), "v"(a4));
                asm("v_dot4_i32_i8 %0, %1, %2, 0" : "=v"(out[8 * d + 2 * m + 1]) : "v"(T[m]), "v"(a4));
            } else {
                out[8 * d + 2 * m]     = __builtin_amdgcn_sdot4((int)(T[m] & M), (int)a4, out[8 * d + 2 * m], false);
                out[8 * d + 2 * m + 1] = __builtin_amdgcn_sdot4((int)T[m], (int)a4, out[8 * d + 2 * m + 1], false);
            }
        }
    }
    asm volatile("" : "+v"(out[0]), "+v"(out[1]), "+v"(out[2]), "+v"(out[3]), "+v"(out[4]), "+v"(out[5]), "+v"(out[6]), "+v"(out[7]));
    asm volatile("" : "+v"(out[8]), "+v"(out[9]), "+v"(out[10]), "+v"(out[11]), "+v"(out[12]), "+v"(out[13]), "+v"(out[14]), "+v"(out[15]));
    asm volatile("" : "+v"(out[16]), "+v"(out[17]), "+v"(out[18]), "+v"(out[19]), "+v"(out[20]), "+v"(out[21]), "+v"(out[22]), "+v"(out[23]));
    asm volatile("" : "+v"(out[24]), "+v"(out[25]), "+v"(out[26]), "+v"(out[27]), "+v"(out[28]), "+v"(out[29]), "+v"(out[30]), "+v"(out[31]));
}
DI void peer_issue4(const unsigned char* tab, unsigned w_lo, unsigned w_hi, unsigned coloff, uint4 (&buf)[4]) {
    asm volatile("" : "+v"(w_lo), "+v"(w_hi));
    buf[0] = *(const uint4*)(tab + ((w_lo & 0xffffu) * 128u + coloff));
    buf[1] = *(const uint4*)(tab + ((w_lo >> 16) * 128u + coloff));
    buf[2] = *(const uint4*)(tab + ((w_hi & 0xffffu) * 128u + coloff));
    buf[3] = *(const uint4*)(tab + ((w_hi >> 16) * 128u + coloff));
}
DI void peer_v_reduce(const int (&out)[32], int sl, int (&r4)[4]) {
    int r16[16];
#pragma unroll
    for (int k = 0; k < 16; ++k) {
        const auto q = __builtin_amdgcn_permlane32_swap((unsigned)out[k], (unsigned)out[16 + k], false, false);
        r16[k] = (int)q[0] + (int)q[1];
    }
    int r8[8];
#pragma unroll
    for (int k = 0; k < 8; ++k) {
        const auto q = __builtin_amdgcn_permlane16_swap((unsigned)r16[k], (unsigned)r16[8 + k], false, false);
        r8[k] = (int)q[0] + (int)q[1];
    }
#pragma unroll
    for (int k = 0; k < 4; ++k) {
        const int mine = (sl & 1) ? r8[4 + k] : r8[k];
        const int send = (sl & 1) ? r8[k] : r8[4 + k];
        r4[k] = mine + __builtin_amdgcn_mov_dpp(send, 0x128, 0xF, 0xF, true);
    }
}
DI int peer_v_asum(const uint4& a) {
    int sa = __builtin_amdgcn_sdot4((int)a.x, 0x01010101, 0, false);
    sa = __builtin_amdgcn_sdot4((int)a.y, 0x01010101, sa, false);
    sa = __builtin_amdgcn_sdot4((int)a.z, 0x01010101, sa, false);
    sa = __builtin_amdgcn_sdot4((int)a.w, 0x01010101, sa, false);
    { const auto q = __builtin_amdgcn_permlane32_swap((unsigned)sa, (unsigned)sa, false, false); sa = (int)q[0] + (int)q[1]; }
    { const auto q = __builtin_amdgcn_permlane16_swap((unsigned)sa, (unsigned)sa, false, false); sa = (int)q[0] + (int)q[1]; }
    sa += __builtin_amdgcn_mov_dpp(sa, 0x128, 0xF, 0xF, true);
    return sa;
}
template <bool DRY>
DI void phase_peer_v(const Params& p, char* ws, char* smem, int layer) {
    bf16_t* X = (bf16_t*)(ws + OFF_R1);
    bf16_t* XO = DRY ? (bf16_t*)p.out : X;
    const int lj = layer * 2 + 1;
    const float* mods = (const float*)(ws + OFF_MODS) + (size_t)lj * 16 * 3072;
    const unsigned short* EID = (const unsigned short*)(ws + OFF_R5);
    const unsigned char* ACT8 = (const unsigned char*)(ws + OFF_R2);
    const float* AS = (const float*)(ws + OFF_AS);
    const unsigned char* V4 = (const unsigned char*)(ws + OFF_R4) + TAB_V_OFF;
    const int tid = get_tid(), lane = tid & 63;
    const int sl = lane >> 3, c = lane & 7;
    int x, wv, nwv;
    slice_assign4(x, wv, nwv);
    float* Gs = (float*)smem;
    for (int i = tid; i < 16 * 256; i += 256) Gs[i] = mods[(size_t)(i >> 8) * 3072 + 2048 + x * 256 + (i & 255)];
    __syncthreads();
    const unsigned coloff = (unsigned)x * (16384u * 128u) + (unsigned)c * 16u;
    const int n = (T_TOK - wv + nwv - 1) / nwv;
    if (n <= 0) return;
    const int colL = c * 32 + 4 * sl;
    const int col0 = x * 256 + colL;
    uint4 E0[2], E1[2], LE0[2], LE1[2], q0[4], q1[4], q2[4], q3[4];
    uint4 a0, a1, la0, la1;
    float as0, as1, las0, las1;
    u32x2_t x0, x1, lx0, lx1;
#define VTOK(I) ((unsigned)wv + __umul24((unsigned)(I), (unsigned)nwv))
#define VCL(I) ((I) < n ? (I) : n - 1)
#define V_LOAD_E(E, I) { const size_t t_ = VTOK(I); E[0] = nt_load_u4(EID + t_ * 128 + sl * 16); E[1] = nt_load_u4(EID + t_ * 128 + sl * 16 + 8); }
#define V_LOAD_M(A, ASV, XV, I)                                                                                \
    {                                                                                                           \
        const size_t t_ = VTOK(I);                                                                              \
        A = nt_load_u4(ACT8 + t_ * 128 + sl * 16);                                                              \
        ASV = AS[t_];                                                                                           \
        XV = __builtin_nontemporal_load((const u32x2_t*)(X + t_ * 1024 + col0));                                \
    }
#define V_ROT(E, A, ASV, XV, LE, LA, LASV, LXV)                                                                \
    {                                                                                                           \
        asm volatile("" : "+v"(LE[0].x), "+v"(LE[0].y), "+v"(LE[0].z), "+v"(LE[0].w), "+v"(LE[1].x), "+v"(LE[1].y), "+v"(LE[1].z), "+v"(LE[1].w)); \
        asm volatile("" : "+v"(LA.x), "+v"(LA.y), "+v"(LA.z), "+v"(LA.w), "+v"(LASV), "+v"(LXV.x), "+v"(LXV.y)); \
        E[0] = LE[0]; E[1] = LE[1]; A = LA; ASV = LASV; XV = LXV;                                               \
    }
#define V_SECTION(I, E, A, ASV, XV, DOIT)                                                                      \
    {                                                                                                           \
        int out[32];                                                                                            \
        peer_v_compute<true>(q0, A.x, out);                                                                     \
        peer_issue4(V4, E[0].x, E[0].y, coloff, q0);                                                            \
        peer_v_compute<false>(q1, A.y, out);                                                                           \
        peer_issue4(V4, E[0].z, E[0].w, coloff, q1);                                                            \
        peer_v_compute<false>(q2, A.z, out);                                                                           \
        peer_issue4(V4, E[1].x, E[1].y, coloff, q2);                                                            \
        peer_v_compute<false>(q3, A.w, out);                                                                           \
        peer_issue4(V4, E[1].z, E[1].w, coloff, q3);                                                            \
        int r4_[4];                                                                                             \
        peer_v_reduce(out, sl, r4_);                                                                            \
        const float sa_ = (float)peer_v_asum(A);                                                                \
        const unsigned tt_ = VTOK(I);                                                                           \
        const float4 g_ = *(const float4*)(Gs + (tt_ >> 11) * 256 + colL);                                     \
        const float xa_ = __uint_as_float(XV.x << 16), xb_ = __uint_as_float(XV.x & 0xffff0000u);               \
        const float xc_ = __uint_as_float(XV.y << 16), xd_ = __uint_as_float(XV.y & 0xffff0000u);               \
          \
        const float oa_ = xa_ + g_.x * (((float)r4_[0] - 7.5f * sa_) * (ASV));                                  \
        const float ob_ = xb_ + g_.y * (((float)(r4_[1] - r4_[0]) * 0.0625f + 0.5f * sa_) * (ASV));             \
        const float oc_ = xc_ + g_.z * (((float)r4_[2] - 7.5f * sa_) * (ASV));                                  \
        const float od_ = xd_ + g_.w * (((float)(r4_[3] - r4_[2]) * 0.0625f + 0.5f * sa_) * (ASV));             \
        u32x2_t ov__; ov__.x = pack2bf(oa_, ob_); ov__.y = pack2bf(oc_, od_);                                   \
        bf16_t* op__ = (DOIT) ? XO + (size_t)tt_ * 1024 + col0 : (bf16_t*)(ws + OFF_PTRS + 4096) + lane * 4;   \
        __builtin_nontemporal_store(ov__, (u32x2_t*)op__);                                                      \
    }
    V_LOAD_E(E0, 0)
    peer_issue4(V4, E0[0].x, E0[0].y, coloff, q0);
    peer_issue4(V4, E0[0].z, E0[0].w, coloff, q1);
    peer_issue4(V4, E0[1].x, E0[1].y, coloff, q2);
    peer_issue4(V4, E0[1].z, E0[1].w, coloff, q3);
    V_LOAD_E(LE0, VCL(1))
    V_LOAD_M(la0, las0, lx0, 0)
    V_LOAD_E(LE1, VCL(2))
    V_LOAD_M(la1, las1, lx1, VCL(1))
    V_ROT(E0, a0, as0, x0, LE0, la0, las0, lx0)
    V_ROT(E1, a1, as1, x1, LE1, la1, las1, lx1)
#pragma unroll 1
    for (int i = 0; i < n; i += 2) {
        V_LOAD_E(LE0, VCL(i + 3))
        V_LOAD_M(la0, las0, lx0, VCL(i + 2))
        V_LOAD_E(LE1, VCL(i + 4))
        V_LOAD_M(la1, las1, lx1, VCL(i + 3))
        V_SECTION(i, E0, a0, as0, x0, true)
        V_SECTION(VCL(i + 1), E1, a1, as1, x1, (i + 1 < n))
        V_ROT(E0, a0, as0, x0, LE0, la0, las0, lx0)
        V_ROT(E1, a1, as1, x1, LE1, la1, las1, lx1)
    }
#undef VTOK
}

#define AK_LD 72
#define AV_LD 200
#define AP_LD 40
DI void phase_attn(const Params& p, char* ws, char* smem) {
    const bf16_t* Qa = (const bf16_t*)(ws + OFF_R3);
    const bf16_t* Ka = Qa + (size_t)T_TOK * 1024;
    const bf16_t* VT2 = Ka + (size_t)T_TOK * 128;
    bf16_t* ATT = (bf16_t*)(ws + OFF_R4);
    const int tid = get_tid(), lane = tid & 63, wave = tid >> 6;
    const int r = lane & 31, h = lane >> 5;
    bf16_t* Ks = (bf16_t*)smem;
    bf16_t* Vs = (bf16_t*)(smem + 27648);
    float* btab = (float*)(smem + 27648 + 25600);
    bf16_t* Pw = (bf16_t*)(smem + 27648 + 25600 + 4096) + (size_t)wave * 32 * AP_LD;
    for (int unit = blockIdx.x; unit < 1024; unit += gridDim.x) {
        const int kvh = unit & 1, qh = (unit >> 1) & 31, b = unit >> 6;
        const size_t tb = (size_t)b * SEQ;
        const int Qh = qh * 64;
        const int Kb = Qh - 128;
        __syncthreads();
#pragma unroll
        for (int q = 0; q < 6; ++q) {
            const int c = tid + 256 * q, row = c >> 3, ch = c & 7;
            int kpos = Kb + row; if (kpos < 0) kpos = 0;
            *(uint4*)(Ks + row * AK_LD + ch * 8) = *(const uint4*)(Ka + (tb + kpos) * 128 + kvh * 64 + ch * 8);
        }
#pragma unroll
        for (int q = 0; q < 6; ++q) {
            const int c = tid + 256 * q, row = c / 24, ch = c % 24;
            int kpos = Kb + ch * 8; if (kpos < 0) kpos = 0;
            *(uint4*)(Vs + row * AV_LD + ch * 8) = *(const uint4*)(VT2 + ((size_t)b * 128 + kvh * 64 + row) * 2048 + kpos);
        }
        for (int i = tid; i < 8 * 128; i += 256) {
            const int g = i >> 7, n = i & 127;
            int bk = n;
            if (n >= 16) {
                const float lr = logf((float)n / 16.f) / 2.0794415416798357f;
                bk = 16 + (int)(lr * 16.f);
                if (bk > 31) bk = 31;
            }
            btab[i] = p.rel_bias[bk * 16 + kvh * 8 + g];
        }
        __syncthreads();
        for (int sub = 0; sub < 4; ++sub) {
            const int g = wave * 2 + (sub >> 1), qs = sub & 1;
            const int hq = kvh * 8 + g;
            const int Q0 = Qh + qs * 32;
            const int K0 = Q0 - 128;
            const int kl0 = K0 - Kb;
            f32x16 sacc[5];
            zero_acc<5>(sacc);
            {
                const bf16_t* Bq = Qa + (tb + Q0 + r) * 1024 + hq * 64 + h * 8;
                bf16x8 bq[4];
#pragma unroll
                for (int ks = 0; ks < 4; ++ks) bq[ks] = *(const bf16x8*)(Bq + ks * 16);
#pragma unroll
                for (int ks = 0; ks < 4; ++ks)
#pragma unroll
                    for (int kt = 0; kt < 5; ++kt)
                        sacc[kt] = MFMA32(*(const bf16x8*)(Ks + (kl0 + kt * 32 + r) * AK_LD + ks * 16 + h * 8), bq[ks], sacc[kt]);
            }
            const float sink = p.sinks[hq];
            float mx = sink;
#pragma unroll
            for (int kt = 0; kt < 5; ++kt)
#pragma unroll
                for (int i = 0; i < 16; ++i) {
                    const int kpos = K0 + kt * 32 + crow(i, h);
                    const int dist = Q0 + r - kpos;
                    float lg = NEG_INF_F;
                    if (dist >= 0 && dist < 128 && kpos >= 0) lg = sacc[kt][i] * 0.125f + btab[g * 128 + dist];
                    sacc[kt][i] = lg;
                    mx = fmaxf(mx, lg);
                }
            mx = fmaxf(mx, __shfl_xor(mx, 32));
            float sum = 0.f;
#pragma unroll
            for (int kt = 0; kt < 5; ++kt)
#pragma unroll
                for (int i = 0; i < 16; ++i) {
                    const float e = (sacc[kt][i] > -1e29f) ? __expf(sacc[kt][i] - mx) : 0.f;
                    sacc[kt][i] = e;
                    sum += e;
                }
            sum += __shfl_xor(sum, 32);
            sum += __expf(sink - mx);
            const float inv = 1.f / sum;
            f32x16 oacc[2];
            zero_acc<2>(oacc);
#pragma unroll
            for (int kt = 0; kt < 5; ++kt) {
#pragma unroll
                for (int q4 = 0; q4 < 4; ++q4) {
                    uint2 o;
                    o.x = pack2bf(sacc[kt][q4 * 4 + 0] * inv, sacc[kt][q4 * 4 + 1] * inv);
                    o.y = pack2bf(sacc[kt][q4 * 4 + 2] * inv, sacc[kt][q4 * 4 + 3] * inv);
                    *(uint2*)(Pw + r * AP_LD + q4 * 8 + h * 4) = o;
                }
#pragma unroll
                for (int ks = 0; ks < 2; ++ks) {
                    const bf16x8 ap = *(const bf16x8*)(Pw + r * AP_LD + ks * 16 + h * 8);
#pragma unroll
                    for (int nt = 0; nt < 2; ++nt)
                        oacc[nt] = MFMA32(ap, *(const bf16x8*)(Vs + (nt * 32 + r) * AV_LD + kl0 + kt * 32 + ks * 16 + h * 8), oacc[nt]);
                }
            }
            {
                bf16_t* ab = ATT + (tb + Q0 + 4 * h) * 1024 + hq * 64 + r;
#pragma unroll
                for (int i4 = 0; i4 < 4; ++i4) {
                    bf16_t* a2 = ab + (size_t)i4 * 8 * 1024;
                    LAUNDER(a2);
#pragma unroll
                    for (int ii = 0; ii < 4; ++ii)
#pragma unroll
                        for (int nt = 0; nt < 2; ++nt) a2[ii * 1024 + nt * 32] = f2bf(oacc[nt][i4 * 4 + ii]);
                }
            }
        }
    }
    __syncthreads();
}

DI void phase_final(const Params& p, const bf16_t* __restrict__ X) {
    const int tid = get_tid(), lane = tid & 63, wave = tid >> 6;
    for (int t = blockIdx.x * 4 + wave; t < T_TOK; t += gridDim.x * 4) {
        float xv[16];
        float ss = 0.f;
#pragma unroll
        for (int i = 0; i < 4; ++i) {
            const uint2 q = *(const uint2*)(X + (size_t)t * 1024 + i * 256 + lane * 4);
            const float4 v = make_float4(__uint_as_float(q.x << 16), __uint_as_float(q.x & 0xffff0000u), __uint_as_float(q.y << 16), __uint_as_float(q.y & 0xffff0000u));
            xv[i * 4 + 0] = v.x; xv[i * 4 + 1] = v.y; xv[i * 4 + 2] = v.z; xv[i * 4 + 3] = v.w;
            ss += v.x * v.x + v.y * v.y + v.z * v.z + v.w * v.w;
        }
        ss = wave_sum(ss);
        const float rinv = rsqrtf(ss * (1.f / 1024.f) + 1e-6f);
#pragma unroll
        for (int i = 0; i < 4; ++i) {
            const int col = i * 256 + lane * 4;
            const float4 g4 = *(const float4*)(p.final_g + col);
            float4 o;
            o.x = xv[i * 4 + 0] * rinv * g4.x; o.y = xv[i * 4 + 1] * rinv * g4.y;
            o.z = xv[i * 4 + 2] * rinv * g4.z; o.w = xv[i * 4 + 3] * rinv * g4.w;
            *(float4*)(p.out + (size_t)t * 1024 + col) = o;
        }
    }
}

#define NPHASES 25
template <int PH>
DI void run_phase(const Params& pk, char* smem) {
    typedef __attribute__((address_space(1))) char gchar_t;
    gchar_t* wsg = (gchar_t*)pk.ws;
    asm volatile("" : "+s"(wsg));
    char* ws = (char*)wsg;
    Params p;
    if (PH == 0) {
        p = pk;
        if (threadIdx.x < 29) {
            const void* v = pk.x;
            switch (threadIdx.x) {
                case 0: v = pk.x; break; case 1: v = pk.c; break; case 2: v = pk.ada_w; break; case 3: v = pk.ada_b; break;
                case 4: v = pk.norm_g; break; case 5: v = pk.w_in; break; case 6: v = pk.b_if; break; case 7: v = pk.conv_w; break;
                case 8: v = pk.conv_b; break; case 9: v = pk.w_q; break; case 10: v = pk.w_k; break; case 11: v = pk.head_g; break;
                case 12: v = pk.skip; break; case 13: v = pk.pool_w; break; case 14: v = pk.pool_scale; break; case 15: v = pk.w_out; break;
                case 16: v = pk.w_qkv; break; case 17: v = pk.b_qkv; break; case 18: v = pk.sinks; break; case 19: v = pk.w_o; break;
                case 20: v = pk.b_o; break; case 21: v = pk.rel_bias; break; case 22: v = pk.peer_wq; break; case 23: v = pk.peer_keys; break;
                case 24: v = pk.peer_u; break; case 25: v = pk.peer_v; break; case 26: v = pk.final_g; break; case 27: v = pk.out; break;
                default: v = pk.ws; break;
            }
            ((const void**)(ws + OFF_PTRS))[threadIdx.x] = v;
        }
    } else {
        const float* const* tab = (const float* const*)(ws + OFF_PTRS);
        p.x = tab[0]; p.c = tab[1]; p.ada_w = tab[2]; p.ada_b = tab[3]; p.norm_g = tab[4]; p.w_in = tab[5]; p.b_if = tab[6]; p.conv_w = tab[7];
        p.conv_b = tab[8]; p.w_q = tab[9]; p.w_k = tab[10]; p.head_g = tab[11]; p.skip = tab[12]; p.pool_w = tab[13]; p.pool_scale = tab[14];
        p.w_out = tab[15]; p.w_qkv = tab[16]; p.b_qkv = tab[17]; p.sinks = tab[18]; p.w_o = tab[19]; p.b_o = tab[20]; p.rel_bias = tab[21];
        p.peer_wq = tab[22]; p.peer_keys = tab[23]; p.peer_u = tab[24]; p.peer_v = tab[25]; p.final_g = tab[26]; p.out = (float*)tab[27]; p.ws = ws;
    }
    bf16_t* X = (bf16_t*)(ws + OFF_R1);
    const float* mods = (const float*)(ws + OFF_MODS);
    if (PH == 0) { phase_pre_mods(p, ws, smem); phase_pre_scoremat(p, ws, smem); }
    else if (PH == 1) { phase_adanorm<true, true, false>(p, ws, p.x, 0, smem); phase_pre_weights(p, ws, smem); }
    else if (PH == 2) { GemmArgs ga{}; ga.A = (const bf16_t*)(ws + OFF_R5 + 16ull * MiB); ga.Bt = (const bf16_t*)(ws + OFF_WINT); ga.N = 2048; ga.hs = (const float*)(ws + OFF_HS); ga.wsc = (const float*)(ws + OFF_WSC); phase_gemm<GM_INPROJ, true>(p, ws, ga, smem); }
    else if (PH == 3) {   }
    else if (PH == 4) phase_m1b(p, ws, smem);
    else if (PH == 5) phase_m2(p, ws);
    else if (PH == 6) phase_m3(p, ws, smem);
    else if (PH == 7) {
        GemmArgs ga{}; ga.A = (const bf16_t*)(ws + OFF_R4); ga.Bt = (const bf16_t*)(ws + OFF_WOUTT); ga.N = 1024;
        ga.xin = p.x; ga.xout = X; ga.gate = mods + (size_t)0 * 16 * 3072 + 2048; ga.bias = nullptr;
        phase_gemm<GM_RESID, false>(p, ws, ga, smem);
    }
    else if (PH == 8) phase_adanorm<false, true, true>(p, ws, X, 1, smem);
    else if (PH == 9) { GemmArgs ga{}; ga.A = (const bf16_t*)(ws + OFF_R5 + 16ull * MiB); ga.Bt = (const bf16_t*)(ws + OFF_WPQT); ga.N = 2048; ga.out = (bf16_t*)(ws + OFF_R3); ga.hs = (const float*)(ws + OFF_HS); ga.wsc = (const float*)(ws + OFF_WSC) + 3328; phase_gemm<GM_PLAIN, true>(p, ws, ga, smem); }
    else if (PH == 10) phase_topk(p, ws, 0, smem);
    else if (PH == 11) phase_peer_u(p, ws, 0);
    else if (PH == 12) phase_peer_act(p, ws, 0);
    else if (PH == 13) phase_peer_v<false>(p, ws, smem, 0);
    else if (PH == 14) phase_adanorm<false, true, true>(p, ws, X, 2, smem);
    else if (PH == 15) { GemmArgs ga{}; ga.A = (const bf16_t*)(ws + OFF_R5 + 16ull * MiB); ga.Bt = (const bf16_t*)(ws + OFF_WQKVT); ga.N = 1280; ga.hs = (const float*)(ws + OFF_HS); ga.wsc = (const float*)(ws + OFF_WSC) + 2048; phase_gemm<GM_QKV, true>(p, ws, ga, smem); }
    else if (PH == 16) phase_attn(p, ws, smem);
    else if (PH == 17 || PH == 27) {
        GemmArgs ga{}; ga.A = (const bf16_t*)(ws + OFF_R4); ga.Bt = (const bf16_t*)(ws + OFF_WOT); ga.N = 1024;
        ga.xin = X; ga.xout = (PH == 27) ? (bf16_t*)p.out : X; ga.gate = mods + (size_t)2 * 16 * 3072 + 2048; ga.bias = p.b_o;
        phase_gemm<GM_RESID_BF, false>(p, ws, ga, smem);
    }
    else if (PH == 18) phase_adanorm<false, true, true>(p, ws, X, 3, smem);
    else if (PH == 19) { GemmArgs ga{}; ga.A = (const bf16_t*)(ws + OFF_R5 + 16ull * MiB); ga.Bt = (const bf16_t*)(ws + OFF_WPQT + (size_t)2048 * 1024); ga.N = 2048; ga.out = (bf16_t*)(ws + OFF_R3); ga.hs = (const float*)(ws + OFF_HS); ga.wsc = (const float*)(ws + OFF_WSC) + 5376; phase_gemm<GM_PLAIN, true>(p, ws, ga, smem); }
    else if (PH == 20) phase_topk(p, ws, 1, smem);
    else if (PH == 21) phase_peer_u(p, ws, 1);
    else if (PH == 22) phase_peer_act(p, ws, 1);
    else if (PH == 23) phase_peer_v<false>(p, ws, smem, 1);
    else if (PH == 24) phase_final(p, X);
    else if (PH == 25) phase_peer_v<true>(p, ws, smem, 0);
    else if (PH == 26) phase_peer_v<true>(p, ws, smem, 1);
}

extern __shared__ __attribute__((aligned(16))) char dyn_smem[];

#define LDS_GEMM 73728
#define LDS_BYTES (LDS_GEMM + 16)

#if !ONE_LAUNCH
template <int PH>
__global__ void __launch_bounds__(256, 2) k_phase(Params p) { run_phase<PH>(p, dyn_smem); }

template <int PH>
static void launch_phase(const Params& p, int grid, hipStream_t stream) {
    (void)hipFuncSetAttribute((const void*)k_phase<PH>, hipFuncAttributeMaxDynamicSharedMemorySize, LDS_BYTES);
    hipLaunchKernelGGL(k_phase<PH>, dim3(grid), dim3(256), LDS_BYTES, stream, p);
}
template <int PH>
static void launch_all(const Params& p, int grid, hipStream_t stream) {
    launch_phase<PH>(p, grid, stream);
    if constexpr (PH + 1 < NPHASES) launch_all<PH + 1>(p, grid, stream);
}
#else
template <int PH>
DI void fused_from(const Params& p, volatile LAS unsigned* st) {
    run_phase<PH>(p, dyn_smem);
    if ((PROBE_MASK >> PH) & 1u) run_phase<(PH == 13) ? 25 : (PH == 23) ? 26 : (PH == 17) ? 27 : PH>(p, dyn_smem);
    if constexpr (PH + 1 < NPHASES && PH != 3) {
        { XcdBarrier bar_; bar_.bar = (unsigned*)(p.ws + OFF_BAR); bar_.x = xb_xcc_id(); bar_.st = st; xcd_barrier(bar_); }
        fused_from<PH + 1>(p, st);
    } else if constexpr (PH + 1 < NPHASES) {
        fused_from<PH + 1>(p, st);
    }
}
__global__ void __launch_bounds__(256, 2) k_fused(Params p) {
    volatile LAS unsigned* st = (volatile LAS unsigned*)(dyn_smem + LDS_GEMM);
    if (threadIdx.x == 0) { st[0] = 0u; st[1] = 0u; st[2] = 0u; st[3] = 0u; }
    __syncthreads();
    (void)xcd_barrier_post((unsigned*)(p.ws + OFF_BAR), st);
    fused_from<0>(p, st);
}
#endif

extern "C" void kernel_launch(void* const* d_in, const int* in_sizes, int n_in, void* d_out, int out_size, void* d_ws, size_t ws_size,
                              hipStream_t stream) {
    (void)in_sizes; (void)n_in; (void)out_size;
    Params p{};
    const float** pp = (const float**)&p;
    for (int i = 0; i < 27; ++i) pp[i] = (const float*)d_in[i];
    p.out = (float*)d_out;
    p.ws = (char*)d_ws;
    if (ws_size < WS_NEEDED) fprintf(stderr, "workspace too small: %zu < %llu\n", ws_size, (unsigned long long)WS_NEEDED);
#if !ONE_LAUNCH
    const int grid = 512;
    launch_all<0>(p, grid, stream);
#else
    static int grid = 0;
    if (!grid) {
        int dev = 0, cus = 0, per_cu = 0;
        (void)hipGetDevice(&dev);
        (void)hipDeviceGetAttribute(&cus, hipDeviceAttributeMultiprocessorCount, dev);
        (void)hipFuncSetAttribute((const void*)k_fused, hipFuncAttributeMaxDynamicSharedMemorySize, LDS_BYTES);
        (void)hipOccupancyMaxActiveBlocksPerMultiprocessor(&per_cu, (const void*)k_fused, 256, LDS_BYTES);
        if (per_cu < 1) per_cu = 1;
        if (cus < 1) cus = 256;
        grid = cus * (per_cu < 2 ? per_cu : 2);
    }
    (void)hipMemsetAsync(d_ws, 0, XCD_BAR_WORDS * sizeof(unsigned), stream);
    hipLaunchKernelGGL(k_fused, dim3(grid), dim3(256), LDS_BYTES, stream, p);
#endif
}
```

```cpp
#include <hip/hip_runtime.h>
#include <stdint.h>
#include <stdio.h>

#ifndef ONE_LAUNCH
#define ONE_LAUNCH 1
#endif
#ifndef PROBE_MASK
#define PROBE_MASK 0u
#endif

#define DI __device__ __forceinline__
typedef unsigned short bf16_t;
typedef __attribute__((ext_vector_type(8))) short bf16x8;
typedef __attribute__((ext_vector_type(16))) float f32x16;
typedef unsigned u32x4_t __attribute__((ext_vector_type(4)));
typedef float f32x4n_t __attribute__((ext_vector_type(4)));
typedef unsigned u32x2_t __attribute__((ext_vector_type(2)));
#define MFMA32(a, b, c) __builtin_amdgcn_mfma_f32_32x32x16_bf16((a), (b), (c), 0, 0, 0)

#define T_TOK 32768
#define SEQ 2048
#define NBATCH 16
#define DM 1024
#define NEG_INF_F (-1e30f)

#define MiB (1024ull * 1024ull)
#define OFF_BAR     0ull
#define OFF_MODS    (16ull * 1024)
#define OFF_WGT     (1ull * MiB)
#define OFF_IPRE    (OFF_WGT + 64ull * 1024)
#define OFF_LOGF    (OFF_IPRE + 512ull * 1024)
#define OFF_G       (OFF_LOGF + 512ull * 1024)
#define OFF_BV      (OFF_G + 512ull * 1024)
#define OFF_USC     (OFF_BV + 512ull * 1024)
#define OFF_ND      (OFF_USC + 64ull * 1024)
#define OFF_NIN     (OFF_ND + 512ull * 1024)
#define OFF_HS      (27ull * MiB)
#define OFF_PTRS    (27ull * MiB + 512ull * 1024)
#define OFF_AS      (27ull * MiB + 256ull * 1024)
#define OFF_WSC     (27ull * MiB + 768ull * 1024)
#define OFF_SC      (26ull * MiB)
#define OFF_WINT    (4ull * MiB)
#define OFF_WOUTT   (8ull * MiB)
#define OFF_WQKVT   (10ull * MiB)
#define OFF_WOT     (13ull * MiB)
#define OFF_WPQT    (15ull * MiB)
#define OFF_WQT     (23ull * MiB)
#define OFF_WKT     (OFF_WQT + 128ull * 1024)
#define OFF_PWT     (OFF_WKT + 128ull * 1024)
#define OFF_KEYS    (24ull * MiB)
#define OFF_R1      (32ull * MiB)
#define OFF_M       (OFF_R1 + 64ull * MiB)
#define OFF_R2      (160ull * MiB)
#define OFF_R3      (224ull * MiB)
#define OFF_R4      (352ull * MiB)
#define OFF_R5      (416ull * MiB)
#define WS_NEEDED   (512ull * MiB)

struct Params {
    const float *x, *c, *ada_w, *ada_b, *norm_g, *w_in, *b_if, *conv_w, *conv_b, *w_q, *w_k, *head_g, *skip, *pool_w,
        *pool_scale, *w_out, *w_qkv, *b_qkv, *sinks, *w_o, *b_o, *rel_bias, *peer_wq, *peer_keys, *peer_u, *peer_v, *final_g;
    float* out;
    char* ws;
};


#define XB_TMO      128
#define XB_XCNT(j)  (256  + 64 * (j))
#define XB_XSUB(j)  (1280 + 64 * (j))
#define XB_XGEN(j)  (2304 + 64 * (j))
#define XB_TOP      3328
#define XB_TOPGEN   3392
#define XCD_BAR_WORDS 3456
#define XB_SPIN_CAP (1u << 18)
#define LAS __attribute__((address_space(3)))

__device__ __forceinline__ unsigned xb_ld(unsigned* p)              { return __hip_atomic_load(p, __ATOMIC_RELAXED, __HIP_MEMORY_SCOPE_AGENT); }
__device__ __forceinline__ unsigned xb_add(unsigned* p, unsigned v) { return __hip_atomic_fetch_add(p, v, __ATOMIC_RELAXED, __HIP_MEMORY_SCOPE_AGENT); }
__device__ __forceinline__ unsigned xb_xcc_id() { return (unsigned)__builtin_amdgcn_s_getreg((3 << 11) | 20) & 0xFu; }
#define XB_SPIN(cond, bar) do { unsigned _sp = 0; while (cond) { __builtin_amdgcn_s_sleep(1); \
    if ((++_sp & 255u) == 0u) { if (xb_ld(&(bar)[XB_TMO])) break; if (_sp > XB_SPIN_CAP) { atomicAdd(&(bar)[XB_TMO], 1u); break; } } } } while (0)

struct XcdBarrier {
    unsigned* bar; unsigned x;
    volatile LAS unsigned* st;
};

__device__ __forceinline__ XcdBarrier xcd_barrier_post(unsigned* bar, volatile LAS unsigned* st) {
    XcdBarrier b; b.bar = bar; b.x = xb_xcc_id(); b.st = st;
    if (threadIdx.x == 0) (void)xb_add(&bar[XB_XCNT(b.x)], 1u);
    return b;
}
__device__ __forceinline__ void xcd_barrier_complete(unsigned* bar, unsigned x, unsigned& nloc, unsigned& nx) {
    const unsigned G = gridDim.x * gridDim.y * gridDim.z;
    unsigned sum, cnt, mine, sp = 0u;
    for (;;) {
        sum = 0u; cnt = 0u; mine = 0u;
#pragma unroll
        for (unsigned j = 0; j < 16; ++j) { const unsigned c = xb_ld(&bar[XB_XCNT(j)]); sum += c; cnt += (c > 0u) ? 1u : 0u; mine = (j == x) ? c : mine; }
        if (sum == G) break;
        __builtin_amdgcn_s_sleep(1);
        if ((++sp & 255u) == 0u) { if (xb_ld(&bar[XB_TMO])) break; if (sp > XB_SPIN_CAP) { atomicAdd(&bar[XB_TMO], 1u); break; } }
    }
    nloc = mine > 0u ? mine : 1u; nx = cnt > 0u ? cnt : 1u;
}
__device__ __forceinline__ void xcd_barrier(const XcdBarrier& b) {
    asm volatile("s_waitcnt vmcnt(0)" ::: "memory");
    __syncthreads();
    if (threadIdx.x == 0) {
        unsigned* bar = b.bar;
        __builtin_amdgcn_s_waitcnt(0);
        unsigned nloc = b.st[0], nx = b.st[1];
        if (nloc == 0u) { xcd_barrier_complete(bar, b.x, nloc, nx); b.st[0] = nloc; b.st[1] = nx; }
        const unsigned old = xb_add(&bar[XB_XSUB(b.x)], 1u);
        const unsigned gen = old / nloc;
        if (old + 1u == (gen + 1u) * nloc) {
            __builtin_amdgcn_fence(__ATOMIC_RELEASE, "agent");
            asm volatile("s_waitcnt vmcnt(0)" ::: "memory");
            const unsigned og = xb_add(&bar[XB_TOP], 1u);
            const unsigned tg = og / nx;
            if (og + 1u == (tg + 1u) * nx) xb_add(&bar[XB_TOPGEN], 1u);
            else XB_SPIN(xb_ld(&bar[XB_TOPGEN]) == tg, bar);
            __builtin_amdgcn_fence(__ATOMIC_ACQUIRE, "agent");
            xb_add(&bar[XB_XGEN(b.x)], 1u);
            asm volatile("s_waitcnt vmcnt(0)" ::: "memory");
        } else {
            XB_SPIN(xb_ld(&bar[XB_XGEN(b.x)]) == gen, bar);
            __builtin_amdgcn_fence(__ATOMIC_ACQUIRE, "agent");
            asm volatile("s_waitcnt vmcnt(0)" ::: "memory");
        }
    }
    __syncthreads();
}

DI bf16_t f2bf(float x) {
    unsigned u = __float_as_uint(x);
    u += 0x7fffu + ((u >> 16) & 1u);
    return (bf16_t)(u >> 16);
}
DI float bf2f(bf16_t h) { return __uint_as_float(((unsigned)h) << 16); }
DI unsigned pack2bf(float a, float b) { return (unsigned)f2bf(a) | ((unsigned)f2bf(b) << 16); }
DI int get_tid() { int t = (int)threadIdx.x; asm volatile("" : "+v"(t)); return t; }
DI int crow(int i, int h) { return (i & 3) + 8 * (i >> 2) + 4 * h; }
DI float wave_sum(float v) {
#pragma unroll
    for (int o = 32; o >= 1; o >>= 1) v += __shfl_xor(v, o);
    return v;
}
DI float wave_sum_dpp(float v) {
    v += __int_as_float(__builtin_amdgcn_mov_dpp(__float_as_int(v), 0xB1, 0xF, 0xF, true));
    v += __int_as_float(__builtin_amdgcn_mov_dpp(__float_as_int(v), 0x4E, 0xF, 0xF, true));
    v += __int_as_float(__builtin_amdgcn_mov_dpp(__float_as_int(v), 0x141, 0xF, 0xF, true));
    v += __int_as_float(__builtin_amdgcn_mov_dpp(__float_as_int(v), 0x140, 0xF, 0xF, true));
    return __int_as_float(__builtin_amdgcn_readlane(__float_as_int(v), 0)) + __int_as_float(__builtin_amdgcn_readlane(__float_as_int(v), 16)) +
           __int_as_float(__builtin_amdgcn_readlane(__float_as_int(v), 32)) + __int_as_float(__builtin_amdgcn_readlane(__float_as_int(v), 48));
}
DI float wave_max_dpp(float v) {
    v = fmaxf(v, __int_as_float(__builtin_amdgcn_mov_dpp(__float_as_int(v), 0xB1, 0xF, 0xF, true)));
    v = fmaxf(v, __int_as_float(__builtin_amdgcn_mov_dpp(__float_as_int(v), 0x4E, 0xF, 0xF, true)));
    v = fmaxf(v, __int_as_float(__builtin_amdgcn_mov_dpp(__float_as_int(v), 0x141, 0xF, 0xF, true)));
    v = fmaxf(v, __int_as_float(__builtin_amdgcn_mov_dpp(__float_as_int(v), 0x140, 0xF, 0xF, true)));
    return fmaxf(fmaxf(__int_as_float(__builtin_amdgcn_readlane(__float_as_int(v), 0)), __int_as_float(__builtin_amdgcn_readlane(__float_as_int(v), 16))),
                 fmaxf(__int_as_float(__builtin_amdgcn_readlane(__float_as_int(v), 32)), __int_as_float(__builtin_amdgcn_readlane(__float_as_int(v), 48))));
}
DI float half_sum(float v) {
    v += __int_as_float(__builtin_amdgcn_mov_dpp(__float_as_int(v), 0xB1, 0xF, 0xF, true));
    v += __int_as_float(__builtin_amdgcn_mov_dpp(__float_as_int(v), 0x4E, 0xF, 0xF, true));
    v += __int_as_float(__builtin_amdgcn_mov_dpp(__float_as_int(v), 0x141, 0xF, 0xF, true));
    v += __int_as_float(__builtin_amdgcn_mov_dpp(__float_as_int(v), 0x140, 0xF, 0xF, true));
    const auto q = __builtin_amdgcn_permlane16_swap(__float_as_uint(v), __float_as_uint(v), false, false);
    return __uint_as_float(q[0]) + __uint_as_float(q[1]);
}
DI float half_max(float v) {
    v = fmaxf(v, __int_as_float(__builtin_amdgcn_mov_dpp(__float_as_int(v), 0xB1, 0xF, 0xF, true)));
    v = fmaxf(v, __int_as_float(__builtin_amdgcn_mov_dpp(__float_as_int(v), 0x4E, 0xF, 0xF, true)));
    v = fmaxf(v, __int_as_float(__builtin_amdgcn_mov_dpp(__float_as_int(v), 0x141, 0xF, 0xF, true)));
    v = fmaxf(v, __int_as_float(__builtin_amdgcn_mov_dpp(__float_as_int(v), 0x140, 0xF, 0xF, true)));
    const auto q = __builtin_amdgcn_permlane16_swap(__float_as_uint(v), __float_as_uint(v), false, false);
    return fmaxf(__uint_as_float(q[0]), __uint_as_float(q[1]));
}
DI unsigned half_umax(unsigned v) {
#pragma unroll
    for (int o = 16; o >= 1; o >>= 1) { unsigned t = (unsigned)__shfl_xor((int)v, o); v = v > t ? v : t; }
    return v;
}
DI float sigmoidf_(float x) { return 1.f / (1.f + __expf(-x)); }
DI float siluf_(float x) { return x * sigmoidf_(x); }
DI float gelu_tanh(float x) {
    const float k0 = 0.7978845608028654f, k1 = 0.044715f;
    float u = k0 * (x + k1 * x * x * x);
    float t = 1.f - 2.f / (1.f + __expf(2.f * u));
    return 0.5f * x * (1.f + t);
}
DI float logsigmoidf_(float x) { return fminf(x, 0.f) - log1pf(__expf(-fabsf(x))); }

template <int N> DI void zero_acc(f32x16 (&acc)[N]) {
#pragma unroll
    for (int n = 0; n < N; ++n)
#pragma unroll
        for (int i = 0; i < 16; ++i) acc[n][i] = 0.f;
}

template <int NT, int KSTEPS, typename PA, typename PB>
DI void wave_mma(f32x16 (&acc)[NT], PA A, int lda, PB B, int ldb, int lane) {
    const int r = lane & 31, h = lane >> 5;
    bf16x8 a0, b0[NT], a1, b1[NT];
    a0 = *(const bf16x8*)(A + (size_t)r * lda + h * 8);
#pragma unroll
    for (int nt = 0; nt < NT; ++nt) b0[nt] = *(const bf16x8*)(B + (size_t)(nt * 32 + r) * ldb + h * 8);
#pragma unroll
    for (int ks = 0; ks < KSTEPS; ks += 2) {
        if (ks + 1 < KSTEPS) {
            a1 = *(const bf16x8*)(A + (size_t)r * lda + (ks + 1) * 16 + h * 8);
#pragma unroll
            for (int nt = 0; nt < NT; ++nt) b1[nt] = *(const bf16x8*)(B + (size_t)(nt * 32 + r) * ldb + (ks + 1) * 16 + h * 8);
        }
        asm volatile("" ::: "memory");
#pragma unroll
        for (int nt = 0; nt < NT; ++nt) acc[nt] = MFMA32(a0, b0[nt], acc[nt]);
        if (ks + 1 < KSTEPS) {
            if (ks + 2 < KSTEPS) {
                a0 = *(const bf16x8*)(A + (size_t)r * lda + (ks + 2) * 16 + h * 8);
#pragma unroll
                for (int nt = 0; nt < NT; ++nt) b0[nt] = *(const bf16x8*)(B + (size_t)(nt * 32 + r) * ldb + (ks + 2) * 16 + h * 8);
            }
            asm volatile("" ::: "memory");
#pragma unroll
            for (int nt = 0; nt < NT; ++nt) acc[nt] = MFMA32(a1, b1[nt], acc[nt]);
        }
    }
}

DI void phase_pre_mods(const Params& p, char* ws, char* smem) {
    float* cond = (float*)smem;
    float* mods = (float*)(ws + OFF_MODS);
    const int tid = get_tid();
    for (int unit = blockIdx.x; unit < 384; unit += gridDim.x) {
        const int lj = unit / 96, n0 = (unit % 96) * 32;
        __syncthreads();
        for (int i = tid; i < 16 * 1024; i += 256) cond[i] = siluf_(p.c[i]);
        __syncthreads();
        const int ksl = tid >> 5, col = tid & 31;
        const float* W = p.ada_w + (size_t)lj * 1024 * 3072 + n0 + col;
        float acc[16];
#pragma unroll
        for (int b = 0; b < 16; ++b) acc[b] = 0.f;
        for (int kk0 = 0; kk0 < 128; kk0 += 16) {
            float wv_[16];
#pragma unroll
            for (int q = 0; q < 16; ++q) wv_[q] = W[(size_t)(ksl * 128 + kk0 + q) * 3072];
#pragma unroll
            for (int q = 0; q < 16; ++q) {
                const int k = ksl * 128 + kk0 + q;
#pragma unroll
                for (int b = 0; b < 16; ++b) acc[b] += cond[b * 1024 + k] * wv_[q];
            }
        }
        __syncthreads();
        float* red = (float*)smem;
#pragma unroll
        for (int b = 0; b < 16; ++b) red[(ksl * 16 + b) * 32 + col] = acc[b];
        __syncthreads();
        for (int o = tid; o < 512; o += 256) {
            const int b = o >> 5, cc = o & 31;
            float s = 0.f;
#pragma unroll
            for (int q = 0; q < 8; ++q) s += red[(q * 16 + b) * 32 + cc];
            mods[((size_t)lj * 16 + b) * 3072 + n0 + cc] = s + p.ada_b[(size_t)lj * 3072 + n0 + cc];
        }
    }
    __syncthreads();
}

DI void transpose_job(const float* __restrict__ src, int ldsrc, int K, int N, bf16_t* __restrict__ dst, const float* nscale, float cscale,
                      int tile, float* tl) {
    const int tiles_n = N / 32;
    const int tk = tile / tiles_n, tn = tile % tiles_n;
    const int tid_ = get_tid();
    const int tx = tid_ & 31, ty = tid_ >> 5;
    __syncthreads();
#pragma unroll
    for (int q = 0; q < 4; ++q) {
        const int k = tk * 32 + ty + q * 8;
        tl[(ty + q * 8) * 33 + tx] = src[(size_t)k * ldsrc + tn * 32 + tx];
    }
    __syncthreads();
#pragma unroll
    for (int q = 0; q < 4; ++q) {
        const int n = tn * 32 + ty + q * 8;
        float v = tl[tx * 33 + ty + q * 8] * cscale;
        if (nscale) v *= nscale[n];
        dst[(size_t)n * K + tk * 32 + tx] = f2bf(v);
    }
}

DI void quant_job(const float* __restrict__ src, int ldsrc, unsigned char* __restrict__ dst, float* __restrict__ wsc, int n0, float* red) {
    const int tid = get_tid(), tx = tid & 31, ty = tid >> 5;
    const float* col = src + n0 + tx;
    float am = 0.f;
    for (int k = ty; k < 1024; k += 8) am = fmaxf(am, fabsf(col[(size_t)k * ldsrc]));
    __syncthreads();
    red[ty * 32 + tx] = am;
    __syncthreads();
#pragma unroll
    for (int q = 0; q < 8; ++q) am = fmaxf(am, red[q * 32 + tx]);
    const float sc = (am > 0.f) ? 127.f / am : 0.f;
    if (ty == 0) wsc[n0 + tx] = am * (1.f / 127.f);
    unsigned char* drow = dst + (size_t)(n0 + tx) * 1024 + ty * 128;
    for (int k4 = 0; k4 < 32; k4 += 4) {
        unsigned w[4];
#pragma unroll
        for (int q = 0; q < 4; ++q) {
            const int k = ty * 128 + (k4 + q) * 4;
            const int q0 = __float2int_rn(col[(size_t)(k + 0) * ldsrc] * sc), q1 = __float2int_rn(col[(size_t)(k + 1) * ldsrc] * sc);
            const int q2 = __float2int_rn(col[(size_t)(k + 2) * ldsrc] * sc), q3 = __float2int_rn(col[(size_t)(k + 3) * ldsrc] * sc);
            w[q] = ((unsigned)q0 & 0xffu) | (((unsigned)q1 & 0xffu) << 8) | (((unsigned)q2 & 0xffu) << 16) | (((unsigned)q3 & 0xffu) << 24);
        }
        *(uint4*)(drow + k4 * 4) = make_uint4(w[0], w[1], w[2], w[3]);
    }
}
DI void phase_pre_weights(const Params& p, char* ws, char* smem) {
    {
        float* red = (float*)smem;
        float* wsc = (float*)(ws + OFF_WSC);
        for (int j = blockIdx.x; j < 64 + 40 + 64 + 64; j += gridDim.x) {
            if (j < 64) quant_job(p.w_in, 2056, (unsigned char*)(ws + OFF_WINT), wsc, j * 32, red);
            else if (j < 104) quant_job(p.w_qkv, 1280, (unsigned char*)(ws + OFF_WQKVT), wsc + 2048, (j - 64) * 32, red);
            else if (j < 168) quant_job((const float*)(ws + OFF_M), 2048, (unsigned char*)(ws + OFF_WPQT), wsc + 3328, (j - 104) * 32, red);
            else quant_job((const float*)(ws + OFF_M) + (size_t)1024 * 2048, 2048, (unsigned char*)(ws + OFF_WPQT) + (size_t)2048 * 1024, wsc + 5376, (j - 168) * 32, red);
        }
        __syncthreads();
    }
    float* tl = (float*)smem;
    const int J1 = 32 * 32;
    const int J3 = 32 * 32;
    const int J6 = 4 * 16;
    const int J7 = 4 * 16;
    const int J8 = 4 * 16;
    const int total = J1 + J3 + J6 + J7 + J8;
    for (int j = blockIdx.x; j < total; j += gridDim.x) {
        int t = j;
        if (t < J1) { transpose_job(p.w_out, 1024, 1024, 1024, (bf16_t*)(ws + OFF_WOUTT), nullptr, 1.f, t, tl); continue; }
        t -= J1;
        if (t < J3) { transpose_job(p.w_o, 1024, 1024, 1024, (bf16_t*)(ws + OFF_WOT), nullptr, 1.f, t, tl); continue; }
        t -= J3;
        if (t < J6) { const int hh = t / 16; transpose_job(p.w_q + (size_t)hh * 16384, 128, 128, 128, (bf16_t*)(ws + OFF_WQT) + (size_t)hh * 16384, nullptr, 1.f, t % 16, tl); continue; }
        t -= J6;
        if (t < J7) { const int hh = t / 16; transpose_job(p.w_k + (size_t)hh * 16384, 128, 128, 128, (bf16_t*)(ws + OFF_WKT) + (size_t)hh * 16384, nullptr, 0.08838834764831845f, t % 16, tl); continue; }
        t -= J7;
        { const int g = t / 16; transpose_job(p.pool_w + (size_t)g * 16384, 128, 128, 128, (bf16_t*)(ws + OFF_PWT) + (size_t)g * 16384, p.pool_scale + g * 128, 1.f, t % 16, tl); }
    }
    const size_t gtid = (size_t)blockIdx.x * 256 + get_tid(), gsz = (size_t)gridDim.x * 256;
    bf16_t* keys = (bf16_t*)(ws + OFF_KEYS);
    for (size_t i = gtid; i < (size_t)2 * 8 * 2 * 128 * 128; i += gsz) keys[i] = f2bf(p.peer_keys[i]);
    __syncthreads();
}

typedef __bf16 bf16x2_t __attribute__((ext_vector_type(2)));
DI unsigned cvt_pk_bf16(float a, float b) { unsigned r; asm("v_cvt_pk_bf16_f32 %0, %1, %2" : "=v"(r) : "v"(a), "v"(b)); return r; }
DI float dot2_bf16(unsigned a, unsigned b, float c) { return __builtin_amdgcn_fdot2_f32_bf16(__builtin_bit_cast(bf16x2_t, a), __builtin_bit_cast(bf16x2_t, b), c, false); }
template <bool GATES, bool WITH_H8, bool XBF>
DI void phase_adanorm(const Params& p, char* ws, const void* __restrict__ Xv, int lj, char* smem) {
    unsigned char* H8 = (unsigned char*)(ws + OFF_R5 + 16ull * MiB);
    const float* mods = (const float*)(ws + OFF_MODS) + (size_t)lj * 16 * 3072;
    const float* ng = p.norm_g + (size_t)lj * 1024;
    const int tid = get_tid(), lane = tid & 63, wave = tid >> 6;
    (void)smem;
    unsigned wgp[8][8];
    if (GATES) {
#pragma unroll
        for (int q = 0; q < 8; ++q) {
            const int col = (q >> 1) * 256 + lane * 4 + (q & 1) * 2;
            const float4 a0 = *(const float4*)(p.w_in + (size_t)col * 2056 + 2048), a1 = *(const float4*)(p.w_in + (size_t)col * 2056 + 2052);
            const float4 b0 = *(const float4*)(p.w_in + (size_t)(col + 1) * 2056 + 2048), b1 = *(const float4*)(p.w_in + (size_t)(col + 1) * 2056 + 2052);
            wgp[0][q] = cvt_pk_bf16(a0.x, b0.x); wgp[1][q] = cvt_pk_bf16(a0.y, b0.y); wgp[2][q] = cvt_pk_bf16(a0.z, b0.z); wgp[3][q] = cvt_pk_bf16(a0.w, b0.w);
            wgp[4][q] = cvt_pk_bf16(a1.x, b1.x); wgp[5][q] = cvt_pk_bf16(a1.y, b1.y); wgp[6][q] = cvt_pk_bf16(a1.z, b1.z); wgp[7][q] = cvt_pk_bf16(a1.w, b1.w);
        }
    }
    for (int unit = blockIdx.x; unit < T_TOK / 64; unit += gridDim.x) {
        const int row0 = unit * 64, b = row0 >> 11;
        float am[16], sh[16];
#pragma unroll
        for (int i = 0; i < 4; ++i) {
            const int col = i * 256 + lane * 4;
            const float4 g4 = *(const float4*)(ng + col);
            const float4 s4 = *(const float4*)(mods + (size_t)b * 3072 + col);
            const float4 c4 = *(const float4*)(mods + (size_t)b * 3072 + 1024 + col);
            am[i * 4 + 0] = g4.x * (1.f + c4.x); am[i * 4 + 1] = g4.y * (1.f + c4.y);
            am[i * 4 + 2] = g4.z * (1.f + c4.z); am[i * 4 + 3] = g4.w * (1.f + c4.w);
            sh[i * 4 + 0] = s4.x; sh[i * 4 + 1] = s4.y; sh[i * 4 + 2] = s4.z; sh[i * 4 + 3] = s4.w;
        }
        for (int rr = wave; rr < 64; rr += 4) {
            const int t = row0 + rr;
            float xv[16];
            float ss = 0.f;
#pragma unroll
            for (int i = 0; i < 4; ++i) {
                float4 v;
                if (XBF) {
                    const uint2 q = *(const uint2*)((const bf16_t*)Xv + (size_t)t * 1024 + i * 256 + lane * 4);
                    v = make_float4(__uint_as_float(q.x << 16), __uint_as_float(q.x & 0xffff0000u), __uint_as_float(q.y << 16), __uint_as_float(q.y & 0xffff0000u));
                } else v = *(const float4*)((const float*)Xv + (size_t)t * 1024 + i * 256 + lane * 4);
                xv[i * 4 + 0] = v.x; xv[i * 4 + 1] = v.y; xv[i * 4 + 2] = v.z; xv[i * 4 + 3] = v.w;
                ss += v.x * v.x + v.y * v.y + v.z * v.z + v.w * v.w;
            }
            ss = wave_sum_dpp(ss);
            const float rinv = rsqrtf(ss * (1.f / 1024.f) + 1e-6f);
            float hv[16];
#pragma unroll
            for (int i = 0; i < 16; ++i) hv[i] = xv[i] * rinv * am[i] + sh[i];
            if (WITH_H8) {
                float amx = 0.f;
#pragma unroll
                for (int i = 0; i < 16; ++i) amx = fmaxf(amx, fabsf(hv[i]));
                amx = wave_max_dpp(amx);
                const float qs = (amx > 0.f) ? 127.f / amx : 0.f;
#pragma unroll
                for (int i = 0; i < 4; ++i) {
                    const int q0 = __float2int_rn(hv[i * 4 + 0] * qs), q1 = __float2int_rn(hv[i * 4 + 1] * qs);
                    const int q2 = __float2int_rn(hv[i * 4 + 2] * qs), q3 = __float2int_rn(hv[i * 4 + 3] * qs);
                    const unsigned w8 = ((unsigned)q0 & 0xffu) | (((unsigned)q1 & 0xffu) << 8) | (((unsigned)q2 & 0xffu) << 16) | (((unsigned)q3 & 0xffu) << 24);
                    *(unsigned*)(H8 + (size_t)t * 1024 + i * 256 + lane * 4) = w8;
                }
                if (lane == 0) ((float*)(ws + OFF_HS))[t] = amx * (1.f / 127.f);
            }
            if (GATES) {
                unsigned hp[8];
#pragma unroll
                for (int q = 0; q < 8; ++q) hp[q] = cvt_pk_bf16(hv[2 * q], hv[2 * q + 1]);
                float sg[8];
#pragma unroll
                for (int j = 0; j < 8; ++j) {
                    float a = 0.f;
#pragma unroll
                    for (int q = 0; q < 8; ++q) a = dot2_bf16(hp[q], wgp[j][q], a);
                    sg[j] = a;
                }
#define DPPF(v, ctrl) __int_as_float(__builtin_amdgcn_mov_dpp(__float_as_int(v), (ctrl), 0xF, 0xF, true))
                const bool b0 = lane & 1, b1 = lane & 2, b2 = lane & 4;
                float t4[4], u2[2];
#pragma unroll
                for (int k = 0; k < 4; ++k) { const float keep = b2 ? sg[4 + k] : sg[k], send = b2 ? sg[k] : sg[4 + k]; t4[k] = keep + DPPF(send, 0x141); }
#pragma unroll
                for (int k = 0; k < 2; ++k) { const float keep = b0 ? t4[2 + k] : t4[k], send = b0 ? t4[k] : t4[2 + k]; u2[k] = keep + DPPF(send, 0xB1); }
                float gsum;
                { const float keep = b1 ? u2[1] : u2[0], send = b1 ? u2[0] : u2[1]; gsum = keep + DPPF(send, 0x4E); }
                gsum += DPPF(gsum, 0x128);
                { const auto q = __builtin_amdgcn_permlane16_swap(__float_as_uint(gsum), __float_as_uint(gsum), false, false); gsum = __uint_as_float(q[0]) + __uint_as_float(q[1]); }
                { const auto q = __builtin_amdgcn_permlane32_swap(__float_as_uint(gsum), __float_as_uint(gsum), false, false); gsum = __uint_as_float(q[0]) + __uint_as_float(q[1]); }
#undef DPPF
                if (lane < 8) {
                    const int j = ((lane >> 2) & 1) * 4 + (lane & 1) * 2 + ((lane >> 1) & 1);
                    float* ipre = (float*)(ws + OFF_IPRE);
                    float* logf_ = (float*)(ws + OFF_LOGF);
                    if (j < 4) ipre[(size_t)t * 4 + j] = gsum + p.b_if[j];
                    else logf_[(size_t)t * 4 + (j - 4)] = logsigmoidf_(gsum + p.b_if[j]);
                }
            }
        }
    }
}

#define GM_INPROJ 0
#define GM_RESID  1
#define GM_RESID_BF 4
#define GM_PLAIN  2
#define GM_QKV    3
#define LDS_ROW 72

struct GemmArgs {
    const bf16_t* A; const bf16_t* Bt; int N;
    const float* hs; const float* wsc;
    const void* xin; bf16_t* xout; const float* gate; const float* bias;
    bf16_t* out;
};

#define CT_LD 132
typedef __attribute__((address_space(1))) char gch_t;
#define LAUNDER(ptr) do { gch_t* _g = (gch_t*)(ptr); asm volatile("" : "+v"(_g)); (ptr) = (decltype(ptr))(char*)_g; } while (0)
template <int MODE>
DI void gemm_epilogue(const Params& p, char* ws, const GemmArgs& ga, const f32x16 (&acc)[2][2], int m0, int n0, int tn, int wm, int wn, int tid, bool swapped, float* Ct, const f32x4n_t (&xi)[16]) {
    const int lane = tid & 63, r = lane & 31, h = lane >> 5;
    {
#pragma unroll
        for (int mt = 0; mt < 2; ++mt)
#pragma unroll
            for (int nt = 0; nt < 2; ++nt) {
                float* dst = Ct + (wm * 64 + mt * 32 + 4 * h) * CT_LD + wn * 64 + nt * 32 + r;
#pragma unroll
                for (int i = 0; i < 16; ++i) dst[((i & 3) + 8 * (i >> 2)) * CT_LD] = acc[mt][nt][i];
            }
    }
    __syncthreads();
    if (MODE == GM_RESID || MODE == GM_RESID_BF) {
        const int c4 = tid & 31, rr = tid >> 5;
        const int n = n0 + c4 * 4, b = m0 >> 11;
        const float4 g4 = *(const float4*)(ga.gate + (size_t)b * 3072 + n);
        float4 b4 = make_float4(0.f, 0.f, 0.f, 0.f);
        if (ga.bias) b4 = *(const float4*)(ga.bias + n);
        bf16_t* op = ga.xout + (size_t)(m0 + rr) * 1024 + n;
#pragma unroll
        for (int it = 0; it < 16; ++it) {
            const float4 c = *(const float4*)(Ct + (rr + 8 * it) * CT_LD + c4 * 4);
            float4 xq;
            if (MODE == GM_RESID_BF) {
                const unsigned q0 = __float_as_uint(xi[it].x), q1 = __float_as_uint(xi[it].y);
                xq = make_float4(__uint_as_float(q0 << 16), __uint_as_float(q0 & 0xffff0000u), __uint_as_float(q1 << 16), __uint_as_float(q1 & 0xffff0000u));
            } else xq = make_float4(xi[it].x, xi[it].y, xi[it].z, xi[it].w);
            float4 o;
            o.x = xq.x + g4.x * (c.x + b4.x); o.y = xq.y + g4.y * (c.y + b4.y);
            o.z = xq.z + g4.z * (c.z + b4.z); o.w = xq.w + g4.w * (c.w + b4.w);
            { u32x2_t ov_; ov_.x = pack2bf(o.x, o.y); ov_.y = pack2bf(o.z, o.w); __builtin_nontemporal_store(ov_, (u32x2_t*)(op + (size_t)it * 8 * 1024)); }
        }
    } else {
        const int c8 = tid & 15, rr = tid >> 4;
        bf16_t* dst; size_t rstride; const float* colbias = nullptr; const float* rowbias = nullptr;
        bf16_t* R3 = (bf16_t*)(ws + OFF_R3);
        const int b = m0 >> 11, s0 = m0 & 2047;
        if (MODE == GM_PLAIN) { dst = ga.out + (size_t)m0 * ga.N + n0; rstride = (size_t)ga.N; }
        else if (MODE == GM_INPROJ) {
            if (!swapped) { dst = R3 + (size_t)(tn >> 2) * T_TOK * 512 + (size_t)m0 * 512 + (n0 & 511); rstride = 512; }
            else { dst = R3 + (size_t)T_TOK * 512 + ((size_t)b * 512 + (n0 - 512)) * 2048 + s0; rstride = 2048; }
        } else {
            if (tn < 8) { dst = R3 + (size_t)m0 * 1024 + n0; rstride = 1024; colbias = p.b_qkv + n0; }
            else if (tn == 8) { dst = R3 + (size_t)T_TOK * 1024 + (size_t)m0 * 128; rstride = 128; colbias = p.b_qkv + n0; }
            else { dst = R3 + (size_t)T_TOK * 1024 + (size_t)T_TOK * 128 + (size_t)b * 128 * 2048 + s0; rstride = 2048; rowbias = p.b_qkv + 1152; }
        }
        const float* rowscale = nullptr; const float* colscale = nullptr;
        if (ga.hs) { rowscale = swapped ? ga.wsc + n0 : ga.hs + m0; colscale = swapped ? ga.hs + m0 : ga.wsc + n0; }
        float csv[8];
#pragma unroll
        for (int e = 0; e < 8; ++e) csv[e] = 1.f;
        if (colscale) {
            const float4 a = *(const float4*)(colscale + c8 * 8), bq = *(const float4*)(colscale + c8 * 8 + 4);
            csv[0] = a.x; csv[1] = a.y; csv[2] = a.z; csv[3] = a.w; csv[4] = bq.x; csv[5] = bq.y; csv[6] = bq.z; csv[7] = bq.w;
        }
        float cbv[8];
#pragma unroll
        for (int e = 0; e < 8; ++e) cbv[e] = 0.f;
        if (colbias) {
            const float4 a = *(const float4*)(colbias + c8 * 8), bq = *(const float4*)(colbias + c8 * 8 + 4);
            cbv[0] = a.x; cbv[1] = a.y; cbv[2] = a.z; cbv[3] = a.w; cbv[4] = bq.x; cbv[5] = bq.y; cbv[6] = bq.z; cbv[7] = bq.w;
        }
        bf16_t* dp = dst + (size_t)rr * rstride + c8 * 8;
#pragma unroll
        for (int it = 0; it < 8; ++it) {
            const int row = rr + 16 * it;
            const float4 c0 = *(const float4*)(Ct + row * CT_LD + c8 * 8);
            const float4 c1 = *(const float4*)(Ct + row * CT_LD + c8 * 8 + 4);
            float rbv = 0.f, rsv = 1.f;
            if (rowbias) rbv = rowbias[row];
            if (rowscale) rsv = rowscale[row];
            uint4 o;
            o.x = pack2bf(c0.x * rsv * csv[0] + cbv[0] + rbv, c0.y * rsv * csv[1] + cbv[1] + rbv);
            o.y = pack2bf(c0.z * rsv * csv[2] + cbv[2] + rbv, c0.w * rsv * csv[3] + cbv[3] + rbv);
            o.z = pack2bf(c1.x * rsv * csv[4] + cbv[4] + rbv, c1.y * rsv * csv[5] + cbv[5] + rbv);
            o.w = pack2bf(c1.z * rsv * csv[6] + cbv[6] + rbv, c1.w * rsv * csv[7] + cbv[7] + rbv);
            { u32x4_t ov_; ov_.x = o.x; ov_.y = o.y; ov_.z = o.z; ov_.w = o.w; __builtin_nontemporal_store(ov_, (u32x4_t*)(dp + (size_t)it * 16 * rstride)); }
        }
    }
    __syncthreads();
}

#define GT_BYTES 16384
typedef int i32x4_t __attribute__((ext_vector_type(4)));
typedef int i32x16_t __attribute__((ext_vector_type(16)));
template <int MODE, bool I8>
DI void phase_gemm(const Params& p, char* ws, const GemmArgs& ga, char* smem) {
    const int tid = get_tid(), lane = tid & 63, wave = tid >> 6;
    const int wm = wave >> 1, wn = wave & 1;
    const int r = lane & 31, h = lane >> 5;
    const int NT = ga.N / 128;
    const int total = 256 * NT;
    constexpr int RS = I8 ? 1024 : 2048;
    constexpr int NK = I8 ? 8 : 16;
    const int srow = wave * 8 + (lane >> 3);
    const int scg = (lane & 7) ^ ((((wave & 1) << 2) + (lane >> 4)) & 7);
    const size_t soff = (size_t)srow * RS + scg * 16;
    const int fsw = (r >> 1) & 7;
    int fo[4];
#pragma unroll
    for (int ks = 0; ks < 4; ++ks) fo[ks] = ((ks * 2 + h) ^ fsw) * 16;
    for (int ti = blockIdx.x; ti < total; ti += gridDim.x) {
        const int label = ti & 7, j = ti >> 3;
        const int tm = label * 32 + j / NT, tn = j % NT;
        const int m0 = tm * 128, n0 = tn * 128;
        bool swapped = false;
        if (MODE == GM_INPROJ) swapped = (tn >= 4 && tn < 8);
        if (MODE == GM_QKV) swapped = (tn == 9);
        const char* Ag = (const char*)ga.A + (size_t)m0 * RS + soff;
        const char* Bg = (const char*)ga.Bt + (size_t)n0 * RS + soff;
        f32x16 acc[2][2];
        i32x16_t acci[2][2];
#pragma unroll
        for (int a = 0; a < 2; ++a) {
            zero_acc<2>(acc[a]);
#pragma unroll
            for (int b2 = 0; b2 < 2; ++b2)
#pragma unroll
                for (int i = 0; i < 16; ++i) acci[a][b2][i] = 0;
        }
#define GEMM_STAGE(BUF, KT)                                                                                           \
        _Pragma("unroll") for (int i = 0; i < 4; ++i) {                                                                \
            __builtin_amdgcn_global_load_lds((const unsigned*)(Ag + (size_t)i * 32 * RS + (KT) * 128),                \
                                             (unsigned*)(smem + (BUF) * 2 * GT_BYTES + (i * 4 + wave) * 1024), 16, 0, 0); \
            __builtin_amdgcn_global_load_lds((const unsigned*)(Bg + (size_t)i * 32 * RS + (KT) * 128),                \
                                             (unsigned*)(smem + (BUF) * 2 * GT_BYTES + GT_BYTES + (i * 4 + wave) * 1024), 16, 0, 0); \
        }
        f32x4n_t xi[16];
        if (MODE == GM_RESID) {
            const float* xp = (const float*)ga.xin + (size_t)(m0 + (tid >> 5)) * 1024 + n0 + (tid & 31) * 4;
#pragma unroll
            for (int it = 0; it < 16; ++it) xi[it] = __builtin_nontemporal_load((const f32x4n_t*)(xp + (size_t)it * 8 * 1024));
        }
        if (MODE == GM_RESID_BF) {
            const bf16_t* xp = (const bf16_t*)ga.xin + (size_t)(m0 + (tid >> 5)) * 1024 + n0 + (tid & 31) * 4;
#pragma unroll
            for (int it = 0; it < 16; ++it) {
                const u32x2_t q = __builtin_nontemporal_load((const u32x2_t*)(xp + (size_t)it * 8 * 1024));
                xi[it].x = __uint_as_float(q.x); xi[it].y = __uint_as_float(q.y);
            }
        }
        GEMM_STAGE(0, 0)
        asm volatile("s_waitcnt vmcnt(0)" ::: "memory");
        __syncthreads();
        for (int kt = 0; kt < NK; ++kt) {
            const int cur = kt & 1;
            if (kt < NK - 1) { GEMM_STAGE(cur ^ 1, kt + 1) }
            const char* At = smem + cur * 2 * GT_BYTES + (swapped ? GT_BYTES : 0) + (wm * 64 + r) * 128;
            const char* Bt2 = smem + cur * 2 * GT_BYTES + (swapped ? 0 : GT_BYTES) + (wn * 64 + r) * 128;
#pragma unroll
            for (int ks = 0; ks < 4; ++ks) {
                if (I8) {
                    i32x4_t af[2], bfr[2];
                    af[0] = *(const i32x4_t*)(At + fo[ks]);
                    af[1] = *(const i32x4_t*)(At + 32 * 128 + fo[ks]);
                    bfr[0] = *(const i32x4_t*)(Bt2 + fo[ks]);
                    bfr[1] = *(const i32x4_t*)(Bt2 + 32 * 128 + fo[ks]);
#pragma unroll
                    for (int mt = 0; mt < 2; ++mt)
#pragma unroll
                        for (int nt = 0; nt < 2; ++nt) acci[mt][nt] = __builtin_amdgcn_mfma_i32_32x32x32_i8(af[mt], bfr[nt], acci[mt][nt], 0, 0, 0);
                } else {
                    bf16x8 af[2], bfr[2];
                    af[0] = *(const bf16x8*)(At + fo[ks]);
                    af[1] = *(const bf16x8*)(At + 32 * 128 + fo[ks]);
                    bfr[0] = *(const bf16x8*)(Bt2 + fo[ks]);
                    bfr[1] = *(const bf16x8*)(Bt2 + 32 * 128 + fo[ks]);
#pragma unroll
                    for (int mt = 0; mt < 2; ++mt)
#pragma unroll
                        for (int nt = 0; nt < 2; ++nt) acc[mt][nt] = MFMA32(af[mt], bfr[nt], acc[mt][nt]);
                }
            }
            asm volatile("s_waitcnt vmcnt(0) lgkmcnt(0)" ::: "memory");
            __syncthreads();
        }
        if (I8) {
#pragma unroll
            for (int mt = 0; mt < 2; ++mt)
#pragma unroll
                for (int nt = 0; nt < 2; ++nt)
#pragma unroll
                    for (int i = 0; i < 16; ++i) acc[mt][nt][i] = (float)acci[mt][nt][i];
        }
        gemm_epilogue<MODE>(p, ws, ga, acc, m0, n0, tn, wm, wn, tid, swapped, (float*)smem, xi);
    }
}

#define KW_LD 136
DI void phase_m1b(const Params& p, char* ws, char* smem) {
    const bf16_t* VT = (const bf16_t*)(ws + OFF_R3) + (size_t)T_TOK * 512;
    bf16_t* Qm = (bf16_t*)(ws + OFF_R1);
    bf16_t* Km = (bf16_t*)(ws + OFF_R1 + 32ull * MiB);
    float* DT = (float*)(ws + OFF_R5);
    const bf16_t* WqT = (const bf16_t*)(ws + OFF_WQT);
    const bf16_t* WkT = (const bf16_t*)(ws + OFF_WKT);
    const float* ipre = (const float*)(ws + OFF_IPRE);
    const float* logf_ = (const float*)(ws + OFF_LOGF);
    float* Gc = (float*)(ws + OFF_G);
    float* Bv = (float*)(ws + OFF_BV);
    float* usc = (float*)(ws + OFF_USC);
    float* ND = (float*)(ws + OFF_ND);
    bf16_t* KwT = (bf16_t*)smem;
    float* wv = (float*)(smem + 128 * KW_LD * 2);
    bf16_t* CMs = (bf16_t*)(smem + 128 * KW_LD * 2 + 512);
    bf16_t* CMg = (bf16_t*)(ws + OFF_R5 + 64ull * MiB);
    const bf16_t* UM = (const bf16_t*)(ws + OFF_R3);
    const int tid = get_tid(), lane = tid & 63, wave = tid >> 6;
    const int r = lane & 31, h = lane >> 5;
    const int cvc = tid & 15, csub = tid >> 4;
    for (int unit = blockIdx.x; unit < 1024; unit += gridDim.x) {
        const int c = unit & 15, hd = (unit >> 4) & 3, b = unit >> 6;
        const size_t t0 = (size_t)b * SEQ + c * 128;
        __syncthreads();
        {
            const int ch0 = hd * 128 + cvc * 8;
            float cw[4][8], cb[8];
#pragma unroll
            for (int jx = 0; jx < 4; ++jx) {
                const float4 a0 = *(const float4*)(p.conv_w + jx * 512 + ch0), a1 = *(const float4*)(p.conv_w + jx * 512 + ch0 + 4);
                cw[jx][0] = a0.x; cw[jx][1] = a0.y; cw[jx][2] = a0.z; cw[jx][3] = a0.w; cw[jx][4] = a1.x; cw[jx][5] = a1.y; cw[jx][6] = a1.z; cw[jx][7] = a1.w;
            }
            {
                const float4 a0 = *(const float4*)(p.conv_b + ch0), a1 = *(const float4*)(p.conv_b + ch0 + 4);
                cb[0] = a0.x; cb[1] = a0.y; cb[2] = a0.z; cb[3] = a0.w; cb[4] = a1.x; cb[5] = a1.y; cb[6] = a1.z; cb[7] = a1.w;
            }
            u32x4_t raw[11];
#pragma unroll
            for (int q = 0; q < 11; ++q) {
                const int sq = c * 128 + csub * 8 + q - 3;
                raw[q] = (u32x4_t){0u, 0u, 0u, 0u};
                if (sq >= 0) raw[q] = *(const u32x4_t*)(UM + ((size_t)b * SEQ + sq) * 512 + ch0);
            }
            float hist[3][8];
#pragma unroll
            for (int q = 0; q < 3; ++q) {
                const unsigned w[4] = {raw[q].x, raw[q].y, raw[q].z, raw[q].w};
#pragma unroll
                for (int e = 0; e < 4; ++e) { hist[q][2 * e] = __uint_as_float(w[e] << 16); hist[q][2 * e + 1] = __uint_as_float(w[e] & 0xffff0000u); }
            }
#pragma unroll
            for (int q = 0; q < 8; ++q) {
                const unsigned w[4] = {raw[q + 3].x, raw[q + 3].y, raw[q + 3].z, raw[q + 3].w};
                float cur[8], o[8];
#pragma unroll
                for (int e = 0; e < 4; ++e) { cur[2 * e] = __uint_as_float(w[e] << 16); cur[2 * e + 1] = __uint_as_float(w[e] & 0xffff0000u); }
#pragma unroll
                for (int e = 0; e < 8; ++e) {
                    const float a = cw[0][e] * hist[0][e] + cw[1][e] * hist[1][e] + cw[2][e] * hist[2][e] + cw[3][e] * cur[e] + cb[e];
                    o[e] = siluf_(a);
                    hist[0][e] = hist[1][e]; hist[1][e] = hist[2][e]; hist[2][e] = cur[e];
                }
                u32x4_t ov;
                ov.x = pack2bf(o[0], o[1]); ov.y = pack2bf(o[2], o[3]); ov.z = pack2bf(o[4], o[5]); ov.w = pack2bf(o[6], o[7]);
                const int sl_ = csub * 8 + q;
                *(u32x4_t*)(CMs + sl_ * KW_LD + cvc * 8) = ov;
                *(u32x4_t*)(CMg + (t0 + sl_) * 512 + ch0) = ov;
            }
        }
        if (wave == 0) {
            const float i0 = ipre[(t0 + 2 * lane) * 4 + hd], i1 = ipre[(t0 + 2 * lane + 1) * 4 + hd];
            const float f0 = logf_[(t0 + 2 * lane) * 4 + hd], f1 = logf_[(t0 + 2 * lane + 1) * 4 + hd];
            float s = f0 + f1;
#pragma unroll
            for (int d = 1; d < 64; d <<= 1) { const float t = __shfl_up(s, d); if (lane >= d) s += t; }
            const float g1 = s, g0 = s - f1;
            const float gtot = __shfl(s, 63);
            const float b0 = i0 - g0, b1 = i1 - g1;
            float bm = fmaxf(b0, b1);
#pragma unroll
            for (int o = 32; o >= 1; o >>= 1) bm = fmaxf(bm, __shfl_xor(bm, o));
            const float Mc = gtot + bm;
            wv[2 * lane] = __expf(b0 - bm);
            wv[2 * lane + 1] = __expf(b1 - bm);
            Gc[(t0 + 2 * lane) * 4 + hd] = g0; Gc[(t0 + 2 * lane + 1) * 4 + hd] = g1;
            Bv[(t0 + 2 * lane) * 4 + hd] = b0; Bv[(t0 + 2 * lane + 1) * 4 + hd] = b1;
            if (lane == 0) { usc[unit * 4 + 0] = Mc; usc[unit * 4 + 1] = gtot; }
        }
        __syncthreads();
        const bf16_t* Acm = CMs;
        {
            f32x16 acc[4];
            zero_acc<4>(acc);
            wave_mma<4, 8>(acc, Acm + (wave * 32) * KW_LD, KW_LD, WqT + (size_t)hd * 16384, 128, lane);
            {
                bf16_t* qb = Qm + (t0 + wave * 32 + 4 * h) * 512 + hd * 128 + r;
#pragma unroll
                for (int i4 = 0; i4 < 4; ++i4) {
                    bf16_t* q2 = qb + (size_t)i4 * 8 * 512;
                    LAUNDER(q2);
#pragma unroll
                    for (int ii = 0; ii < 4; ++ii)
#pragma unroll
                        for (int nt = 0; nt < 4; ++nt) q2[ii * 512 + nt * 32] = f2bf(acc[nt][i4 * 4 + ii]);
                }
            }
            zero_acc<4>(acc);
            wave_mma<4, 8>(acc, Acm + (wave * 32) * KW_LD, KW_LD, WkT + (size_t)hd * 16384, 128, lane);
            {
                bf16_t* qb = Km + (t0 + wave * 32 + 4 * h) * 512 + hd * 128 + r;
#pragma unroll
                for (int i4 = 0; i4 < 4; ++i4) {
                    bf16_t* q2 = qb + (size_t)i4 * 8 * 512;
                    LAUNDER(q2);
#pragma unroll
                    for (int ii = 0; ii < 4; ++ii)
#pragma unroll
                        for (int nt = 0; nt < 4; ++nt) q2[ii * 512 + nt * 32] = f2bf(acc[nt][i4 * 4 + ii]);
                }
            }
        }
        {
            f32x16 acc[4];
            zero_acc<4>(acc);
            wave_mma<4, 8>(acc, WkT + (size_t)hd * 16384 + (size_t)(wave * 32) * 128, 128, Acm, KW_LD, lane);
#pragma unroll
            for (int nt = 0; nt < 4; ++nt) {
                const float w = wv[nt * 32 + r];
#pragma unroll
                for (int i = 0; i < 16; ++i) KwT[(wave * 32 + crow(i, h)) * KW_LD + nt * 32 + r] = f2bf(acc[nt][i] * w);
            }
        }
        __syncthreads();
        if (tid < 128) {
            float s = 0.f;
            for (int q = 0; q < 128; ++q) s += bf2f(KwT[tid * KW_LD + q]);
            ND[(size_t)unit * 128 + tid] = s;
        }
        {
            f32x16 acc[4];
            zero_acc<4>(acc);
            const bf16_t* Av = VT + ((size_t)b * 512 + hd * 128 + wave * 32) * 2048 + c * 128;
            wave_mma<4, 8>(acc, Av, 2048, KwT, KW_LD, lane);
            float* dst = DT + (size_t)unit * 16384 + (wave * 32 + 4 * h) * 128 + r;
#pragma unroll
            for (int i4 = 0; i4 < 4; ++i4) {
                float* d2 = dst + i4 * 8 * 128;
                LAUNDER(d2);
#pragma unroll
                for (int ii = 0; ii < 4; ++ii)
#pragma unroll
                    for (int nt = 0; nt < 4; ++nt) d2[ii * 128 + nt * 32] = acc[nt][i4 * 4 + ii];
            }
        }
    }
    __syncthreads();
}

DI void phase_m2(const Params& p, char* ws) {
    (void)p;
    const float* DT = (const float*)(ws + OFF_R5);
    bf16_t* Cin = (bf16_t*)(ws + OFF_R2);
    float* usc = (float*)(ws + OFF_USC);
    const float* ND = (const float*)(ws + OFF_ND);
    float* NIN = (float*)(ws + OFF_NIN);
    const size_t gtid = (size_t)blockIdx.x * 256 + get_tid(), gsz = (size_t)gridDim.x * 256;
    const size_t total = (size_t)64 * (16384 + 128);
    for (size_t it = gtid; it < total; it += gsz) {
        const int bh = (int)(it / (16384 + 128));
        const int idx = (int)(it % (16384 + 128));
        const bool isC = idx < 16384;
        const float* src = isC ? DT + (size_t)bh * 16 * 16384 + idx : ND + (size_t)bh * 16 * 128 + (idx - 16384);
        const size_t cstride = isC ? 16384 : 128;
        float dv[16], dec[16], sc[16];
#pragma unroll
        for (int c = 0; c < 16; ++c) dv[c] = src[(size_t)c * cstride];
        float m = NEG_INF_F;
#pragma unroll
        for (int c = 0; c < 16; ++c) {
            const int unit = bh * 16 + c;
            const float Mc = usc[unit * 4 + 0], gt = usc[unit * 4 + 1];
            const float mnew = fmaxf(gt + m, Mc);
            dec[c] = __expf(gt + m - mnew); sc[c] = __expf(Mc - mnew);
            if (idx == 16384) usc[unit * 4 + 2] = m;
            m = mnew;
        }
        float st = 0.f;
#pragma unroll
        for (int c = 0; c < 16; ++c) {
            const int unit = bh * 16 + c;
            if (isC) Cin[(size_t)unit * 16384 + idx] = f2bf(st);
            else NIN[(size_t)unit * 128 + (idx - 16384)] = st;
            st = dec[c] * st + sc[c] * dv[c];
        }
    }
}

template <int NT, int KSTEPS>
DI void wave_mma_regA_ldsB(f32x16 (&acc)[NT], const bf16x8 (&af)[KSTEPS], const bf16_t* B, int ldb, int lane) {
    const int r = lane & 31, h = lane >> 5;
#pragma unroll
    for (int ks = 0; ks < KSTEPS; ++ks) {
#pragma unroll
        for (int nt = 0; nt < NT; ++nt) acc[nt] = MFMA32(af[ks], *(const bf16x8*)(B + (nt * 32 + r) * ldb + ks * 16 + h * 8), acc[nt]);
        if (ks & 1) __builtin_amdgcn_sched_barrier(0);
    }
}
template <int NT, int KSTEPS>
DI void wave_mma_ldsAB(f32x16 (&acc)[NT], const bf16_t* A, int lda, const bf16_t* B, int ldb, int lane) {
    const int r = lane & 31, h = lane >> 5;
#pragma unroll
    for (int ks = 0; ks < KSTEPS; ++ks) {
        const bf16x8 a = *(const bf16x8*)(A + r * lda + ks * 16 + h * 8);
#pragma unroll
        for (int nt = 0; nt < NT; ++nt) acc[nt] = MFMA32(a, *(const bf16x8*)(B + (nt * 32 + r) * ldb + ks * 16 + h * 8), acc[nt]);
        if (ks & 1) asm volatile("" ::: "memory");
    }
}
DI void phase_m3(const Params& p, char* ws, char* smem) {
    const bf16_t* R3 = (const bf16_t*)(ws + OFF_R3);
    const bf16_t* VT = R3 + (size_t)T_TOK * 512;
    const bf16_t* Zb = R3 + (size_t)2 * T_TOK * 512;
    const bf16_t* CM = (const bf16_t*)(ws + OFF_R5 + 64ull * MiB);
    const bf16_t* Qm = (const bf16_t*)(ws + OFF_R1);
    const bf16_t* Km = (const bf16_t*)(ws + OFF_R1 + 32ull * MiB);
    const bf16_t* Cin = (const bf16_t*)(ws + OFF_R2);
    const bf16_t* PWT = (const bf16_t*)(ws + OFF_PWT);
    const float* Gc = (const float*)(ws + OFF_G);
    const float* Bv = (const float*)(ws + OFF_BV);
    const float* usc = (const float*)(ws + OFF_USC);
    const float* NIN = (const float*)(ws + OFF_NIN);
    bf16_t* MIX = (bf16_t*)(ws + OFF_R4);
    const int tid = get_tid(), lane = tid & 63, wave = tid >> 6;
    const int r = lane & 31, h = lane >> 5;
    bf16_t* Sp = (bf16_t*)smem + (size_t)wave * 32 * KW_LD;
    bf16_t* OPB = (bf16_t*)(smem + 4 * 32 * KW_LD * 2);
    float* fb = (float*)(smem + 2 * 4 * 32 * KW_LD * 2);
    float* gs = fb;
    float* bs = fb + 128;
    float* mxs = fb + 256;
    float* nin = fb + 384;
    float* qns = fb + 512;
    const int srow = tid >> 4, sch = tid & 15;
    for (int u2 = blockIdx.x; u2 < 1024; u2 += gridDim.x) {
        const int g = u2 & 3, c = (u2 >> 2) & 15, b = u2 >> 6;
        const size_t t0 = (size_t)b * SEQ + c * 128;
        u32x4_t R[8];
#pragma unroll
        for (int q = 0; q < 8; ++q) R[q] = *(const u32x4_t*)(PWT + (size_t)g * 16384 + (size_t)(srow + 16 * q) * 128 + sch * 8);
        __syncthreads();
#pragma unroll
        for (int q = 0; q < 8; ++q) *(u32x4_t*)(OPB + (srow + 16 * q) * KW_LD + sch * 8) = R[q];
        {
            const bf16_t* UP = (const bf16_t*)(ws + OFF_R3) + (size_t)3 * T_TOK * 512;
            const int pvc = tid & 15, psub = tid >> 4;
            const int ch0 = g * 128 + pvc * 8;
            const int W = 2 << g;
            const int s0 = c * 128 + psub * 8;
            const size_t tbase = (size_t)b * SEQ;
            float sum[8];
#pragma unroll
            for (int e = 0; e < 8; ++e) sum[e] = 0.f;
            for (int q = 1; q < W; ++q) {
                const int sq = s0 - q;
                if (sq >= 0) {
                    const u32x4_t rw = *(const u32x4_t*)(UP + (tbase + sq) * 512 + ch0);
                    const unsigned w[4] = {rw.x, rw.y, rw.z, rw.w};
#pragma unroll
                    for (int e = 0; e < 4; ++e) { sum[2 * e] += __uint_as_float(w[e] << 16); sum[2 * e + 1] += __uint_as_float(w[e] & 0xffff0000u); }
                }
            }
            u32x4_t rawb[8], rlb[8];
#pragma unroll
            for (int q = 0; q < 8; ++q) {
                const int sq = s0 + q;
                rawb[q] = *(const u32x4_t*)(UP + (tbase + sq) * 512 + ch0);
                const int sl_ = sq - W + 1;
                rlb[q] = (u32x4_t){0u, 0u, 0u, 0u};
                if (sl_ >= 0) rlb[q] = *(const u32x4_t*)(UP + (tbase + sl_) * 512 + ch0);
            }
#pragma unroll
            for (int q = 0; q < 8; ++q) {
                const int sq = s0 + q;
                const unsigned w[4] = {rawb[q].x, rawb[q].y, rawb[q].z, rawb[q].w};
                float cur[8], o[8];
#pragma unroll
                for (int e = 0; e < 4; ++e) { cur[2 * e] = __uint_as_float(w[e] << 16); cur[2 * e + 1] = __uint_as_float(w[e] & 0xffff0000u); }
                const int cnt = (sq + 1 < W) ? (sq + 1) : W;
                const float inv = 1.f / (float)cnt;
#pragma unroll
                for (int e = 0; e < 8; ++e) { sum[e] += cur[e]; o[e] = sum[e] * inv - cur[e]; }
                u32x4_t ov;
                ov.x = pack2bf(o[0], o[1]); ov.y = pack2bf(o[2], o[3]); ov.z = pack2bf(o[4], o[5]); ov.w = pack2bf(o[6], o[7]);
                *(u32x4_t*)((bf16_t*)smem + (psub * 8 + q) * KW_LD + pvc * 8) = ov;
                const unsigned wl[4] = {rlb[q].x, rlb[q].y, rlb[q].z, rlb[q].w};
#pragma unroll
                for (int e = 0; e < 4; ++e) { sum[2 * e] -= __uint_as_float(wl[e] << 16); sum[2 * e + 1] -= __uint_as_float(wl[e] & 0xffff0000u); }
            }
        }
        __syncthreads();
        f32x16 acc[4];
        zero_acc<4>(acc);
        wave_mma_ldsAB<4, 8>(acc, (const bf16_t*)smem + wave * 32 * KW_LD, KW_LD, OPB, KW_LD, lane);
        bf16_t* mb = MIX + (t0 + wave * 32 + 4 * h) * 1024 + 512 + g * 128 + r;
#pragma unroll
        for (int i4 = 0; i4 < 4; ++i4) {
            bf16_t* m2 = mb + (size_t)i4 * 8 * 1024;
            LAUNDER(m2);
#pragma unroll
            for (int ii = 0; ii < 4; ++ii)
#pragma unroll
                for (int nt = 0; nt < 4; ++nt) m2[ii * 1024 + nt * 32] = f2bf(acc[nt][i4 * 4 + ii]);
        }
    }
    for (int unit = blockIdx.x; unit < 1024; unit += gridDim.x) {
        const int c = unit & 15, hd = (unit >> 4) & 3, b = unit >> 6;
        const size_t t0 = (size_t)b * SEQ + c * 128;
        const float m_in = usc[unit * 4 + 2];
        const int l0 = wave * 32;
        bf16x8 qf[8];
#pragma unroll
        for (int ks = 0; ks < 8; ++ks) qf[ks] = *(const bf16x8*)(Qm + (t0 + l0 + r) * 512 + hd * 128 + ks * 16 + h * 8);
        __syncthreads();
        if (wave == 0) {
            const float b0 = Bv[(t0 + 2 * lane) * 4 + hd], b1 = Bv[(t0 + 2 * lane + 1) * 4 + hd];
            float s = fmaxf(b0, b1);
#pragma unroll
            for (int d = 1; d < 64; d <<= 1) { const float t = __shfl_up(s, d); if (lane >= d) s = fmaxf(s, t); }
            float prev = __shfl_up(s, 1);
            if (lane == 0) prev = NEG_INF_F;
            const float pm0 = fmaxf(prev, b0), pm1 = s;
            bs[2 * lane] = b0; bs[2 * lane + 1] = b1;
            mxs[2 * lane] = fmaxf(m_in, pm0); mxs[2 * lane + 1] = fmaxf(m_in, pm1);
        } else if (wave == 1) {
            gs[2 * lane] = Gc[(t0 + 2 * lane) * 4 + hd]; gs[2 * lane + 1] = Gc[(t0 + 2 * lane + 1) * 4 + hd];
            nin[2 * lane] = NIN[(size_t)unit * 128 + 2 * lane]; nin[2 * lane + 1] = NIN[(size_t)unit * 128 + 2 * lane + 1];
        }
        {
            u32x4_t R[8];
#pragma unroll
            for (int q = 0; q < 8; ++q) R[q] = *(const u32x4_t*)(Km + (t0 + srow + 16 * q) * 512 + hd * 128 + sch * 8);
#pragma unroll
            for (int q = 0; q < 8; ++q) *(u32x4_t*)(OPB + (srow + 16 * q) * KW_LD + sch * 8) = R[q];
        }
        __syncthreads();
        if (lane < 32) {
            const bf16_t* qr = Qm + (t0 + l0 + lane) * 512 + hd * 128;
            float s = 0.f;
            for (int d8 = 0; d8 < 16; ++d8) {
                const uint4 raw = *(const uint4*)(qr + d8 * 8);
                const unsigned w[4] = {raw.x, raw.y, raw.z, raw.w};
#pragma unroll
                for (int e = 0; e < 4; ++e) s += bf2f((bf16_t)(w[e] & 0xffff)) * nin[d8 * 8 + 2 * e] + bf2f((bf16_t)(w[e] >> 16)) * nin[d8 * 8 + 2 * e + 1];
            }
            qns[wave * 32 + lane] = s;
        }
        float den2[16];
        {
            f32x16 acc[4];
            zero_acc<4>(acc);
            wave_mma_regA_ldsB<4, 8>(acc, qf, OPB, KW_LD, lane);
#pragma unroll
            for (int i = 0; i < 16; ++i) {
                const int l = l0 + crow(i, h);
                const float mxl = mxs[l];
                float rs = 0.f;
#pragma unroll
                for (int nt = 0; nt < 4; ++nt) {
                    const int sx = nt * 32 + r;
                    float v = 0.f;
                    if (sx <= l) v = acc[nt][i] * __expf(fminf(bs[sx] - mxl, 0.f));
                    rs += v;
                    Sp[crow(i, h) * KW_LD + sx] = f2bf(v);
                }
                den2[i] = half_sum(rs);
            }
        }
#pragma unroll
        for (int ks = 0; ks < 8; ++ks) qf[ks] = *(const bf16x8*)(Qm + (t0 + l0 + r) * 512 + hd * 128 + ks * 16 + h * 8);
        __syncthreads();
        {
            u32x4_t R[8];
#pragma unroll
            for (int q = 0; q < 8; ++q) R[q] = *(const u32x4_t*)(Cin + (size_t)unit * 16384 + (size_t)(srow + 16 * q) * 128 + sch * 8);
#pragma unroll
            for (int q = 0; q < 8; ++q) *(u32x4_t*)(OPB + (srow + 16 * q) * KW_LD + sch * 8) = R[q];
        }
        __syncthreads();
        f32x16 acc[4];
        zero_acc<4>(acc);
        wave_mma_regA_ldsB<4, 8>(acc, qf, OPB, KW_LD, lane);
#pragma unroll
        for (int i = 0; i < 16; ++i) {
            const int l = l0 + crow(i, h);
            const float inter_i = __expf(m_in - mxs[l]);
#pragma unroll
            for (int nt = 0; nt < 4; ++nt) acc[nt][i] *= inter_i;
        }
        __syncthreads();
        {
            u32x4_t R[8];
#pragma unroll
            for (int q = 0; q < 8; ++q) R[q] = *(const u32x4_t*)(VT + ((size_t)b * 512 + hd * 128 + srow + 16 * q) * 2048 + c * 128 + sch * 8);
#pragma unroll
            for (int q = 0; q < 8; ++q) *(u32x4_t*)(OPB + (srow + 16 * q) * KW_LD + sch * 8) = R[q];
        }
        __syncthreads();
        wave_mma_ldsAB<4, 8>(acc, Sp, KW_LD, OPB, KW_LD, lane);
#pragma unroll
        for (int i = 0; i < 16; ++i) {
            const int lr = crow(i, h), l = l0 + lr;
            const float den = __expf(m_in - mxs[l]) * qns[wave * 32 + lr] + den2[i];
            const float mrow = gs[l] + mxs[l];
            const float dn = fmaxf(fabsf(den), __expf(-mrow)) + 1e-6f;
            const float inv = 1.f / dn;
            float hv[4];
            float sm = 0.f;
#pragma unroll
            for (int nt = 0; nt < 4; ++nt) { hv[nt] = acc[nt][i] * inv; sm += hv[nt]; }
            const float mu = half_sum(sm) * (1.f / 128.f);
            float sq = 0.f;
#pragma unroll
            for (int nt = 0; nt < 4; ++nt) { const float d = hv[nt] - mu; sq += d * d; }
            const float var = half_sum(sq) * (1.f / 128.f);
            const float rstd = rsqrtf(var + 1e-6f);
#pragma unroll
            for (int nt = 0; nt < 4; ++nt) Sp[lr * KW_LD + nt * 32 + r] = f2bf((hv[nt] - mu) * rstd);
        }
        {
            const int c8 = lane & 15;
            const bf16_t* zrow = Zb + (t0 + l0 + (lane >> 4)) * 512 + hd * 128 + c8 * 8;
            const bf16_t* crow_ = CM + (t0 + l0 + (lane >> 4)) * 512 + hd * 128 + c8 * 8;
            bf16_t* mrow = MIX + (t0 + l0 + (lane >> 4)) * 1024 + hd * 128 + c8 * 8;
            const float* hgp = p.head_g + hd * 128 + c8 * 8;
            const float* skp = p.skip + hd * 128 + c8 * 8;
            LAUNDER(zrow); LAUNDER(crow_); LAUNDER(mrow); LAUNDER(hgp); LAUNDER(skp);
            const float4 hgA = *(const float4*)(hgp), hgB = *(const float4*)(hgp + 4);
            const float4 skA = *(const float4*)(skp), skB = *(const float4*)(skp + 4);
#pragma unroll
            for (int hb = 0; hb < 2; ++hb) {
                uint4 zq[4], cq[4];
#pragma unroll
                for (int it = 0; it < 4; ++it) {
                    zq[it] = *(const uint4*)(zrow + (size_t)(hb * 4 + it) * 4 * 512);
                    cq[it] = *(const uint4*)(crow_ + (size_t)(hb * 4 + it) * 4 * 512);
                }
#pragma unroll
                for (int it = 0; it < 4; ++it) {
                    const int row = (hb * 4 + it) * 4 + (lane >> 4);
                    const uint4 hq = *(const uint4*)(Sp + row * KW_LD + c8 * 8);
#define M3_GATE(HW, ZW, CW, G0, G1, S0, S1, OUTW)                                                             \
                    {                                                                                           \
                        const float h0_ = __uint_as_float((HW) << 16), h1_ = __uint_as_float((HW) & 0xffff0000u); \
                        const float z0_ = __uint_as_float((ZW) << 16), z1_ = __uint_as_float((ZW) & 0xffff0000u); \
                        const float m0_ = __uint_as_float((CW) << 16), m1_ = __uint_as_float((CW) & 0xffff0000u); \
                        OUTW = pack2bf(sigmoidf_(z0_) * (h0_ * (G0) + (S0) * m0_), sigmoidf_(z1_) * (h1_ * (G1) + (S1) * m1_)); \
                    }
                    uint4 ov;
                    M3_GATE(hq.x, zq[it].x, cq[it].x, hgA.x, hgA.y, skA.x, skA.y, ov.x)
                    M3_GATE(hq.y, zq[it].y, cq[it].y, hgA.z, hgA.w, skA.z, skA.w, ov.y)
                    M3_GATE(hq.z, zq[it].z, cq[it].z, hgB.x, hgB.y, skB.x, skB.y, ov.z)
                    M3_GATE(hq.w, zq[it].w, cq[it].w, hgB.z, hgB.w, skB.z, skB.w, ov.w)
                    *(uint4*)(mrow + (size_t)(hb * 4 + it) * 4 * 1024) = ov;
                }
                asm volatile("" ::: "memory");
            }
        }
    }
    __syncthreads();
}

DI void phase_pre_scoremat(const Params& p, char* ws, char* smem) {
    bf16_t* As = (bf16_t*)smem;
    bf16_t* Bs = (bf16_t*)(smem + 128 * KW_LD * 2);
    float* M = (float*)(ws + OFF_M);
    const int tid = get_tid(), lane = tid & 63, wave = tid >> 6, r = lane & 31, h = lane >> 5;
    for (int u = (int)gridDim.x - 1 - (int)blockIdx.x; u < 256; u += gridDim.x) {
        const int layer = u >> 7, hp = (u >> 3) & 15, c0 = (u & 7) * 128;
        __syncthreads();
        for (int i = tid; i < 128 * 32; i += 256) {
            const int row = i >> 5, ch = i & 31;
            const float4 v = *(const float4*)(p.peer_wq + ((size_t)layer * 1024 + c0 + row) * 2048 + hp * 128 + ch * 4);
            *(uint2*)(As + row * KW_LD + ch * 4) = make_uint2(pack2bf(v.x, v.y), pack2bf(v.z, v.w));
            const float4 w = *(const float4*)(p.peer_keys + (((size_t)layer * 16 + hp) * 128 + row) * 128 + ch * 4);
            *(uint2*)(Bs + row * KW_LD + ch * 4) = make_uint2(pack2bf(w.x, w.y), pack2bf(w.z, w.w));
        }
        __syncthreads();
        f32x16 acc[4];
        zero_acc<4>(acc);
        wave_mma_ldsAB<4, 8>(acc, As + wave * 32 * KW_LD, KW_LD, Bs, KW_LD, lane);
        float* mb = M + ((size_t)layer * 1024 + c0 + wave * 32 + 4 * h) * 2048 + hp * 128 + r;
#pragma unroll
        for (int i4 = 0; i4 < 4; ++i4) {
            float* m2 = mb + (size_t)i4 * 8 * 2048;
            LAUNDER(m2);
#pragma unroll
            for (int ii = 0; ii < 4; ++ii)
#pragma unroll
                for (int nt = 0; nt < 4; ++nt) m2[ii * 2048 + nt * 32] = acc[nt][i4 * 4 + ii];
        }
    }
    __syncthreads();
}

DI unsigned f2ord(float x) { const unsigned u = __float_as_uint(x); return (u & 0x80000000u) ? ~u : (u | 0x80000000u); }
DI float ord2f(unsigned k) { const unsigned u = (k & 0x80000000u) ? (k & 0x7fffffffu) : ~k; return __uint_as_float(u); }

DI void convert_row_load(const Params& p, int layer, int row, int lane, float (&v)[16]) {
    const int tab = row >> 14, e = row & 16383;
    const float* src = (tab ? p.peer_v : p.peer_u) + ((size_t)layer * 16384 + e) * 1024 + lane * 16;
#pragma unroll
    for (int i = 0; i < 4; ++i) {
        const f32x4n_t q = __builtin_nontemporal_load((const f32x4n_t*)(src + i * 4));
        v[i * 4 + 0] = q.x; v[i * 4 + 1] = q.y; v[i * 4 + 2] = q.z; v[i * 4 + 3] = q.w;
    }
}
#define TAB_V_OFF (8ull * MiB)
DI void convert_row_finish(char* ws, int layer, int row, int lane, const float (&v)[16]) {
    unsigned char* T8 = (unsigned char*)(ws + OFF_R4);
    float2* SC = (float2*)(ws + OFF_SC) + (size_t)layer * 16384;
    const int tab = row >> 14, e = row & 16383;
    float am = 0.f, ss = 0.f;
#pragma unroll
    for (int i = 0; i < 16; ++i) { am = fmaxf(am, fabsf(v[i])); ss += v[i] * v[i]; }
    am = wave_max_dpp(am); ss = wave_sum_dpp(ss);
    const float step = fminf(0.3352f * sqrtf(ss * (1.f / 1024.f)), am * (1.f / 7.5f));
    const float sc = (step > 0.f) ? 1.f / step : 0.f;
    unsigned w[2];
#pragma unroll
    for (int j = 0; j < 2; ++j) {
        unsigned acc = 0;
#pragma unroll
        for (int k = 0; k < 8; ++k) {
            int n = (int)floorf(v[j * 8 + k] * sc) + 8;
            n = n < 0 ? 0 : (n > 15 ? 15 : n);
            const int nibU = (k < 4) ? 2 * k : 2 * (k - 4) + 1;
            const int pos = (tab == 0) ? nibU : k;
            acc |= (unsigned)((pos & 1) ? (n ^ 8) : n) << (4 * pos);
        }
        w[j] = acc;
    }
    *(uint2*)(T8 + (tab ? TAB_V_OFF : 0) + (size_t)(lane >> 4) * (16384 * 128) + (size_t)e * 128 + (lane & 15) * 8) = make_uint2(w[0], w[1]);
    if (lane == 0) { if (tab == 0) SC[e].x = step * (1.f / 16.f); else SC[e].y = step; }
}

typedef float f32x4 __attribute__((ext_vector_type(4)));
#define MFMA16(a, b, c) __builtin_amdgcn_mfma_f32_16x16x32_bf16((a), (b), (c), 0, 0, 0)
#define DPPU(v, ctrl) ((unsigned)__builtin_amdgcn_mov_dpp((int)(v), (ctrl), 0xF, 0xF, true))
DI unsigned umax_(unsigned a, unsigned b) { return a > b ? a : b; }
DI unsigned row16_umax(unsigned v) {
    v = umax_(v, DPPU(v, 0xB1)); v = umax_(v, DPPU(v, 0x4E)); v = umax_(v, DPPU(v, 0x141)); v = umax_(v, DPPU(v, 0x140));
    return v;
}
DI float row16_sum(float v) {
    v += __int_as_float(__builtin_amdgcn_mov_dpp(__float_as_int(v), 0xB1, 0xF, 0xF, true));
    v += __int_as_float(__builtin_amdgcn_mov_dpp(__float_as_int(v), 0x4E, 0xF, 0xF, true));
    v += __int_as_float(__builtin_amdgcn_mov_dpp(__float_as_int(v), 0x141, 0xF, 0xF, true));
    v += __int_as_float(__builtin_amdgcn_mov_dpp(__float_as_int(v), 0x140, 0xF, 0xF, true));
    return v;
}
DI void cand_pair(int c, int& ia, int& ib) {
    if (c < 16) { ia = 0; ib = c; }
    else if (c < 24) { ia = 1; ib = c - 16; }
    else if (c < 29) { ia = 2; ib = c - 24; }
    else if (c < 33) { ia = 3; ib = c - 29; }
    else if (c < 36) { ia = 4; ib = c - 33; }
    else if (c < 38) { ia = 5; ib = c - 36; }
    else if (c < 40) { ia = 6; ib = c - 38; }
    else if (c < 42) { ia = 7; ib = c - 40; }
    else { ia = c - 34; ib = 0; }
}
DI void phase_topk(const Params& p, char* ws, int layer, char* smem) {
    const bf16_t* Sc = (const bf16_t*)(ws + OFF_R3);
    unsigned* LIST = (unsigned*)(ws + OFF_R5);
    const int tid = get_tid(), lane = tid & 63, wave = tid >> 6;
    const int c16 = lane & 15, q4 = lane >> 4, rowbase = lane & 48;
    int ca[4], cb[4];
#pragma unroll
    for (int q = 0; q < 4; ++q) cand_pair(c16 + 16 * q, ca[q], cb[q]);
    const int hd = (int)blockIdx.x & 7;
    const int nblk = ((int)gridDim.x - hd + 7) >> 3;
    const int wv = ((int)blockIdx.x >> 3) * 4 + wave, nwv = nblk * 4;
    __syncthreads();
    const int gw = (int)blockIdx.x * 4 + wave, ngw = (int)gridDim.x * 4;
    int crow_i = gw;
    u32x4_t sfc[2][4], sfn[2][4];
    {
        const int tl0 = wv < T_TOK / 16 ? wv : T_TOK / 16 - 1;
#pragma unroll
        for (int pp = 0; pp < 2; ++pp)
#pragma unroll
            for (int rg = 0; rg < 4; ++rg) sfc[pp][rg] = *(const u32x4_t*)(Sc + ((size_t)tl0 * 16 + q4 * 4 + rg) * 2048 + (hd * 2 + pp) * 128 + c16 * 8);
    }
    for (int tile = wv; tile < T_TOK / 16; tile += nwv) {
        const size_t t0 = (size_t)tile * 16;
        {
            const int tnx = (tile + nwv < T_TOK / 16) ? tile + nwv : T_TOK / 16 - 1;
#pragma unroll
            for (int pp = 0; pp < 2; ++pp)
#pragma unroll
                for (int rg = 0; rg < 4; ++rg) sfn[pp][rg] = *(const u32x4_t*)(Sc + ((size_t)tnx * 16 + q4 * 4 + rg) * 2048 + (hd * 2 + pp) * 128 + c16 * 8);
        }
        float cva[16], cvb[16];
        const int cr0 = crow_i < 32768 ? crow_i : 32767, cr1 = crow_i + ngw < 32768 ? crow_i + ngw : 32767;
        convert_row_load(p, layer, cr0, lane, cva);
        convert_row_load(p, layer, cr1, lane, cvb);
        crow_i += 2 * ngw;
        unsigned top[2][4];
#pragma unroll
        for (int pp = 0; pp < 2; ++pp) {
            unsigned kk[8][4];
#pragma unroll
            for (int rg = 0; rg < 4; ++rg) {
                const unsigned w[4] = {sfc[pp][rg].x, sfc[pp][rg].y, sfc[pp][rg].z, sfc[pp][rg].w};
#pragma unroll
                for (int e = 0; e < 4; ++e) {
                    kk[2 * e][rg] = (f2ord(__uint_as_float(w[e] << 16)) & ~127u) | (unsigned)(127 - (c16 * 8 + 2 * e));
                    kk[2 * e + 1][rg] = (f2ord(__uint_as_float(w[e] & 0xffff0000u)) & ~127u) | (unsigned)(127 - (c16 * 8 + 2 * e + 1));
                }
            }
#pragma unroll
            for (int rg = 0; rg < 4; ++rg) top[pp][rg] = 0u;
#define CE8(a, b) { const unsigned hi_ = umax_(kk[a][rg], kk[b][rg]); const unsigned lo_ = kk[a][rg] < kk[b][rg] ? kk[a][rg] : kk[b][rg]; kk[a][rg] = hi_; kk[b][rg] = lo_; }
#pragma unroll
            for (int rg = 0; rg < 4; ++rg) {
                CE8(0, 1) CE8(2, 3) CE8(4, 5) CE8(6, 7) CE8(0, 2) CE8(1, 3) CE8(4, 6) CE8(5, 7) CE8(1, 2) CE8(5, 6)
                CE8(0, 4) CE8(3, 7) CE8(1, 5) CE8(2, 6) CE8(1, 4) CE8(3, 6) CE8(2, 4) CE8(3, 5) CE8(3, 4)
            }
            unsigned* hl = (unsigned*)smem + wave * (4 * 64 * 9);
            unsigned head[4], haddr[4];
#pragma unroll
            for (int rg = 0; rg < 4; ++rg) {
                unsigned* hp_ = hl + (rg * 64 + lane) * 9;
#pragma unroll
                for (int j = 0; j < 8; ++j) hp_[j] = kk[j][rg];
                hp_[8] = 0u;
                head[rg] = kk[0][rg];
                haddr[rg] = (unsigned)((rg * 64 + lane) * 9) * 4u;
            }
#pragma unroll 1
            for (int it = 0; it < 16; ++it) {
#pragma unroll
                for (int rg = 0; rg < 4; ++rg) {
                    const unsigned m = row16_umax(head[rg]);
                    if (c16 == it) top[pp][rg] = m;
                    haddr[rg] += (head[rg] == m) ? 4u : 0u;
                    head[rg] = *(const unsigned*)((const char*)hl + haddr[rg]);
                }
            }
        }
        unsigned ck[4][4], win[4];
#pragma unroll
        for (int rg = 0; rg < 4; ++rg) {
            const float va = ord2f(top[0][rg] & ~127u), vb = ord2f(top[1][rg] & ~127u);
#pragma unroll
            for (int q = 0; q < 4; ++q) {
                const float a = __shfl(va, rowbase + ca[q]);
                const float bq = __shfl(vb, rowbase + cb[q]);
                const int c = c16 + 16 * q;
                ck[q][rg] = (c < 50) ? ((f2ord(a + bq) & ~63u) | (unsigned)(63 - c)) : 0u;
            }
            win[rg] = 0u;
        }
#define CE4(a, b) { const unsigned hi_ = umax_(ck[a][rg], ck[b][rg]); const unsigned lo_ = ck[a][rg] < ck[b][rg] ? ck[a][rg] : ck[b][rg]; ck[a][rg] = hi_; ck[b][rg] = lo_; }
#pragma unroll
        for (int rg = 0; rg < 4; ++rg) { CE4(0, 1) CE4(2, 3) CE4(0, 2) CE4(1, 3) CE4(1, 2) }
#pragma unroll 1
        for (int it = 0; it < 16; ++it) {
#pragma unroll
            for (int rg = 0; rg < 4; ++rg) {
                const unsigned m = row16_umax(ck[0][rg]);
                if (c16 == it) win[rg] = m;
                const bool won = (ck[0][rg] == m);
                ck[0][rg] = won ? ck[1][rg] : ck[0][rg];
                ck[1][rg] = won ? ck[2][rg] : ck[1][rg];
                ck[2][rg] = won ? ck[3][rg] : ck[2][rg];
                ck[3][rg] = won ? 0u : ck[3][rg];
            }
        }
#pragma unroll
        for (int rg = 0; rg < 4; ++rg) {
            int ia, ib;
            cand_pair(63 - (int)(win[rg] & 63u), ia, ib);
            ia &= 15; ib &= 15;
            const unsigned ta = (unsigned)__shfl((int)top[0][rg], rowbase + ia);
            const unsigned tb = (unsigned)__shfl((int)top[1][rg], rowbase + ib);
            const int e = (127 - (int)(ta & 127u)) * 128 + (127 - (int)(tb & 127u));
            const float cv = ord2f(win[rg] & ~63u);
            const float cmax = __shfl(cv, rowbase);
            const float ex = __expf(cv - cmax);
            const float den = row16_sum(ex);
            const float g = ex / den;
            const size_t t = t0 + q4 * 4 + rg;
            ((unsigned short*)LIST)[t * 128 + hd * 16 + c16] = (unsigned short)e;
            ((unsigned short*)LIST)[(size_t)T_TOK * 128 + t * 128 + hd * 16 + c16] = f2bf(g);
        }
        convert_row_finish(ws, layer, cr0, lane, cva);
        convert_row_finish(ws, layer, cr1, lane, cvb);
#pragma unroll
        for (int pp = 0; pp < 2; ++pp)
#pragma unroll
            for (int rg = 0; rg < 4; ++rg) sfc[pp][rg] = sfn[pp][rg];
    }
    for (; crow_i < 32768; crow_i += ngw) {
        float cv[16];
        convert_row_load(p, layer, crow_i, lane, cv);
        convert_row_finish(ws, layer, crow_i, lane, cv);
    }
}

typedef float f32x2 __attribute__((ext_vector_type(2)));
DI void fp8x16_to_f32(const uint4& q, float (&f)[16]) {
    const unsigned w[4] = {q.x, q.y, q.z, q.w};
#pragma unroll
    for (int i = 0; i < 4; ++i) {
        const f32x2 lo = __builtin_amdgcn_cvt_pk_f32_fp8((int)w[i], false);
        const f32x2 hi = __builtin_amdgcn_cvt_pk_f32_fp8((int)w[i], true);
        f[i * 4 + 0] = lo.x; f[i * 4 + 1] = lo.y; f[i * 4 + 2] = hi.x; f[i * 4 + 3] = hi.y;
    }
}

DI uint4 nt_load_u4(const void* ptr) { const u32x4_t v = __builtin_nontemporal_load((const u32x4_t*)ptr); return make_uint4(v.x, v.y, v.z, v.w); }
DI float4 nt_load_f4(const void* ptr) { const f32x4n_t v = __builtin_nontemporal_load((const f32x4n_t*)ptr); return make_float4(v.x, v.y, v.z, v.w); }
DI void slice_assign(int& x, int& wv, int& nwv) {
    const int G = (int)gridDim.x;
    x = (int)blockIdx.x & 7;
    const int nblk = (G - x + 7) >> 3;
    wv = ((int)blockIdx.x >> 3) * 4 + (get_tid() >> 6);
    nwv = nblk * 4;
}
DI void peer_issue(const unsigned char* tab, const uint4 (&E)[2], int half, unsigned coloff, uint4 (&buf)[8]) {
    const uint4 ea = half ? E[1] : E[0];
    unsigned w4[4] = {ea.x, ea.y, ea.z, ea.w};
    asm volatile("" : "+v"(w4[0]), "+v"(w4[1]), "+v"(w4[2]), "+v"(w4[3]));
#pragma unroll
    for (int j = 0; j < 8; ++j) {
        const unsigned e = (j & 1) ? (w4[j >> 1] >> 16) : (w4[j >> 1] & 0xffffu);
        buf[j] = *(const uint4*)(tab + (e * 128u + coloff));
    }
}
DI void slice_assign4(int& x, int& wv, int& nwv) {
    const int G = (int)gridDim.x, L = (int)blockIdx.x & 7;
    x = L & 3;
    const int nb_lo = (G - x + 7) >> 3, nb_hi = (G - (x + 4) + 7) >> 3;
    wv = ((L >> 2) ? nb_lo * 4 : 0) + ((int)blockIdx.x >> 3) * 4 + (get_tid() >> 6);
    nwv = (nb_lo + nb_hi) * 4;
}
DI void peer_u_compute(const uint4 (&buf)[8], const uint4& hA_in, const uint4& hB_in, int init, int c, int& keep) {
    unsigned h0 = hA_in.x, h1 = hA_in.y, h2 = hA_in.z, h3 = hA_in.w, h4 = hB_in.x, h5 = hB_in.y, h6 = hB_in.z, h7 = hB_in.w;
    asm volatile("" : "+v"(h0), "+v"(h1), "+v"(h2), "+v"(h3), "+v"(h4), "+v"(h5), "+v"(h6), "+v"(h7), "+v"(keep), "+v"(init));
    const unsigned ML = 0x0F0F0F0Fu, MH = 0xF0F0F0F0u;
#pragma unroll
    for (int j = 0; j < 8; ++j) {
        int accL, accH;
        asm("v_dot4_i32_i8 %0, %1, %2, 0" : "=v"(accL) : "v"(buf[j].x & ML), "v"(h0));
        asm("v_dot4_i32_i8 %0, %1, %2, %3" : "=v"(accH) : "v"(buf[j].x & MH), "v"(h1), "v"(init));
        accL = __builtin_amdgcn_sdot4((int)(buf[j].y & ML), (int)h2, accL, false);
        accH = __builtin_amdgcn_sdot4((int)(buf[j].y & MH), (int)h3, accH, false);
        accL = __builtin_amdgcn_sdot4((int)(buf[j].z & ML), (int)h4, accL, false);
        accH = __builtin_amdgcn_sdot4((int)(buf[j].z & MH), (int)h5, accH, false);
        accL = __builtin_amdgcn_sdot4((int)(buf[j].w & ML), (int)h6, accL, false);
        accH = __builtin_amdgcn_sdot4((int)(buf[j].w & MH), (int)h7, accH, false);
        int acc = accL * 16 + accH;
        acc += __builtin_amdgcn_mov_dpp(acc, 0xB1, 0xF, 0xF, true);
        acc += __builtin_amdgcn_mov_dpp(acc, 0x4E, 0xF, 0xF, true);
        acc += __builtin_amdgcn_mov_dpp(acc, 0x141, 0xF, 0xF, true);
        if (c == j) keep = acc;
    }
    asm volatile("" : "+v"(keep));
}
DI int peer_u_init(const uint4& hA, const uint4& hB) {
    int sl_ = __builtin_amdgcn_sdot4((int)hA.x, 0x01010101, 0, false);
    int sh_ = __builtin_amdgcn_sdot4((int)hA.y, 0x01010101, 0, false);
    sl_ = __builtin_amdgcn_sdot4((int)hA.z, 0x01010101, sl_, false);
    sh_ = __builtin_amdgcn_sdot4((int)hA.w, 0x01010101, sh_, false);
    sl_ = __builtin_amdgcn_sdot4((int)hB.x, 0x01010101, sl_, false);
    sh_ = __builtin_amdgcn_sdot4((int)hB.y, 0x01010101, sh_, false);
    sl_ = __builtin_amdgcn_sdot4((int)hB.z, 0x01010101, sl_, false);
    sh_ = __builtin_amdgcn_sdot4((int)hB.w, 0x01010101, sh_, false);
    return 8 * sh_ - 120 * sl_;
}
DI void phase_peer_u(const Params& p, char* ws, int layer) {
    (void)p; (void)layer;
    const unsigned char* H8 = (const unsigned char*)(ws + OFF_R5 + 16ull * MiB);
    const unsigned* LIST = (const unsigned*)(ws + OFF_R5);
    const unsigned char* U4 = (const unsigned char*)(ws + OFF_R4);
    int* PART = (int*)(ws + OFF_R3);
    const int lane = get_tid() & 63;
    const int sl = lane >> 3, c = lane & 7;
    int x, wv, nwv;
    slice_assign4(x, wv, nwv);
    const unsigned coloff = (unsigned)x * (16384u * 128u) + (unsigned)c * 16u;
    const int n = (T_TOK - wv + nwv - 1) / nwv;
    if (n <= 0) return;
    const unsigned short* EID = (const unsigned short*)LIST;
    uint4 E0[2], E1[2], LE0[2], LE1[2], hA0, hB0, hA1, hB1, lhA0, lhB0, lhA1, lhB1, b0[8], b1[8], b2[8], b3[8];
    int in0, in1;
#define UTOK(I) ((unsigned)wv + __umul24((unsigned)(I), (unsigned)nwv))
#define U_LOAD_E(E, I) { const size_t t_ = UTOK(I); E[0] = nt_load_u4(EID + t_ * 128 + sl * 16); E[1] = nt_load_u4(EID + t_ * 128 + sl * 16 + 8); }
#define U_LOAD_H(HA, HB, I) { const size_t t_ = UTOK(I); HA = nt_load_u4(H8 + t_ * 1024 + x * 256 + c * 32); HB = nt_load_u4(H8 + t_ * 1024 + x * 256 + c * 32 + 16); }
#define U_STORE(I, K0, K1) { int* dst_ = PART + ((size_t)x * T_TOK + UTOK(I)) * 128 + sl * 16 + c; __builtin_nontemporal_store(K0, dst_); __builtin_nontemporal_store(K1, dst_ + 8); }
#define U_ROT(E, HA, HB, INI, LE, LHA, LHB)                                                                    \
    {                                                                                                           \
        asm volatile("" : "+v"(LE[0].x), "+v"(LE[0].y), "+v"(LE[0].z), "+v"(LE[0].w), "+v"(LE[1].x), "+v"(LE[1].y), "+v"(LE[1].z), "+v"(LE[1].w)); \
        asm volatile("" : "+v"(LHA.x), "+v"(LHA.y), "+v"(LHA.z), "+v"(LHA.w), "+v"(LHB.x), "+v"(LHB.y), "+v"(LHB.z), "+v"(LHB.w)); \
        E[0] = LE[0]; E[1] = LE[1]; HA = LHA; HB = LHB; INI = peer_u_init(LHA, LHB);                            \
    }
#define UCL(I) ((I) < n ? (I) : n - 1)
    U_LOAD_E(E0, 0)
    U_LOAD_E(E1, UCL(1))
    peer_issue(U4, E0, 0, coloff, b0);
    peer_issue(U4, E0, 1, coloff, b1);
    peer_issue(U4, E1, 0, coloff, b2);
    peer_issue(U4, E1, 1, coloff, b3);
    U_LOAD_E(LE0, UCL(2)) U_LOAD_H(lhA0, lhB0, 0)
    U_LOAD_E(LE1, UCL(3)) U_LOAD_H(lhA1, lhB1, UCL(1))
    U_ROT(E0, hA0, hB0, in0, LE0, lhA0, lhB0)
    U_ROT(E1, hA1, hB1, in1, LE1, lhA1, lhB1)
#pragma unroll 1
    for (int i = 0; i < n; i += 2) {
        U_LOAD_E(LE0, UCL(i + 4)) U_LOAD_H(lhA0, lhB0, UCL(i + 2))
        U_LOAD_E(LE1, UCL(i + 5)) U_LOAD_H(lhA1, lhB1, UCL(i + 3))
        {
            int k0 = 0, k1 = 0;
            peer_u_compute(b0, hA0, hB0, in0, c, k0);
            peer_issue(U4, E0, 0, coloff, b0);
            peer_u_compute(b1, hA0, hB0, in0, c, k1);
            peer_issue(U4, E0, 1, coloff, b1);
            U_STORE(i, k0, k1)
        }
        {
            int k0 = 0, k1 = 0;
            peer_u_compute(b2, hA1, hB1, in1, c, k0);
            peer_issue(U4, E1, 0, coloff, b2);
            peer_u_compute(b3, hA1, hB1, in1, c, k1);
            peer_issue(U4, E1, 1, coloff, b3);
            U_STORE(UCL(i + 1), k0, k1)
        }
        U_ROT(E0, hA0, hB0, in0, LE0, lhA0, lhB0)
        U_ROT(E1, hA1, hB1, in1, LE1, lhA1, lhB1)
    }
#undef UTOK
}

DI void phase_peer_act(const Params& p, char* ws, int layer) {
    (void)p;
    const unsigned short* EID = (const unsigned short*)(ws + OFF_R5);
    const unsigned short* GW = EID + (size_t)T_TOK * 128;
    const int* PART = (const int*)(ws + OFF_R3);
    unsigned short* ACT8 = (unsigned short*)(ws + OFF_R2);
    float* AS = (float*)(ws + OFF_AS);
    const float2* SC = (const float2*)(ws + OFF_SC) + (size_t)layer * 16384;
    const float* HS = (const float*)(ws + OFF_HS);
    const int tid = get_tid(), lane = tid & 63, wave = tid >> 6;
    for (int tb = (blockIdx.x * 4 + wave) * 4; tb < T_TOK; tb += gridDim.x * 16) {
        uint2 q[4][4];
        unsigned ew[4], gw[4];
        float hs[4];
#pragma unroll
        for (int u = 0; u < 4; ++u) {
            const size_t i = (size_t)(tb + u) * 128 + 2 * lane;
#pragma unroll
            for (int x = 0; x < 4; ++x) q[u][x] = *(const uint2*)(PART + (size_t)x * T_TOK * 128 + i);
            ew[u] = *(const unsigned*)(EID + i); gw[u] = *(const unsigned*)(GW + i);
            hs[u] = HS[tb + u];
        }
        float2 c0[4], c1[4];
#pragma unroll
        for (int u = 0; u < 4; ++u) { c0[u] = SC[ew[u] & 0xffffu]; c1[u] = SC[ew[u] >> 16]; }
        float a0[4], a1[4], am[4];
#pragma unroll
        for (int u = 0; u < 4; ++u) {
            const int s0 = (int)q[u][0].x + (int)q[u][1].x + (int)q[u][2].x + (int)q[u][3].x;
            const int s1 = (int)q[u][0].y + (int)q[u][1].y + (int)q[u][2].y + (int)q[u][3].y;
            a0[u] = gelu_tanh((float)s0 * c0[u].x * hs[u]) * __uint_as_float(gw[u] << 16) * c0[u].y;
            a1[u] = gelu_tanh((float)s1 * c1[u].x * hs[u]) * __uint_as_float(gw[u] & 0xffff0000u) * c1[u].y;
            am[u] = fmaxf(fabsf(a0[u]), fabsf(a1[u]));
        }
#pragma unroll
        for (int u = 0; u < 4; ++u) am[u] = wave_max_dpp(am[u]);
#pragma unroll
        for (int u = 0; u < 4; ++u) {
            const float qs = (am[u] > 0.f) ? 127.f / am[u] : 0.f;
            const int q0 = __float2int_rn(a0[u] * qs), q1 = __float2int_rn(a1[u] * qs);
            ACT8[(size_t)(tb + u) * 64 + lane] = (unsigned short)(((unsigned)q0 & 0xffu) | (((unsigned)q1 & 0xffu) << 8));
            if (lane == 0) AS[tb + u] = am[u] * (1.f / 127.f);
        }
    }
}

template <bool FIRST>
DI void peer_v_compute(const uint4 (&buf)[4], unsigned a4, int (&out)[32]) {
    unsigned sA = 0x05010400u, sB = 0x07030602u, sC = 0x05040100u, sD = 0x07060302u;
    asm volatile("" : "+s"(sA), "+s"(sB), "+s"(sC), "+s"(sD));
    const unsigned M = 0x0F0F0F0Fu;
    const unsigned r0[4] = {buf[0].x, buf[0].y, buf[0].z, buf[0].w}, r1[4] = {buf[1].x, buf[1].y, buf[1].z, buf[1].w};
    const unsigned r2[4] = {buf[2].x, buf[2].y, buf[2].z, buf[2].w}, r3[4] = {buf[3].x, buf[3].y, buf[3].z, buf[3].w};
#pragma unroll
    for (int d = 0; d < 4; ++d) {
        const unsigned t01l = __builtin_amdgcn_perm(r1[d], r0[d], sA);
        const unsigned t01h = __builtin_amdgcn_perm(r1[d], r0[d], sB);
        const unsigned t23l = __builtin_amdgcn_perm(r3[d], r2[d], sA);
        const unsigned t23h = __builtin_amdgcn_perm(r3[d], r2[d], sB);
        unsigned T[4];
        T[0] = __builtin_amdgcn_perm(t23l, t01l, sC);
        T[1] = __builtin_amdgcn_perm(t23l, t01l, sD);
        T[2] = __builtin_amdgcn_perm(t23h, t01h, sC);
        T[3] = __builtin_amdgcn_perm(t23h, t01h, sD);
#pragma unroll
        for (int m = 0; m < 4; ++m) {
            if (FIRST) {
                asm("v_dot4_i32_i8 %0, %1, %2, 0" : "=v"(out[8 * d + 2 * m]) : "v"(T[m] & M), "v"(a4));
                asm("v_dot4_i32_i8 %0, %1, %2, 0" : "=v"(out[8 * d + 2 * m + 1]) : "v"(T[m]), "v"(a4));
            } else {
                out[8 * d + 2 * m]     = __builtin_amdgcn_sdot4((int)(T[m] & M), (int)a4, out[8 * d + 2 * m], false);
                out[8 * d + 2 * m + 1] = __builtin_amdgcn_sdot4((int)T[m], (int)a4, out[8 * d + 2 * m + 1], false);
            }
        }
    }
    asm volatile("" : "+v"(out[0]), "+v"(out[1]), "+v"(out[2]), "+v"(out[3]), "+v"(out[4]), "+v"(out[5]), "+v"(out[6]), "+v"(out[7]));
    asm volatile("" : "+v"(out[8]), "+v"(out[9]), "+v"(out[10]), "+v"(out[11]), "+v"(out[12]), "+v"(out[13]), "+v"(out[14]), "+v"(out[15]));
    asm volatile("" : "+v"(out[16]), "+v"(out[17]), "+v"(out[18]), "+v"(out[19]), "+v"(out[20]), "+v"(out[21]), "+v"(out[22]), "+v"(out[23]));
    asm volatile("" : "+v"(out[24]), "+v"(out[25]), "+v"(out[26]), "+v"(out[27]), "+v"(out[28]), "+v"(out[29]), "+v"(out[30]), "+v"(out[31]));
}
DI void peer_issue4(const unsigned char* tab, unsigned w_lo, unsigned w_hi, unsigned coloff, uint4 (&buf)[4]) {
    asm volatile("" : "+v"(w_lo), "+v"(w_hi));
    buf[0] = *(const uint4*)(tab + ((w_lo & 0xffffu) * 128u + coloff));
    buf[1] = *(const uint4*)(tab + ((w_lo >> 16) * 128u + coloff));
    buf[2] = *(const uint4*)(tab + ((w_hi & 0xffffu) * 128u + coloff));
    buf[3] = *(const uint4*)(tab + ((w_hi >> 16) * 128u + coloff));
}
DI void peer_v_reduce(const int (&out)[32], int sl, int (&r4)[4]) {
    int r16[16];
#pragma unroll
    for (int k = 0; k < 16; ++k) {
        const auto q = __builtin_amdgcn_permlane32_swap((unsigned)out[k], (unsigned)out[16 + k], false, false);
        r16[k] = (int)q[0] + (int)q[1];
    }
    int r8[8];
#pragma unroll
    for (int k = 0; k < 8; ++k) {
        const auto q = __builtin_amdgcn_permlane16_swap((unsigned)r16[k], (unsigned)r16[8 + k], false, false);
        r8[k] = (int)q[0] + (int)q[1];
    }
#pragma unroll
    for (int k = 0; k < 4; ++k) {
        const int mine = (sl & 1) ? r8[4 + k] : r8[k];
        const int send = (sl & 1) ? r8[k] : r8[4 + k];
        r4[k] = mine + __builtin_amdgcn_mov_dpp(send, 0x128, 0xF, 0xF, true);
    }
}
DI int peer_v_asum(const uint4& a) {
    int sa = __builtin_amdgcn_sdot4((int)a.x, 0x01010101, 0, false);
    sa = __builtin_amdgcn_sdot4((int)a.y, 0x01010101, sa, false);
    sa = __builtin_amdgcn_sdot4((int)a.z, 0x01010101, sa, false);
    sa = __builtin_amdgcn_sdot4((int)a.w, 0x01010101, sa, false);
    { const auto q = __builtin_amdgcn_permlane32_swap((unsigned)sa, (unsigned)sa, false, false); sa = (int)q[0] + (int)q[1]; }
    { const auto q = __builtin_amdgcn_permlane16_swap((unsigned)sa, (unsigned)sa, false, false); sa = (int)q[0] + (int)q[1]; }
    sa += __builtin_amdgcn_mov_dpp(sa, 0x128, 0xF, 0xF, true);
    return sa;
}
template <bool DRY>
DI void phase_peer_v(const Params& p, char* ws, char* smem, int layer) {
    bf16_t* X = (bf16_t*)(ws + OFF_R1);
    bf16_t* XO = DRY ? (bf16_t*)p.out : X;
    const int lj = layer * 2 + 1;
    const float* mods = (const float*)(ws + OFF_MODS) + (size_t)lj * 16 * 3072;
    const unsigned short* EID = (const unsigned short*)(ws + OFF_R5);
    const unsigned char* ACT8 = (const unsigned char*)(ws + OFF_R2);
    const float* AS = (const float*)(ws + OFF_AS);
    const unsigned char* V4 = (const unsigned char*)(ws + OFF_R4) + TAB_V_OFF;
    const int tid = get_tid(), lane = tid & 63;
    const int sl = lane >> 3, c = lane & 7;
    int x, wv, nwv;
    slice_assign4(x, wv, nwv);
    float* Gs = (float*)smem;
    for (int i = tid; i < 16 * 256; i += 256) Gs[i] = mods[(size_t)(i >> 8) * 3072 + 2048 + x * 256 + (i & 255)];
    __syncthreads();
    const unsigned coloff = (unsigned)x * (16384u * 128u) + (unsigned)c * 16u;
    const int n = (T_TOK - wv + nwv - 1) / nwv;
    if (n <= 0) return;
    const int colL = c * 32 + 4 * sl;
    const int col0 = x * 256 + colL;
    uint4 E0[2], E1[2], LE0[2], LE1[2], q0[4], q1[4], q2[4], q3[4];
    uint4 a0, a1, la0, la1;
    float as0, as1, las0, las1;
    u32x2_t x0, x1, lx0, lx1;
#define VTOK(I) ((unsigned)wv + __umul24((unsigned)(I), (unsigned)nwv))
#define VCL(I) ((I) < n ? (I) : n - 1)
#define V_LOAD_E(E, I) { const size_t t_ = VTOK(I); E[0] = nt_load_u4(EID + t_ * 128 + sl * 16); E[1] = nt_load_u4(EID + t_ * 128 + sl * 16 + 8); }
#define V_LOAD_M(A, ASV, XV, I)                                                                                \
    {                                                                                                           \
        const size_t t_ = VTOK(I);                                                                              \
        A = nt_load_u4(ACT8 + t_ * 128 + sl * 16);                                                              \
        ASV = AS[t_];                                                                                           \
        XV = __builtin_nontemporal_load((const u32x2_t*)(X + t_ * 1024 + col0));                                \
    }
#define V_ROT(E, A, ASV, XV, LE, LA, LASV, LXV)                                                                \
    {                                                                                                           \
        asm volatile("" : "+v"(LE[0].x), "+v"(LE[0].y), "+v"(LE[0].z), "+v"(LE[0].w), "+v"(LE[1].x), "+v"(LE[1].y), "+v"(LE[1].z), "+v"(LE[1].w)); \
        asm volatile("" : "+v"(LA.x), "+v"(LA.y), "+v"(LA.z), "+v"(LA.w), "+v"(LASV), "+v"(LXV.x), "+v"(LXV.y)); \
        E[0] = LE[0]; E[1] = LE[1]; A = LA; ASV = LASV; XV = LXV;                                               \
    }
#define V_SECTION(I, E, A, ASV, XV, DOIT)                                                                      \
    {                                                                                                           \
        int out[32];                                                                                            \
        peer_v_compute<true>(q0, A.x, out);                                                                     \
        peer_issue4(V4, E[0].x, E[0].y, coloff, q0);                                                            \
        peer_v_compute<false>(q1, A.y, out);                                                                           \
        peer_issue4(V4, E[0].z, E[0].w, coloff, q1);                                                            \
        peer_v_compute<false>(q2, A.z, out);                                                                           \
        peer_issue4(V4, E[1].x, E[1].y, coloff, q2);                                                            \
        peer_v_compute<false>(q3, A.w, out);                                                                           \
        peer_issue4(V4, E[1].z, E[1].w, coloff, q3);                                                            \
        int r4_[4];                                                                                             \
        peer_v_reduce(out, sl, r4_);                                                                            \
        const float sa_ = (float)peer_v_asum(A);                                                                \
        const unsigned tt_ = VTOK(I);                                                                           \
        const float4 g_ = *(const float4*)(Gs + (tt_ >> 11) * 256 + colL);                                     \
        const float xa_ = __uint_as_float(XV.x << 16), xb_ = __uint_as_float(XV.x & 0xffff0000u);               \
        const float xc_ = __uint_as_float(XV.y << 16), xd_ = __uint_as_float(XV.y & 0xffff0000u);               \
          \
        const float oa_ = xa_ + g_.x * (((float)r4_[0] - 7.5f * sa_) * (ASV));                                  \
        const float ob_ = xb_ + g_.y * (((float)(r4_[1] - r4_[0]) * 0.0625f + 0.5f * sa_) * (ASV));             \
        const float oc_ = xc_ + g_.z * (((float)r4_[2] - 7.5f * sa_) * (ASV));                                  \
        const float od_ = xd_ + g_.w * (((float)(r4_[3] - r4_[2]) * 0.0625f + 0.5f * sa_) * (ASV));             \
        u32x2_t ov__; ov__.x = pack2bf(oa_, ob_); ov__.y = pack2bf(oc_, od_);                                   \
        bf16_t* op__ = (DOIT) ? XO + (size_t)tt_ * 1024 + col0 : (bf16_t*)(ws + OFF_PTRS + 4096) + lane * 4;   \
        __builtin_nontemporal_store(ov__, (u32x2_t*)op__);                                                      \
    }
    V_LOAD_E(E0, 0)
    peer_issue4(V4, E0[0].x, E0[0].y, coloff, q0);
    peer_issue4(V4, E0[0].z, E0[0].w, coloff, q1);
    peer_issue4(V4, E0[1].x, E0[1].y, coloff, q2);
    peer_issue4(V4, E0[1].z, E0[1].w, coloff, q3);
    V_LOAD_E(LE0, VCL(1))
    V_LOAD_M(la0, las0, lx0, 0)
    V_LOAD_E(LE1, VCL(2))
    V_LOAD_M(la1, las1, lx1, VCL(1))
    V_ROT(E0, a0, as0, x0, LE0, la0, las0, lx0)
    V_ROT(E1, a1, as1, x1, LE1, la1, las1, lx1)
#pragma unroll 1
    for (int i = 0; i < n; i += 2) {
        V_LOAD_E(LE0, VCL(i + 3))
        V_LOAD_M(la0, las0, lx0, VCL(i + 2))
        V_LOAD_E(LE1, VCL(i + 4))
        V_LOAD_M(la1, las1, lx1, VCL(i + 3))
        V_SECTION(i, E0, a0, as0, x0, true)
        V_SECTION(VCL(i + 1), E1, a1, as1, x1, (i + 1 < n))
        V_ROT(E0, a0, as0, x0, LE0, la0, las0, lx0)
        V_ROT(E1, a1, as1, x1, LE1, la1, las1, lx1)
    }
#undef VTOK
}

#define AK_LD 72
#define AV_LD 200
#define AP_LD 40
DI void phase_attn(const Params& p, char* ws, char* smem) {
    const bf16_t* Qa = (const bf16_t*)(ws + OFF_R3);
    const bf16_t* Ka = Qa + (size_t)T_TOK * 1024;
    const bf16_t* VT2 = Ka + (size_t)T_TOK * 128;
    bf16_t* ATT = (bf16_t*)(ws + OFF_R4);
    const int tid = get_tid(), lane = tid & 63, wave = tid >> 6;
    const int r = lane & 31, h = lane >> 5;
    bf16_t* Ks = (bf16_t*)smem;
    bf16_t* Vs = (bf16_t*)(smem + 27648);
    float* btab = (float*)(smem + 27648 + 25600);
    bf16_t* Pw = (bf16_t*)(smem + 27648 + 25600 + 4096) + (size_t)wave * 32 * AP_LD;
    for (int unit = blockIdx.x; unit < 1024; unit += gridDim.x) {
        const int kvh = unit & 1, qh = (unit >> 1) & 31, b = unit >> 6;
        const size_t tb = (size_t)b * SEQ;
        const int Qh = qh * 64;
        const int Kb = Qh - 128;
        __syncthreads();
#pragma unroll
        for (int q = 0; q < 6; ++q) {
            const int c = tid + 256 * q, row = c >> 3, ch = c & 7;
            int kpos = Kb + row; if (kpos < 0) kpos = 0;
            *(uint4*)(Ks + row * AK_LD + ch * 8) = *(const uint4*)(Ka + (tb + kpos) * 128 + kvh * 64 + ch * 8);
        }
#pragma unroll
        for (int q = 0; q < 6; ++q) {
            const int c = tid + 256 * q, row = c / 24, ch = c % 24;
            int kpos = Kb + ch * 8; if (kpos < 0) kpos = 0;
            *(uint4*)(Vs + row * AV_LD + ch * 8) = *(const uint4*)(VT2 + ((size_t)b * 128 + kvh * 64 + row) * 2048 + kpos);
        }
        for (int i = tid; i < 8 * 128; i += 256) {
            const int g = i >> 7, n = i & 127;
            int bk = n;
            if (n >= 16) {
                const float lr = logf((float)n / 16.f) / 2.0794415416798357f;
                bk = 16 + (int)(lr * 16.f);
                if (bk > 31) bk = 31;
            }
            btab[i] = p.rel_bias[bk * 16 + kvh * 8 + g];
        }
        __syncthreads();
        for (int sub = 0; sub < 4; ++sub) {
            const int g = wave * 2 + (sub >> 1), qs = sub & 1;
            const int hq = kvh * 8 + g;
            const int Q0 = Qh + qs * 32;
            const int K0 = Q0 - 128;
            const int kl0 = K0 - Kb;
            f32x16 sacc[5];
            zero_acc<5>(sacc);
            {
                const bf16_t* Bq = Qa + (tb + Q0 + r) * 1024 + hq * 64 + h * 8;
                bf16x8 bq[4];
#pragma unroll
                for (int ks = 0; ks < 4; ++ks) bq[ks] = *(const bf16x8*)(Bq + ks * 16);
#pragma unroll
                for (int ks = 0; ks < 4; ++ks)
#pragma unroll
                    for (int kt = 0; kt < 5; ++kt)
                        sacc[kt] = MFMA32(*(const bf16x8*)(Ks + (kl0 + kt * 32 + r) * AK_LD + ks * 16 + h * 8), bq[ks], sacc[kt]);
            }
            const float sink = p.sinks[hq];
            float mx = sink;
#pragma unroll
            for (int kt = 0; kt < 5; ++kt)
#pragma unroll
                for (int i = 0; i < 16; ++i) {
                    const int kpos = K0 + kt * 32 + crow(i, h);
                    const int dist = Q0 + r - kpos;
                    float lg = NEG_INF_F;
                    if (dist >= 0 && dist < 128 && kpos >= 0) lg = sacc[kt][i] * 0.125f + btab[g * 128 + dist];
                    sacc[kt][i] = lg;
                    mx = fmaxf(mx, lg);
                }
            mx = fmaxf(mx, __shfl_xor(mx, 32));
            float sum = 0.f;
#pragma unroll
            for (int kt = 0; kt < 5; ++kt)
#pragma unroll
                for (int i = 0; i < 16; ++i) {
                    const float e = (sacc[kt][i] > -1e29f) ? __expf(sacc[kt][i] - mx) : 0.f;
                    sacc[kt][i] = e;
                    sum += e;
                }
            sum += __shfl_xor(sum, 32);
            sum += __expf(sink - mx);
            const float inv = 1.f / sum;
            f32x16 oacc[2];
            zero_acc<2>(oacc);
#pragma unroll
            for (int kt = 0; kt < 5; ++kt) {
#pragma unroll
                for (int q4 = 0; q4 < 4; ++q4) {
                    uint2 o;
                    o.x = pack2bf(sacc[kt][q4 * 4 + 0] * inv, sacc[kt][q4 * 4 + 1] * inv);
                    o.y = pack2bf(sacc[kt][q4 * 4 + 2] * inv, sacc[kt][q4 * 4 + 3] * inv);
                    *(uint2*)(Pw + r * AP_LD + q4 * 8 + h * 4) = o;
                }
#pragma unroll
                for (int ks = 0; ks < 2; ++ks) {
                    const bf16x8 ap = *(const bf16x8*)(Pw + r * AP_LD + ks * 16 + h * 8);
#pragma unroll
                    for (int nt = 0; nt < 2; ++nt)
                        oacc[nt] = MFMA32(ap, *(const bf16x8*)(Vs + (nt * 32 + r) * AV_LD + kl0 + kt * 32 + ks * 16 + h * 8), oacc[nt]);
                }
            }
            {
                bf16_t* ab = ATT + (tb + Q0 + 4 * h) * 1024 + hq * 64 + r;
#pragma unroll
                for (int i4 = 0; i4 < 4; ++i4) {
                    bf16_t* a2 = ab + (size_t)i4 * 8 * 1024;
                    LAUNDER(a2);
#pragma unroll
                    for (int ii = 0; ii < 4; ++ii)
#pragma unroll
                        for (int nt = 0; nt < 2; ++nt) a2[ii * 1024 + nt * 32] = f2bf(oacc[nt][i4 * 4 + ii]);
                }
            }
        }
    }
    __syncthreads();
}

DI void phase_final(const Params& p, const bf16_t* __restrict__ X) {
    const int tid = get_tid(), lane = tid & 63, wave = tid >> 6;
    for (int t = blockIdx.x * 4 + wave; t < T_TOK; t += gridDim.x * 4) {
        float xv[16];
        float ss = 0.f;
#pragma unroll
        for (int i = 0; i < 4; ++i) {
            const uint2 q = *(const uint2*)(X + (size_t)t * 1024 + i * 256 + lane * 4);
            const float4 v = make_float4(__uint_as_float(q.x << 16), __uint_as_float(q.x & 0xffff0000u), __uint_as_float(q.y << 16), __uint_as_float(q.y & 0xffff0000u));
            xv[i * 4 + 0] = v.x; xv[i * 4 + 1] = v.y; xv[i * 4 + 2] = v.z; xv[i * 4 + 3] = v.w;
            ss += v.x * v.x + v.y * v.y + v.z * v.z + v.w * v.w;
        }
        ss = wave_sum_dpp(ss);
        const float rinv = rsqrtf(ss * (1.f / 1024.f) + 1e-6f);
#pragma unroll
        for (int i = 0; i < 4; ++i) {
            const int col = i * 256 + lane * 4;
            const float4 g4 = *(const float4*)(p.final_g + col);
            float4 o;
            o.x = xv[i * 4 + 0] * rinv * g4.x; o.y = xv[i * 4 + 1] * rinv * g4.y;
            o.z = xv[i * 4 + 2] * rinv * g4.z; o.w = xv[i * 4 + 3] * rinv * g4.w;
            *(float4*)(p.out + (size_t)t * 1024 + col) = o;
        }
    }
}

#define NPHASES 25
template <int PH>
DI void run_phase(const Params& pk, char* smem) {
    typedef __attribute__((address_space(1))) char gchar_t;
    gchar_t* wsg = (gchar_t*)pk.ws;
    asm volatile("" : "+s"(wsg));
    char* ws = (char*)wsg;
    Params p;
    if (PH == 0) {
        p = pk;
        if (threadIdx.x < 29) {
            const void* v = pk.x;
            switch (threadIdx.x) {
                case 0: v = pk.x; break; case 1: v = pk.c; break; case 2: v = pk.ada_w; break; case 3: v = pk.ada_b; break;
                case 4: v = pk.norm_g; break; case 5: v = pk.w_in; break; case 6: v = pk.b_if; break; case 7: v = pk.conv_w; break;
                case 8: v = pk.conv_b; break; case 9: v = pk.w_q; break; case 10: v = pk.w_k; break; case 11: v = pk.head_g; break;
                case 12: v = pk.skip; break; case 13: v = pk.pool_w; break; case 14: v = pk.pool_scale; break; case 15: v = pk.w_out; break;
                case 16: v = pk.w_qkv; break; case 17: v = pk.b_qkv; break; case 18: v = pk.sinks; break; case 19: v = pk.w_o; break;
                case 20: v = pk.b_o; break; case 21: v = pk.rel_bias; break; case 22: v = pk.peer_wq; break; case 23: v = pk.peer_keys; break;
                case 24: v = pk.peer_u; break; case 25: v = pk.peer_v; break; case 26: v = pk.final_g; break; case 27: v = pk.out; break;
                default: v = pk.ws; break;
            }
            ((const void**)(ws + OFF_PTRS))[threadIdx.x] = v;
        }
    } else {
        const float* const* tab = (const float* const*)(ws + OFF_PTRS);
        p.x = tab[0]; p.c = tab[1]; p.ada_w = tab[2]; p.ada_b = tab[3]; p.norm_g = tab[4]; p.w_in = tab[5]; p.b_if = tab[6]; p.conv_w = tab[7];
        p.conv_b = tab[8]; p.w_q = tab[9]; p.w_k = tab[10]; p.head_g = tab[11]; p.skip = tab[12]; p.pool_w = tab[13]; p.pool_scale = tab[14];
        p.w_out = tab[15]; p.w_qkv = tab[16]; p.b_qkv = tab[17]; p.sinks = tab[18]; p.w_o = tab[19]; p.b_o = tab[20]; p.rel_bias = tab[21];
        p.peer_wq = tab[22]; p.peer_keys = tab[23]; p.peer_u = tab[24]; p.peer_v = tab[25]; p.final_g = tab[26]; p.out = (float*)tab[27]; p.ws = ws;
    }
    bf16_t* X = (bf16_t*)(ws + OFF_R1);
    const float* mods = (const float*)(ws + OFF_MODS);
    if (PH == 0) { phase_pre_mods(p, ws, smem); phase_pre_scoremat(p, ws, smem); }
    else if (PH == 1) { phase_adanorm<true, true, false>(p, ws, p.x, 0, smem); phase_pre_weights(p, ws, smem); }
    else if (PH == 2) { GemmArgs ga{}; ga.A = (const bf16_t*)(ws + OFF_R5 + 16ull * MiB); ga.Bt = (const bf16_t*)(ws + OFF_WINT); ga.N = 2048; ga.hs = (const float*)(ws + OFF_HS); ga.wsc = (const float*)(ws + OFF_WSC); phase_gemm<GM_INPROJ, true>(p, ws, ga, smem); }
    else if (PH == 3) {   }
    else if (PH == 4) phase_m1b(p, ws, smem);
    else if (PH == 5) phase_m2(p, ws);
    else if (PH == 6) phase_m3(p, ws, smem);
    else if (PH == 7) {
        GemmArgs ga{}; ga.A = (const bf16_t*)(ws + OFF_R4); ga.Bt = (const bf16_t*)(ws + OFF_WOUTT); ga.N = 1024;
        ga.xin = p.x; ga.xout = X; ga.gate = mods + (size_t)0 * 16 * 3072 + 2048; ga.bias = nullptr;
        phase_gemm<GM_RESID, false>(p, ws, ga, smem);
    }
    else if (PH == 8) phase_adanorm<false, true, true>(p, ws, X, 1, smem);
    else if (PH == 9) { GemmArgs ga{}; ga.A = (const bf16_t*)(ws + OFF_R5 + 16ull * MiB); ga.Bt = (const bf16_t*)(ws + OFF_WPQT); ga.N = 2048; ga.out = (bf16_t*)(ws + OFF_R3); ga.hs = (const float*)(ws + OFF_HS); ga.wsc = (const float*)(ws + OFF_WSC) + 3328; phase_gemm<GM_PLAIN, true>(p, ws, ga, smem); }
    else if (PH == 10) phase_topk(p, ws, 0, smem);
    else if (PH == 11) phase_peer_u(p, ws, 0);
    else if (PH == 12) phase_peer_act(p, ws, 0);
    else if (PH == 13) phase_peer_v<false>(p, ws, smem, 0);
    else if (PH == 14) phase_adanorm<false, true, true>(p, ws, X, 2, smem);
    else if (PH == 15) { GemmArgs ga{}; ga.A = (const bf16_t*)(ws + OFF_R5 + 16ull * MiB); ga.Bt = (const bf16_t*)(ws + OFF_WQKVT); ga.N = 1280; ga.hs = (const float*)(ws + OFF_HS); ga.wsc = (const float*)(ws + OFF_WSC) + 2048; phase_gemm<GM_QKV, true>(p, ws, ga, smem); }
    else if (PH == 16) phase_attn(p, ws, smem);
    else if (PH == 17 || PH == 27) {
        GemmArgs ga{}; ga.A = (const bf16_t*)(ws + OFF_R4); ga.Bt = (const bf16_t*)(ws + OFF_WOT); ga.N = 1024;
        ga.xin = X; ga.xout = (PH == 27) ? (bf16_t*)p.out : X; ga.gate = mods + (size_t)2 * 16 * 3072 + 2048; ga.bias = p.b_o;
        phase_gemm<GM_RESID_BF, false>(p, ws, ga, smem);
    }
    else if (PH == 18) phase_adanorm<false, true, true>(p, ws, X, 3, smem);
    else if (PH == 19) { GemmArgs ga{}; ga.A = (const bf16_t*)(ws + OFF_R5 + 16ull * MiB); ga.Bt = (const bf16_t*)(ws + OFF_WPQT + (size_t)2048 * 1024); ga.N = 2048; ga.out = (bf16_t*)(ws + OFF_R3); ga.hs = (const float*)(ws + OFF_HS); ga.wsc = (const float*)(ws + OFF_WSC) + 5376; phase_gemm<GM_PLAIN, true>(p, ws, ga, smem); }
    else if (PH == 20) phase_topk(p, ws, 1, smem);
    else if (PH == 21) phase_peer_u(p, ws, 1);
    else if (PH == 22) phase_peer_act(p, ws, 1);
    else if (PH == 23) phase_peer_v<false>(p, ws, smem, 1);
    else if (PH == 24) phase_final(p, X);
    else if (PH == 25) phase_peer_v<true>(p, ws, smem, 0);
    else if (PH == 26) phase_peer_v<true>(p, ws, smem, 1);
}

extern __shared__ __attribute__((aligned(16))) char dyn_smem[];

#define LDS_GEMM 73728
#define LDS_BYTES (LDS_GEMM + 16)

#if !ONE_LAUNCH
template <int PH>
__global__ void __launch_bounds__(256, 2) k_phase(Params p) { run_phase<PH>(p, dyn_smem); }

template <int PH>
static void launch_phase(const Params& p, int grid, hipStream_t stream) {
    (void)hipFuncSetAttribute((const void*)k_phase<PH>, hipFuncAttributeMaxDynamicSharedMemorySize, LDS_BYTES);
    hipLaunchKernelGGL(k_phase<PH>, dim3(grid), dim3(256), LDS_BYTES, stream, p);
}
template <int PH>
static void launch_all(const Params& p, int grid, hipStream_t stream) {
    launch_phase<PH>(p, grid, stream);
    if constexpr (PH + 1 < NPHASES) launch_all<PH + 1>(p, grid, stream);
}
#else
template <int PH>
DI void fused_from(const Params& p, volatile LAS unsigned* st) {
    run_phase<PH>(p, dyn_smem);
    if ((PROBE_MASK >> PH) & 1u) run_phase<(PH == 13) ? 25 : (PH == 23) ? 26 : (PH == 17) ? 27 : PH>(p, dyn_smem);
    if constexpr (PH + 1 < NPHASES && PH != 3) {
        { XcdBarrier bar_; bar_.bar = (unsigned*)(p.ws + OFF_BAR); bar_.x = xb_xcc_id(); bar_.st = st; xcd_barrier(bar_); }
        fused_from<PH + 1>(p, st);
    } else if constexpr (PH + 1 < NPHASES) {
        fused_from<PH + 1>(p, st);
    }
}
__global__ void __launch_bounds__(256, 2) k_fused(Params p) {
    volatile LAS unsigned* st = (volatile LAS unsigned*)(dyn_smem + LDS_GEMM);
    if (threadIdx.x == 0) { st[0] = 0u; st[1] = 0u; st[2] = 0u; st[3] = 0u; }
    __syncthreads();
    (void)xcd_barrier_post((unsigned*)(p.ws + OFF_BAR), st);
    fused_from<0>(p, st);
}
#endif

extern "C" void kernel_launch(void* const* d_in, const int* in_sizes, int n_in, void* d_out, int out_size, void* d_ws, size_t ws_size,
                              hipStream_t stream) {
    (void)in_sizes; (void)n_in; (void)out_size;
    Params p{};
    const float** pp = (const float**)&p;
    for (int i = 0; i < 27; ++i) pp[i] = (const float*)d_in[i];
    p.out = (float*)d_out;
    p.ws = (char*)d_ws;
    if (ws_size < WS_NEEDED) fprintf(stderr, "workspace too small: %zu < %llu\n", ws_size, (unsigned long long)WS_NEEDED);
#if !ONE_LAUNCH
    const int grid = 512;
    launch_all<0>(p, grid, stream);
#else
    static int grid = 0;
    if (!grid) {
        int dev = 0, cus = 0, per_cu = 0;
        (void)hipGetDevice(&dev);
        (void)hipDeviceGetAttribute(&cus, hipDeviceAttributeMultiprocessorCount, dev);
        (void)hipFuncSetAttribute((const void*)k_fused, hipFuncAttributeMaxDynamicSharedMemorySize, LDS_BYTES);
        (void)hipOccupancyMaxActiveBlocksPerMultiprocessor(&per_cu, (const void*)k_fused, 256, LDS_BYTES);
        if (per_cu < 1) per_cu = 1;
        if (cus < 1) cus = 256;
        grid = cus * (per_cu < 2 ? per_cu : 2);
    }
    (void)hipMemsetAsync(d_ws, 0, XCD_BAR_WORDS * sizeof(unsigned), stream);
    hipLaunchKernelGGL(k_fused, dim3(grid), dim3(256), LDS_BYTES, stream, p);
#endif
}
```

```cpp
#include <hip/hip_runtime.h>
#include <stdint.h>
#include <stdio.h>

#ifndef ONE_LAUNCH
#define ONE_LAUNCH 1
#endif
#ifndef PROBE_MASK
#define PROBE_MASK 0u
#endif

#define DI __device__ __forceinline__
typedef unsigned short bf16_t;
typedef __attribute__((ext_vector_type(8))) short bf16x8;
typedef __attribute__((ext_vector_type(16))) float f32x16;
typedef unsigned u32x4_t __attribute__((ext_vector_type(4)));
typedef float f32x4n_t __attribute__((ext_vector_type(4)));
typedef unsigned u32x2_t __attribute__((ext_vector_type(2)));
#define MFMA32(a, b, c) __builtin_amdgcn_mfma_f32_32x32x16_bf16((a), (b), (c), 0, 0, 0)

#define T_TOK 32768
#define SEQ 2048
#define NBATCH 16
#define DM 1024
#define NEG_INF_F (-1e30f)

#define MiB (1024ull * 1024ull)
#define OFF_BAR     0ull
#define OFF_MODS    (16ull * 1024)
#define OFF_WGT     (1ull * MiB)
#define OFF_IPRE    (OFF_WGT + 64ull * 1024)
#define OFF_LOGF    (OFF_IPRE + 512ull * 1024)
#define OFF_G       (OFF_LOGF + 512ull * 1024)
#define OFF_BV      (OFF_G + 512ull * 1024)
#define OFF_USC     (OFF_BV + 512ull * 1024)
#define OFF_ND      (OFF_USC + 64ull * 1024)
#define OFF_NIN     (OFF_ND + 512ull * 1024)
#define OFF_HS      (27ull * MiB)
#define OFF_PTRS    (27ull * MiB + 512ull * 1024)
#define OFF_AS      (27ull * MiB + 256ull * 1024)
#define OFF_WSC     (27ull * MiB + 768ull * 1024)
#define OFF_SC      (26ull * MiB)
#define OFF_WINT    (4ull * MiB)
#define OFF_WOUTT   (8ull * MiB)
#define OFF_WQKVT   (10ull * MiB)
#define OFF_WOT     (13ull * MiB)
#define OFF_WPQT    (15ull * MiB)
#define OFF_WQT     (23ull * MiB)
#define OFF_WKT     (OFF_WQT + 128ull * 1024)
#define OFF_PWT     (OFF_WKT + 128ull * 1024)
#define OFF_KEYS    (24ull * MiB)
#define OFF_R1      (32ull * MiB)
#define OFF_M       (OFF_R1 + 64ull * MiB)
#define OFF_R2      (160ull * MiB)
#define OFF_R3      (224ull * MiB)
#define OFF_R4      (352ull * MiB)
#define OFF_R5      (416ull * MiB)
#define WS_NEEDED   (512ull * MiB)

struct Params {
    const float *x, *c, *ada_w, *ada_b, *norm_g, *w_in, *b_if, *conv_w, *conv_b, *w_q, *w_k, *head_g, *skip, *pool_w,
        *pool_scale, *w_out, *w_qkv, *b_qkv, *sinks, *w_o, *b_o, *rel_bias, *peer_wq, *peer_keys, *peer_u, *peer_v, *final_g;
    float* out;
    char* ws;
};


#define XB_TMO      128
#define XB_XCNT(j)  (256  + 64 * (j))
#define XB_XSUB(j)  (1280 + 64 * (j))
#define XB_XGEN(j)  (2304 + 64 * (j))
#define XB_TOP      3328
#define XB_TOPGEN   3392
#define XCD_BAR_WORDS 3456
#define XB_SPIN_CAP (1u << 18)
#define LAS __attribute__((address_space(3)))

__device__ __forceinline__ unsigned xb_ld(unsigned* p)              { return __hip_atomic_load(p, __ATOMIC_RELAXED, __HIP_MEMORY_SCOPE_AGENT); }
__device__ __forceinline__ unsigned xb_add(unsigned* p, unsigned v) { return __hip_atomic_fetch_add(p, v, __ATOMIC_RELAXED, __HIP_MEMORY_SCOPE_AGENT); }
__device__ __forceinline__ unsigned xb_xcc_id() { return (unsigned)__builtin_amdgcn_s_getreg((3 << 11) | 20) & 0xFu; }
#define XB_SPIN(cond, bar) do { unsigned _sp = 0; while (cond) { __builtin_amdgcn_s_sleep(1); \
    if ((++_sp & 255u) == 0u) { if (xb_ld(&(bar)[XB_TMO])) break; if (_sp > XB_SPIN_CAP) { atomicAdd(&(bar)[XB_TMO], 1u); break; } } } } while (0)

struct XcdBarrier {
    unsigned* bar; unsigned x;
    volatile LAS unsigned* st;
};

__device__ __forceinline__ XcdBarrier xcd_barrier_post(unsigned* bar, volatile LAS unsigned* st) {
    XcdBarrier b; b.bar = bar; b.x = xb_xcc_id(); b.st = st;
    if (threadIdx.x == 0) (void)xb_add(&bar[XB_XCNT(b.x)], 1u);
    return b;
}
__device__ __forceinline__ void xcd_barrier_complete(unsigned* bar, unsigned x, unsigned& nloc, unsigned& nx) {
    const unsigned G = gridDim.x * gridDim.y * gridDim.z;
    unsigned sum, cnt, mine, sp = 0u;
    for (;;) {
        sum = 0u; cnt = 0u; mine = 0u;
#pragma unroll
        for (unsigned j = 0; j < 16; ++j) { const unsigned c = xb_ld(&bar[XB_XCNT(j)]); sum += c; cnt += (c > 0u) ? 1u : 0u; mine = (j == x) ? c : mine; }
        if (sum == G) break;
        __builtin_amdgcn_s_sleep(1);
        if ((++sp & 255u) == 0u) { if (xb_ld(&bar[XB_TMO])) break; if (sp > XB_SPIN_CAP) { atomicAdd(&bar[XB_TMO], 1u); break; } }
    }
    nloc = mine > 0u ? mine : 1u; nx = cnt > 0u ? cnt : 1u;
}
__device__ __forceinline__ void xcd_barrier(const XcdBarrier& b) {
    asm volatile("s_waitcnt vmcnt(0)" ::: "memory");
    __syncthreads();
    if (threadIdx.x == 0) {
        unsigned* bar = b.bar;
        __builtin_amdgcn_s_waitcnt(0);
        unsigned nloc = b.st[0], nx = b.st[1];
        if (nloc == 0u) { xcd_barrier_complete(bar, b.x, nloc, nx); b.st[0] = nloc; b.st[1] = nx; }
        const unsigned old = xb_add(&bar[XB_XSUB(b.x)], 1u);
        const unsigned gen = old / nloc;
        if (old + 1u == (gen + 1u) * nloc) {
            __builtin_amdgcn_fence(__ATOMIC_RELEASE, "agent");
            asm volatile("s_waitcnt vmcnt(0)" ::: "memory");
            const unsigned og = xb_add(&bar[XB_TOP], 1u);
            const unsigned tg = og / nx;
            if (og + 1u == (tg + 1u) * nx) xb_add(&bar[XB_TOPGEN], 1u);
            else XB_SPIN(xb_ld(&bar[XB_TOPGEN]) == tg, bar);
            __builtin_amdgcn_fence(__ATOMIC_ACQUIRE, "agent");
            xb_add(&bar[XB_XGEN(b.x)], 1u);
            asm volatile("s_waitcnt vmcnt(0)" ::: "memory");
        } else {
            XB_SPIN(xb_ld(&bar[XB_XGEN(b.x)]) == gen, bar);
            __builtin_amdgcn_fence(__ATOMIC_ACQUIRE, "agent");
            asm volatile("s_waitcnt vmcnt(0)" ::: "memory");
        }
    }
    __syncthreads();
}

typedef __bf16 bf16x2_t __attribute__((ext_vector_type(2)));
typedef float f32x2v_t __attribute__((ext_vector_type(2)));
DI unsigned pack2bf(float a, float b) { const f32x2v_t v = {a, b}; return __builtin_bit_cast(unsigned, __builtin_convertvector(v, bf16x2_t)); }
DI bf16_t f2bf(float x) { return __builtin_bit_cast(bf16_t, (__bf16)x); }
DI float bf2f(bf16_t h) { return __uint_as_float(((unsigned)h) << 16); }
DI int get_tid() { int t = (int)threadIdx.x; asm volatile("" : "+v"(t)); return t; }
DI int crow(int i, int h) { return (i & 3) + 8 * (i >> 2) + 4 * h; }
DI float wave_sum(float v) {
#pragma unroll
    for (int o = 32; o >= 1; o >>= 1) v += __shfl_xor(v, o);
    return v;
}
DI float wave_sum_dpp(float v) {
    v += __int_as_float(__builtin_amdgcn_mov_dpp(__float_as_int(v), 0xB1, 0xF, 0xF, true));
    v += __int_as_float(__builtin_amdgcn_mov_dpp(__float_as_int(v), 0x4E, 0xF, 0xF, true));
    v += __int_as_float(__builtin_amdgcn_mov_dpp(__float_as_int(v), 0x141, 0xF, 0xF, true));
    v += __int_as_float(__builtin_amdgcn_mov_dpp(__float_as_int(v), 0x140, 0xF, 0xF, true));
    return __int_as_float(__builtin_amdgcn_readlane(__float_as_int(v), 0)) + __int_as_float(__builtin_amdgcn_readlane(__float_as_int(v), 16)) +
           __int_as_float(__builtin_amdgcn_readlane(__float_as_int(v), 32)) + __int_as_float(__builtin_amdgcn_readlane(__float_as_int(v), 48));
}
DI float wave_max_dpp(float v) {
    v = fmaxf(v, __int_as_float(__builtin_amdgcn_mov_dpp(__float_as_int(v), 0xB1, 0xF, 0xF, true)));
    v = fmaxf(v, __int_as_float(__builtin_amdgcn_mov_dpp(__float_as_int(v), 0x4E, 0xF, 0xF, true)));
    v = fmaxf(v, __int_as_float(__builtin_amdgcn_mov_dpp(__float_as_int(v), 0x141, 0xF, 0xF, true)));
    v = fmaxf(v, __int_as_float(__builtin_amdgcn_mov_dpp(__float_as_int(v), 0x140, 0xF, 0xF, true)));
    return fmaxf(fmaxf(__int_as_float(__builtin_amdgcn_readlane(__float_as_int(v), 0)), __int_as_float(__builtin_amdgcn_readlane(__float_as_int(v), 16))),
                 fmaxf(__int_as_float(__builtin_amdgcn_readlane(__float_as_int(v), 32)), __int_as_float(__builtin_amdgcn_readlane(__float_as_int(v), 48))));
}
DI float half_sum(float v) {
    v += __int_as_float(__builtin_amdgcn_mov_dpp(__float_as_int(v), 0xB1, 0xF, 0xF, true));
    v += __int_as_float(__builtin_amdgcn_mov_dpp(__float_as_int(v), 0x4E, 0xF, 0xF, true));
    v += __int_as_float(__builtin_amdgcn_mov_dpp(__float_as_int(v), 0x141, 0xF, 0xF, true));
    v += __int_as_float(__builtin_amdgcn_mov_dpp(__float_as_int(v), 0x140, 0xF, 0xF, true));
    const auto q = __builtin_amdgcn_permlane16_swap(__float_as_uint(v), __float_as_uint(v), false, false);
    return __uint_as_float(q[0]) + __uint_as_float(q[1]);
}
DI float half_max(float v) {
    v = fmaxf(v, __int_as_float(__builtin_amdgcn_mov_dpp(__float_as_int(v), 0xB1, 0xF, 0xF, true)));
    v = fmaxf(v, __int_as_float(__builtin_amdgcn_mov_dpp(__float_as_int(v), 0x4E, 0xF, 0xF, true)));
    v = fmaxf(v, __int_as_float(__builtin_amdgcn_mov_dpp(__float_as_int(v), 0x141, 0xF, 0xF, true)));
    v = fmaxf(v, __int_as_float(__builtin_amdgcn_mov_dpp(__float_as_int(v), 0x140, 0xF, 0xF, true)));
    const auto q = __builtin_amdgcn_permlane16_swap(__float_as_uint(v), __float_as_uint(v), false, false);
    return fmaxf(__uint_as_float(q[0]), __uint_as_float(q[1]));
}
DI unsigned half_umax(unsigned v) {
#pragma unroll
    for (int o = 16; o >= 1; o >>= 1) { unsigned t = (unsigned)__shfl_xor((int)v, o); v = v > t ? v : t; }
    return v;
}
DI float sigmoidf_(float x) { return 1.f / (1.f + __expf(-x)); }
DI float siluf_(float x) { return x * sigmoidf_(x); }
DI float gelu_tanh(float x) {
    const float k0 = 0.7978845608028654f, k1 = 0.044715f;
    float u = k0 * (x + k1 * x * x * x);
    float t = 1.f - 2.f / (1.f + __expf(2.f * u));
    return 0.5f * x * (1.f + t);
}
DI float logsigmoidf_(float x) { return fminf(x, 0.f) - log1pf(__expf(-fabsf(x))); }

template <int N> DI void zero_acc(f32x16 (&acc)[N]) {
#pragma unroll
    for (int n = 0; n < N; ++n)
#pragma unroll
        for (int i = 0; i < 16; ++i) acc[n][i] = 0.f;
}

template <int NT, int KSTEPS, typename PA, typename PB>
DI void wave_mma(f32x16 (&acc)[NT], PA A, int lda, PB B, int ldb, int lane) {
    const int r = lane & 31, h = lane >> 5;
    bf16x8 a0, b0[NT], a1, b1[NT];
    a0 = *(const bf16x8*)(A + (size_t)r * lda + h * 8);
#pragma unroll
    for (int nt = 0; nt < NT; ++nt) b0[nt] = *(const bf16x8*)(B + (size_t)(nt * 32 + r) * ldb + h * 8);
#pragma unroll
    for (int ks = 0; ks < KSTEPS; ks += 2) {
        if (ks + 1 < KSTEPS) {
            a1 = *(const bf16x8*)(A + (size_t)r * lda + (ks + 1) * 16 + h * 8);
#pragma unroll
            for (int nt = 0; nt < NT; ++nt) b1[nt] = *(const bf16x8*)(B + (size_t)(nt * 32 + r) * ldb + (ks + 1) * 16 + h * 8);
        }
        asm volatile("" ::: "memory");
#pragma unroll
        for (int nt = 0; nt < NT; ++nt) acc[nt] = MFMA32(a0, b0[nt], acc[nt]);
        if (ks + 1 < KSTEPS) {
            if (ks + 2 < KSTEPS) {
                a0 = *(const bf16x8*)(A + (size_t)r * lda + (ks + 2) * 16 + h * 8);
#pragma unroll
                for (int nt = 0; nt < NT; ++nt) b0[nt] = *(const bf16x8*)(B + (size_t)(nt * 32 + r) * ldb + (ks + 2) * 16 + h * 8);
            }
            asm volatile("" ::: "memory");
#pragma unroll
            for (int nt = 0; nt < NT; ++nt) acc[nt] = MFMA32(a1, b1[nt], acc[nt]);
        }
    }
}

DI void phase_pre_mods(const Params& p, char* ws, char* smem) {
    float* cond = (float*)smem;
    float* mods = (float*)(ws + OFF_MODS);
    const int tid = get_tid();
    for (int unit = blockIdx.x; unit < 384; unit += gridDim.x) {
        const int lj = unit / 96, n0 = (unit % 96) * 32;
        __syncthreads();
        for (int i = tid; i < 16 * 1024; i += 256) cond[i] = siluf_(p.c[i]);
        __syncthreads();
        const int ksl = tid >> 5, col = tid & 31;
        const float* W = p.ada_w + (size_t)lj * 1024 * 3072 + n0 + col;
        float acc[16];
#pragma unroll
        for (int b = 0; b < 16; ++b) acc[b] = 0.f;
        for (int kk0 = 0; kk0 < 128; kk0 += 16) {
            float wv_[16];
#pragma unroll
            for (int q = 0; q < 16; ++q) wv_[q] = W[(size_t)(ksl * 128 + kk0 + q) * 3072];
#pragma unroll
            for (int q = 0; q < 16; ++q) {
                const int k = ksl * 128 + kk0 + q;
#pragma unroll
                for (int b = 0; b < 16; ++b) acc[b] += cond[b * 1024 + k] * wv_[q];
            }
        }
        __syncthreads();
        float* red = (float*)smem;
#pragma unroll
        for (int b = 0; b < 16; ++b) red[(ksl * 16 + b) * 32 + col] = acc[b];
        __syncthreads();
        for (int o = tid; o < 512; o += 256) {
            const int b = o >> 5, cc = o & 31;
            float s = 0.f;
#pragma unroll
            for (int q = 0; q < 8; ++q) s += red[(q * 16 + b) * 32 + cc];
            mods[((size_t)lj * 16 + b) * 3072 + n0 + cc] = s + p.ada_b[(size_t)lj * 3072 + n0 + cc];
        }
    }
    __syncthreads();
}

DI void transpose_job(const float* __restrict__ src, int ldsrc, int K, int N, bf16_t* __restrict__ dst, const float* nscale, float cscale,
                      int tile, float* tl) {
    const int tiles_n = N / 32;
    const int tk = tile / tiles_n, tn = tile % tiles_n;
    const int tid_ = get_tid();
    const int tx = tid_ & 31, ty = tid_ >> 5;
    __syncthreads();
#pragma unroll
    for (int q = 0; q < 4; ++q) {
        const int k = tk * 32 + ty + q * 8;
        tl[(ty + q * 8) * 33 + tx] = src[(size_t)k * ldsrc + tn * 32 + tx];
    }
    __syncthreads();
#pragma unroll
    for (int q = 0; q < 4; ++q) {
        const int n = tn * 32 + ty + q * 8;
        float v = tl[tx * 33 + ty + q * 8] * cscale;
        if (nscale) v *= nscale[n];
        dst[(size_t)n * K + tk * 32 + tx] = f2bf(v);
    }
}

DI void quant_job(const float* __restrict__ src, int ldsrc, unsigned char* __restrict__ dst, float* __restrict__ wsc, int n0, float* red) {
    const int tid = get_tid(), tx = tid & 31, ty = tid >> 5;
    const float* col = src + n0 + tx;
    float am = 0.f;
    for (int k = ty; k < 1024; k += 8) am = fmaxf(am, fabsf(col[(size_t)k * ldsrc]));
    __syncthreads();
    red[ty * 32 + tx] = am;
    __syncthreads();
#pragma unroll
    for (int q = 0; q < 8; ++q) am = fmaxf(am, red[q * 32 + tx]);
    const float sc = (am > 0.f) ? 127.f / am : 0.f;
    if (ty == 0) wsc[n0 + tx] = am * (1.f / 127.f);
    unsigned char* drow = dst + (size_t)(n0 + tx) * 1024 + ty * 128;
    for (int k4 = 0; k4 < 32; k4 += 4) {
        unsigned w[4];
#pragma unroll
        for (int q = 0; q < 4; ++q) {
            const int k = ty * 128 + (k4 + q) * 4;
            const int q0 = __float2int_rn(col[(size_t)(k + 0) * ldsrc] * sc), q1 = __float2int_rn(col[(size_t)(k + 1) * ldsrc] * sc);
            const int q2 = __float2int_rn(col[(size_t)(k + 2) * ldsrc] * sc), q3 = __float2int_rn(col[(size_t)(k + 3) * ldsrc] * sc);
            w[q] = ((unsigned)q0 & 0xffu) | (((unsigned)q1 & 0xffu) << 8) | (((unsigned)q2 & 0xffu) << 16) | (((unsigned)q3 & 0xffu) << 24);
        }
        *(uint4*)(drow + k4 * 4) = make_uint4(w[0], w[1], w[2], w[3]);
    }
}
DI void phase_pre_weights(const Params& p, char* ws, char* smem) {
    {
        float* red = (float*)smem;
        float* wsc = (float*)(ws + OFF_WSC);
        for (int j = blockIdx.x; j < 64 + 40 + 64 + 64; j += gridDim.x) {
            if (j < 64) quant_job(p.w_in, 2056, (unsigned char*)(ws + OFF_WINT), wsc, j * 32, red);
            else if (j < 104) quant_job(p.w_qkv, 1280, (unsigned char*)(ws + OFF_WQKVT), wsc + 2048, (j - 64) * 32, red);
            else if (j < 168) quant_job((const float*)(ws + OFF_M), 2048, (unsigned char*)(ws + OFF_WPQT), wsc + 3328, (j - 104) * 32, red);
            else quant_job((const float*)(ws + OFF_M) + (size_t)1024 * 2048, 2048, (unsigned char*)(ws + OFF_WPQT) + (size_t)2048 * 1024, wsc + 5376, (j - 168) * 32, red);
        }
        __syncthreads();
    }
    float* tl = (float*)smem;
    const int J1 = 32 * 32;
    const int J3 = 32 * 32;
    const int J6 = 4 * 16;
    const int J7 = 4 * 16;
    const int J8 = 4 * 16;
    const int total = J1 + J3 + J6 + J7 + J8;
    for (int j = blockIdx.x; j < total; j += gridDim.x) {
        int t = j;
        if (t < J1) { transpose_job(p.w_out, 1024, 1024, 1024, (bf16_t*)(ws + OFF_WOUTT), nullptr, 1.f, t, tl); continue; }
        t -= J1;
        if (t < J3) { transpose_job(p.w_o, 1024, 1024, 1024, (bf16_t*)(ws + OFF_WOT), nullptr, 1.f, t, tl); continue; }
        t -= J3;
        if (t < J6) { const int hh = t / 16; transpose_job(p.w_q + (size_t)hh * 16384, 128, 128, 128, (bf16_t*)(ws + OFF_WQT) + (size_t)hh * 16384, nullptr, 1.f, t % 16, tl); continue; }
        t -= J6;
        if (t < J7) { const int hh = t / 16; transpose_job(p.w_k + (size_t)hh * 16384, 128, 128, 128, (bf16_t*)(ws + OFF_WKT) + (size_t)hh * 16384, nullptr, 0.08838834764831845f, t % 16, tl); continue; }
        t -= J7;
        { const int g = t / 16; transpose_job(p.pool_w + (size_t)g * 16384, 128, 128, 128, (bf16_t*)(ws + OFF_PWT) + (size_t)g * 16384, p.pool_scale + g * 128, 1.f, t % 16, tl); }
    }
    const size_t gtid = (size_t)blockIdx.x * 256 + get_tid(), gsz = (size_t)gridDim.x * 256;
    bf16_t* keys = (bf16_t*)(ws + OFF_KEYS);
    for (size_t i = gtid; i < (size_t)2 * 8 * 2 * 128 * 128; i += gsz) keys[i] = f2bf(p.peer_keys[i]);
    __syncthreads();
}

DI unsigned cvt_pk_bf16(float a, float b) { return pack2bf(a, b); }
DI float dot2_bf16(unsigned a, unsigned b, float c) { return __builtin_amdgcn_fdot2_f32_bf16(__builtin_bit_cast(bf16x2_t, a), __builtin_bit_cast(bf16x2_t, b), c, false); }
template <bool GATES, bool WITH_H8, bool XBF>
DI void phase_adanorm(const Params& p, char* ws, const void* __restrict__ Xv, int lj, char* smem) {
    unsigned char* H8 = (unsigned char*)(ws + OFF_R5 + 16ull * MiB);
    const float* mods = (const float*)(ws + OFF_MODS) + (size_t)lj * 16 * 3072;
    const float* ng = p.norm_g + (size_t)lj * 1024;
    const int tid = get_tid(), lane = tid & 63, wave = tid >> 6;
    (void)smem;
    unsigned wgp[8][8];
    if (GATES) {
#pragma unroll
        for (int q = 0; q < 8; ++q) {
            const int col = (q >> 1) * 256 + lane * 4 + (q & 1) * 2;
            const float4 a0 = *(const float4*)(p.w_in + (size_t)col * 2056 + 2048), a1 = *(const float4*)(p.w_in + (size_t)col * 2056 + 2052);
            const float4 b0 = *(const float4*)(p.w_in + (size_t)(col + 1) * 2056 + 2048), b1 = *(const float4*)(p.w_in + (size_t)(col + 1) * 2056 + 2052);
            wgp[0][q] = cvt_pk_bf16(a0.x, b0.x); wgp[1][q] = cvt_pk_bf16(a0.y, b0.y); wgp[2][q] = cvt_pk_bf16(a0.z, b0.z); wgp[3][q] = cvt_pk_bf16(a0.w, b0.w);
            wgp[4][q] = cvt_pk_bf16(a1.x, b1.x); wgp[5][q] = cvt_pk_bf16(a1.y, b1.y); wgp[6][q] = cvt_pk_bf16(a1.z, b1.z); wgp[7][q] = cvt_pk_bf16(a1.w, b1.w);
        }
    }
    for (int unit = blockIdx.x; unit < T_TOK / 64; unit += gridDim.x) {
        const int row0 = unit * 64, b = row0 >> 11;
        float am[16], sh[16];
#pragma unroll
        for (int i = 0; i < 4; ++i) {
            const int col = i * 256 + lane * 4;
            const float4 g4 = *(const float4*)(ng + col);
            const float4 s4 = *(const float4*)(mods + (size_t)b * 3072 + col);
            const float4 c4 = *(const float4*)(mods + (size_t)b * 3072 + 1024 + col);
            am[i * 4 + 0] = g4.x * (1.f + c4.x); am[i * 4 + 1] = g4.y * (1.f + c4.y);
            am[i * 4 + 2] = g4.z * (1.f + c4.z); am[i * 4 + 3] = g4.w * (1.f + c4.w);
            sh[i * 4 + 0] = s4.x; sh[i * 4 + 1] = s4.y; sh[i * 4 + 2] = s4.z; sh[i * 4 + 3] = s4.w;
        }
        for (int rr = wave; rr < 64; rr += 4) {
            const int t = row0 + rr;
            float xv[16];
            float ss = 0.f;
#pragma unroll
            for (int i = 0; i < 4; ++i) {
                float4 v;
                if (XBF) {
                    const uint2 q = *(const uint2*)((const bf16_t*)Xv + (size_t)t * 1024 + i * 256 + lane * 4);
                    v = make_float4(__uint_as_float(q.x << 16), __uint_as_float(q.x & 0xffff0000u), __uint_as_float(q.y << 16), __uint_as_float(q.y & 0xffff0000u));
                } else v = *(const float4*)((const float*)Xv + (size_t)t * 1024 + i * 256 + lane * 4);
                xv[i * 4 + 0] = v.x; xv[i * 4 + 1] = v.y; xv[i * 4 + 2] = v.z; xv[i * 4 + 3] = v.w;
                ss += v.x * v.x + v.y * v.y + v.z * v.z + v.w * v.w;
            }
            ss = wave_sum_dpp(ss);
            const float rinv = rsqrtf(ss * (1.f / 1024.f) + 1e-6f);
            float hv[16];
#pragma unroll
            for (int i = 0; i < 16; ++i) hv[i] = xv[i] * rinv * am[i] + sh[i];
            if (WITH_H8) {
                float amx = 0.f;
#pragma unroll
                for (int i = 0; i < 16; ++i) amx = fmaxf(amx, fabsf(hv[i]));
                amx = wave_max_dpp(amx);
                const float qs = (amx > 0.f) ? 127.f / amx : 0.f;
#pragma unroll
                for (int i = 0; i < 4; ++i) {
                    const int q0 = __float2int_rn(hv[i * 4 + 0] * qs), q1 = __float2int_rn(hv[i * 4 + 1] * qs);
                    const int q2 = __float2int_rn(hv[i * 4 + 2] * qs), q3 = __float2int_rn(hv[i * 4 + 3] * qs);
                    const unsigned w8 = ((unsigned)q0 & 0xffu) | (((unsigned)q1 & 0xffu) << 8) | (((unsigned)q2 & 0xffu) << 16) | (((unsigned)q3 & 0xffu) << 24);
                    *(unsigned*)(H8 + (size_t)t * 1024 + i * 256 + lane * 4) = w8;
                }
                if (lane == 0) ((float*)(ws + OFF_HS))[t] = amx * (1.f / 127.f);
            }
            if (GATES) {
                unsigned hp[8];
#pragma unroll
                for (int q = 0; q < 8; ++q) hp[q] = cvt_pk_bf16(hv[2 * q], hv[2 * q + 1]);
                float sg[8];
#pragma unroll
                for (int j = 0; j < 8; ++j) {
                    float a = 0.f;
#pragma unroll
                    for (int q = 0; q < 8; ++q) a = dot2_bf16(hp[q], wgp[j][q], a);
                    sg[j] = a;
                }
#define DPPF(v, ctrl) __int_as_float(__builtin_amdgcn_mov_dpp(__float_as_int(v), (ctrl), 0xF, 0xF, true))
                const bool b0 = lane & 1, b1 = lane & 2, b2 = lane & 4;
                float t4[4], u2[2];
#pragma unroll
                for (int k = 0; k < 4; ++k) { const float keep = b2 ? sg[4 + k] : sg[k], send = b2 ? sg[k] : sg[4 + k]; t4[k] = keep + DPPF(send, 0x141); }
#pragma unroll
                for (int k = 0; k < 2; ++k) { const float keep = b0 ? t4[2 + k] : t4[k], send = b0 ? t4[k] : t4[2 + k]; u2[k] = keep + DPPF(send, 0xB1); }
                float gsum;
                { const float keep = b1 ? u2[1] : u2[0], send = b1 ? u2[0] : u2[1]; gsum = keep + DPPF(send, 0x4E); }
                gsum += DPPF(gsum, 0x128);
                { const auto q = __builtin_amdgcn_permlane16_swap(__float_as_uint(gsum), __float_as_uint(gsum), false, false); gsum = __uint_as_float(q[0]) + __uint_as_float(q[1]); }
                { const auto q = __builtin_amdgcn_permlane32_swap(__float_as_uint(gsum), __float_as_uint(gsum), false, false); gsum = __uint_as_float(q[0]) + __uint_as_float(q[1]); }
#undef DPPF
                if (lane < 8) {
                    const int j = ((lane >> 2) & 1) * 4 + (lane & 1) * 2 + ((lane >> 1) & 1);
                    float* ipre = (float*)(ws + OFF_IPRE);
                    float* logf_ = (float*)(ws + OFF_LOGF);
                    if (j < 4) ipre[(size_t)t * 4 + j] = gsum + p.b_if[j];
                    else logf_[(size_t)t * 4 + (j - 4)] = logsigmoidf_(gsum + p.b_if[j]);
                }
            }
        }
    }
}

#define GM_INPROJ 0
#define GM_RESID  1
#define GM_RESID_BF 4
#define GM_PLAIN  2
#define GM_QKV    3
#define LDS_ROW 72

struct GemmArgs {
    const bf16_t* A; const bf16_t* Bt; int N;
    const float* hs; const float* wsc;
    const void* xin; bf16_t* xout; const float* gate; const float* bias;
    bf16_t* out;
};

#define CT_LD 132
typedef __attribute__((address_space(1))) char gch_t;
#define LAUNDER(ptr) do { gch_t* _g = (gch_t*)(ptr); asm volatile("" : "+v"(_g)); (ptr) = (decltype(ptr))(char*)_g; } while (0)
template <int MODE>
DI void gemm_epilogue(const Params& p, char* ws, const GemmArgs& ga, const f32x16 (&acc)[2][2], int m0, int n0, int tn, int wm, int wn, int tid, bool swapped, float* Ct, const f32x4n_t (&xi)[16]) {
    const int lane = tid & 63, r = lane & 31, h = lane >> 5;
    {
#pragma unroll
        for (int mt = 0; mt < 2; ++mt)
#pragma unroll
            for (int nt = 0; nt < 2; ++nt) {
                float* dst = Ct + (wm * 64 + mt * 32 + 4 * h) * CT_LD + wn * 64 + nt * 32 + r;
#pragma unroll
                for (int i = 0; i < 16; ++i) dst[((i & 3) + 8 * (i >> 2)) * CT_LD] = acc[mt][nt][i];
            }
    }
    __syncthreads();
    if (MODE == GM_RESID || MODE == GM_RESID_BF) {
        const int c4 = tid & 31, rr = tid >> 5;
        const int n = n0 + c4 * 4, b = m0 >> 11;
        const float4 g4 = *(const float4*)(ga.gate + (size_t)b * 3072 + n);
        float4 b4 = make_float4(0.f, 0.f, 0.f, 0.f);
        if (ga.bias) b4 = *(const float4*)(ga.bias + n);
        bf16_t* op = ga.xout + (size_t)(m0 + rr) * 1024 + n;
#pragma unroll
        for (int it = 0; it < 16; ++it) {
            const float4 c = *(const float4*)(Ct + (rr + 8 * it) * CT_LD + c4 * 4);
            float4 xq;
            if (MODE == GM_RESID_BF) {
                const unsigned q0 = __float_as_uint(xi[it].x), q1 = __float_as_uint(xi[it].y);
                xq = make_float4(__uint_as_float(q0 << 16), __uint_as_float(q0 & 0xffff0000u), __uint_as_float(q1 << 16), __uint_as_float(q1 & 0xffff0000u));
            } else xq = make_float4(xi[it].x, xi[it].y, xi[it].z, xi[it].w);
            float4 o;
            o.x = xq.x + g4.x * (c.x + b4.x); o.y = xq.y + g4.y * (c.y + b4.y);
            o.z = xq.z + g4.z * (c.z + b4.z); o.w = xq.w + g4.w * (c.w + b4.w);
            { u32x2_t ov_; ov_.x = pack2bf(o.x, o.y); ov_.y = pack2bf(o.z, o.w); __builtin_nontemporal_store(ov_, (u32x2_t*)(op + (size_t)it * 8 * 1024)); }
        }
    } else {
        const int c8 = tid & 15, rr = tid >> 4;
        bf16_t* dst; size_t rstride; const float* colbias = nullptr; const float* rowbias = nullptr;
        bf16_t* R3 = (bf16_t*)(ws + OFF_R3);
        const int b = m0 >> 11, s0 = m0 & 2047;
        if (MODE == GM_PLAIN) { dst = ga.out + (size_t)m0 * ga.N + n0; rstride = (size_t)ga.N; }
        else if (MODE == GM_INPROJ) {
            if (!swapped) { dst = R3 + (size_t)(tn >> 2) * T_TOK * 512 + (size_t)m0 * 512 + (n0 & 511); rstride = 512; }
            else { dst = R3 + (size_t)T_TOK * 512 + ((size_t)b * 512 + (n0 - 512)) * 2048 + s0; rstride = 2048; }
        } else {
            if (tn < 8) { dst = R3 + (size_t)m0 * 1024 + n0; rstride = 1024; colbias = p.b_qkv + n0; }
            else if (tn == 8) { dst = R3 + (size_t)T_TOK * 1024 + (size_t)m0 * 128; rstride = 128; colbias = p.b_qkv + n0; }
            else { dst = R3 + (size_t)T_TOK * 1024 + (size_t)T_TOK * 128 + (size_t)b * 128 * 2048 + s0; rstride = 2048; rowbias = p.b_qkv + 1152; }
        }
        const float* rowscale = nullptr; const float* colscale = nullptr;
        if (ga.hs) { rowscale = swapped ? ga.wsc + n0 : ga.hs + m0; colscale = swapped ? ga.hs + m0 : ga.wsc + n0; }
        float csv[8];
#pragma unroll
        for (int e = 0; e < 8; ++e) csv[e] = 1.f;
        if (colscale) {
            const float4 a = *(const float4*)(colscale + c8 * 8), bq = *(const float4*)(colscale + c8 * 8 + 4);
            csv[0] = a.x; csv[1] = a.y; csv[2] = a.z; csv[3] = a.w; csv[4] = bq.x; csv[5] = bq.y; csv[6] = bq.z; csv[7] = bq.w;
        }
        float cbv[8];
#pragma unroll
        for (int e = 0; e < 8; ++e) cbv[e] = 0.f;
        if (colbias) {
            const float4 a = *(const float4*)(colbias + c8 * 8), bq = *(const float4*)(colbias + c8 * 8 + 4);
            cbv[0] = a.x; cbv[1] = a.y; cbv[2] = a.z; cbv[3] = a.w; cbv[4] = bq.x; cbv[5] = bq.y; cbv[6] = bq.z; cbv[7] = bq.w;
        }
        bf16_t* dp = dst + (size_t)rr * rstride + c8 * 8;
#pragma unroll
        for (int it = 0; it < 8; ++it) {
            const int row = rr + 16 * it;
            const float4 c0 = *(const float4*)(Ct + row * CT_LD + c8 * 8);
            const float4 c1 = *(const float4*)(Ct + row * CT_LD + c8 * 8 + 4);
            float rbv = 0.f, rsv = 1.f;
            if (rowbias) rbv = rowbias[row];
            if (rowscale) rsv = rowscale[row];
            uint4 o;
            o.x = pack2bf(c0.x * rsv * csv[0] + cbv[0] + rbv, c0.y * rsv * csv[1] + cbv[1] + rbv);
            o.y = pack2bf(c0.z * rsv * csv[2] + cbv[2] + rbv, c0.w * rsv * csv[3] + cbv[3] + rbv);
            o.z = pack2bf(c1.x * rsv * csv[4] + cbv[4] + rbv, c1.y * rsv * csv[5] + cbv[5] + rbv);
            o.w = pack2bf(c1.z * rsv * csv[6] + cbv[6] + rbv, c1.w * rsv * csv[7] + cbv[7] + rbv);
            { u32x4_t ov_; ov_.x = o.x; ov_.y = o.y; ov_.z = o.z; ov_.w = o.w; __builtin_nontemporal_store(ov_, (u32x4_t*)(dp + (size_t)it * 16 * rstride)); }
        }
    }
    __syncthreads();
}

#define GT_BYTES 16384
typedef int i32x4_t __attribute__((ext_vector_type(4)));
typedef int i32x16_t __attribute__((ext_vector_type(16)));
template <int MODE, bool I8>
DI void phase_gemm(const Params& p, char* ws, const GemmArgs& ga, char* smem) {
    const int tid = get_tid(), lane = tid & 63, wave = tid >> 6;
    const int wm = wave >> 1, wn = wave & 1;
    const int r = lane & 31, h = lane >> 5;
    const int NT = ga.N / 128;
    const int total = 256 * NT;
    constexpr int RS = I8 ? 1024 : 2048;
    constexpr int NK = I8 ? 8 : 16;
    const int srow = wave * 8 + (lane >> 3);
    const int scg = (lane & 7) ^ ((((wave & 1) << 2) + (lane >> 4)) & 7);
    const size_t soff = (size_t)srow * RS + scg * 16;
    const int fsw = (r >> 1) & 7;
    int fo[4];
#pragma unroll
    for (int ks = 0; ks < 4; ++ks) fo[ks] = ((ks * 2 + h) ^ fsw) * 16;
    for (int ti = blockIdx.x; ti < total; ti += gridDim.x) {
        const int label = ti & 7, j = ti >> 3;
        const int tm = label * 32 + j / NT, tn = j % NT;
        const int m0 = tm * 128, n0 = tn * 128;
        bool swapped = false;
        if (MODE == GM_INPROJ) swapped = (tn >= 4 && tn < 8);
        if (MODE == GM_QKV) swapped = (tn == 9);
        const char* Ag = (const char*)ga.A + (size_t)m0 * RS + soff;
        const char* Bg = (const char*)ga.Bt + (size_t)n0 * RS + soff;
        f32x16 acc[2][2];
        i32x16_t acci[2][2];
#pragma unroll
        for (int a = 0; a < 2; ++a) {
            zero_acc<2>(acc[a]);
#pragma unroll
            for (int b2 = 0; b2 < 2; ++b2)
#pragma unroll
                for (int i = 0; i < 16; ++i) acci[a][b2][i] = 0;
        }
#define GEMM_STAGE(BUF, KT)                                                                                           \
        _Pragma("unroll") for (int i = 0; i < 4; ++i) {                                                                \
            __builtin_amdgcn_global_load_lds((const unsigned*)(Ag + (size_t)i * 32 * RS + (KT) * 128),                \
                                             (unsigned*)(smem + (BUF) * 2 * GT_BYTES + (i * 4 + wave) * 1024), 16, 0, 0); \
            __builtin_amdgcn_global_load_lds((const unsigned*)(Bg + (size_t)i * 32 * RS + (KT) * 128),                \
                                             (unsigned*)(smem + (BUF) * 2 * GT_BYTES + GT_BYTES + (i * 4 + wave) * 1024), 16, 0, 0); \
        }
        f32x4n_t xi[16];
        if (MODE == GM_RESID) {
            const float* xp = (const float*)ga.xin + (size_t)(m0 + (tid >> 5)) * 1024 + n0 + (tid & 31) * 4;
#pragma unroll
            for (int it = 0; it < 16; ++it) xi[it] = __builtin_nontemporal_load((const f32x4n_t*)(xp + (size_t)it * 8 * 1024));
        }
        if (MODE == GM_RESID_BF) {
            const bf16_t* xp = (const bf16_t*)ga.xin + (size_t)(m0 + (tid >> 5)) * 1024 + n0 + (tid & 31) * 4;
#pragma unroll
            for (int it = 0; it < 16; ++it) {
                const u32x2_t q = __builtin_nontemporal_load((const u32x2_t*)(xp + (size_t)it * 8 * 1024));
                xi[it].x = __uint_as_float(q.x); xi[it].y = __uint_as_float(q.y);
            }
        }
        GEMM_STAGE(0, 0)
        asm volatile("s_waitcnt vmcnt(0)" ::: "memory");
        __syncthreads();
        for (int kt = 0; kt < NK; ++kt) {
            const int cur = kt & 1;
            if (kt < NK - 1) { GEMM_STAGE(cur ^ 1, kt + 1) }
            const char* At = smem + cur * 2 * GT_BYTES + (swapped ? GT_BYTES : 0) + (wm * 64 + r) * 128;
            const char* Bt2 = smem + cur * 2 * GT_BYTES + (swapped ? 0 : GT_BYTES) + (wn * 64 + r) * 128;
#pragma unroll
            for (int ks = 0; ks < 4; ++ks) {
                if (I8) {
                    i32x4_t af[2], bfr[2];
                    af[0] = *(const i32x4_t*)(At + fo[ks]);
                    af[1] = *(const i32x4_t*)(At + 32 * 128 + fo[ks]);
                    bfr[0] = *(const i32x4_t*)(Bt2 + fo[ks]);
                    bfr[1] = *(const i32x4_t*)(Bt2 + 32 * 128 + fo[ks]);
#pragma unroll
                    for (int mt = 0; mt < 2; ++mt)
#pragma unroll
                        for (int nt = 0; nt < 2; ++nt) acci[mt][nt] = __builtin_amdgcn_mfma_i32_32x32x32_i8(af[mt], bfr[nt], acci[mt][nt], 0, 0, 0);
                } else {
                    bf16x8 af[2], bfr[2];
                    af[0] = *(const bf16x8*)(At + fo[ks]);
                    af[1] = *(const bf16x8*)(At + 32 * 128 + fo[ks]);
                    bfr[0] = *(const bf16x8*)(Bt2 + fo[ks]);
                    bfr[1] = *(const bf16x8*)(Bt2 + 32 * 128 + fo[ks]);
#pragma unroll
                    for (int mt = 0; mt < 2; ++mt)
#pragma unroll
                        for (int nt = 0; nt < 2; ++nt) acc[mt][nt] = MFMA32(af[mt], bfr[nt], acc[mt][nt]);
                }
            }
            asm volatile("s_waitcnt vmcnt(0) lgkmcnt(0)" ::: "memory");
            __syncthreads();
        }
        if (I8) {
#pragma unroll
            for (int mt = 0; mt < 2; ++mt)
#pragma unroll
                for (int nt = 0; nt < 2; ++nt)
#pragma unroll
                    for (int i = 0; i < 16; ++i) acc[mt][nt][i] = (float)acci[mt][nt][i];
        }
        gemm_epilogue<MODE>(p, ws, ga, acc, m0, n0, tn, wm, wn, tid, swapped, (float*)smem, xi);
    }
}

#define KW_LD 136
DI void phase_m1b(const Params& p, char* ws, char* smem) {
    const bf16_t* VT = (const bf16_t*)(ws + OFF_R3) + (size_t)T_TOK * 512;
    bf16_t* Qm = (bf16_t*)(ws + OFF_R1);
    bf16_t* Km = (bf16_t*)(ws + OFF_R1 + 32ull * MiB);
    float* DT = (float*)(ws + OFF_R5);
    const bf16_t* WqT = (const bf16_t*)(ws + OFF_WQT);
    const bf16_t* WkT = (const bf16_t*)(ws + OFF_WKT);
    const float* ipre = (const float*)(ws + OFF_IPRE);
    const float* logf_ = (const float*)(ws + OFF_LOGF);
    float* Gc = (float*)(ws + OFF_G);
    float* Bv = (float*)(ws + OFF_BV);
    float* usc = (float*)(ws + OFF_USC);
    float* ND = (float*)(ws + OFF_ND);
    bf16_t* KwT = (bf16_t*)smem;
    float* wv = (float*)(smem + 128 * KW_LD * 2);
    bf16_t* CMs = (bf16_t*)(smem + 128 * KW_LD * 2 + 512);
    bf16_t* CMg = (bf16_t*)(ws + OFF_R5 + 64ull * MiB);
    const bf16_t* UM = (const bf16_t*)(ws + OFF_R3);
    const int tid = get_tid(), lane = tid & 63, wave = tid >> 6;
    const int r = lane & 31, h = lane >> 5;
    const int cvc = tid & 15, csub = tid >> 4;
    for (int unit = blockIdx.x; unit < 1024; unit += gridDim.x) {
        const int c = unit & 15, hd = (unit >> 4) & 3, b = unit >> 6;
        const size_t t0 = (size_t)b * SEQ + c * 128;
        __syncthreads();
        {
            const int ch0 = hd * 128 + cvc * 8;
            float cw[4][8], cb[8];
#pragma unroll
            for (int jx = 0; jx < 4; ++jx) {
                const float4 a0 = *(const float4*)(p.conv_w + jx * 512 + ch0), a1 = *(const float4*)(p.conv_w + jx * 512 + ch0 + 4);
                cw[jx][0] = a0.x; cw[jx][1] = a0.y; cw[jx][2] = a0.z; cw[jx][3] = a0.w; cw[jx][4] = a1.x; cw[jx][5] = a1.y; cw[jx][6] = a1.z; cw[jx][7] = a1.w;
            }
            {
                const float4 a0 = *(const float4*)(p.conv_b + ch0), a1 = *(const float4*)(p.conv_b + ch0 + 4);
                cb[0] = a0.x; cb[1] = a0.y; cb[2] = a0.z; cb[3] = a0.w; cb[4] = a1.x; cb[5] = a1.y; cb[6] = a1.z; cb[7] = a1.w;
            }
            u32x4_t raw[11];
#pragma unroll
            for (int q = 0; q < 11; ++q) {
                const int sq = c * 128 + csub * 8 + q - 3;
                raw[q] = (u32x4_t){0u, 0u, 0u, 0u};
                if (sq >= 0) raw[q] = *(const u32x4_t*)(UM + ((size_t)b * SEQ + sq) * 512 + ch0);
            }
            float hist[3][8];
#pragma unroll
            for (int q = 0; q < 3; ++q) {
                const unsigned w[4] = {raw[q].x, raw[q].y, raw[q].z, raw[q].w};
#pragma unroll
                for (int e = 0; e < 4; ++e) { hist[q][2 * e] = __uint_as_float(w[e] << 16); hist[q][2 * e + 1] = __uint_as_float(w[e] & 0xffff0000u); }
            }
#pragma unroll
            for (int q = 0; q < 8; ++q) {
                const unsigned w[4] = {raw[q + 3].x, raw[q + 3].y, raw[q + 3].z, raw[q + 3].w};
                float cur[8], o[8];
#pragma unroll
                for (int e = 0; e < 4; ++e) { cur[2 * e] = __uint_as_float(w[e] << 16); cur[2 * e + 1] = __uint_as_float(w[e] & 0xffff0000u); }
#pragma unroll
                for (int e = 0; e < 8; ++e) {
                    const float a = cw[0][e] * hist[0][e] + cw[1][e] * hist[1][e] + cw[2][e] * hist[2][e] + cw[3][e] * cur[e] + cb[e];
                    o[e] = siluf_(a);
                    hist[0][e] = hist[1][e]; hist[1][e] = hist[2][e]; hist[2][e] = cur[e];
                }
                u32x4_t ov;
                ov.x = pack2bf(o[0], o[1]); ov.y = pack2bf(o[2], o[3]); ov.z = pack2bf(o[4], o[5]); ov.w = pack2bf(o[6], o[7]);
                const int sl_ = csub * 8 + q;
                *(u32x4_t*)(CMs + sl_ * KW_LD + cvc * 8) = ov;
                *(u32x4_t*)(CMg + (t0 + sl_) * 512 + ch0) = ov;
            }
        }
        if (wave == 0) {
            const float i0 = ipre[(t0 + 2 * lane) * 4 + hd], i1 = ipre[(t0 + 2 * lane + 1) * 4 + hd];
            const float f0 = logf_[(t0 + 2 * lane) * 4 + hd], f1 = logf_[(t0 + 2 * lane + 1) * 4 + hd];
            float s = f0 + f1;
#pragma unroll
            for (int d = 1; d < 64; d <<= 1) { const float t = __shfl_up(s, d); if (lane >= d) s += t; }
            const float g1 = s, g0 = s - f1;
            const float gtot = __shfl(s, 63);
            const float b0 = i0 - g0, b1 = i1 - g1;
            float bm = fmaxf(b0, b1);
#pragma unroll
            for (int o = 32; o >= 1; o >>= 1) bm = fmaxf(bm, __shfl_xor(bm, o));
            const float Mc = gtot + bm;
            wv[2 * lane] = __expf(b0 - bm);
            wv[2 * lane + 1] = __expf(b1 - bm);
            Gc[(t0 + 2 * lane) * 4 + hd] = g0; Gc[(t0 + 2 * lane + 1) * 4 + hd] = g1;
            Bv[(t0 + 2 * lane) * 4 + hd] = b0; Bv[(t0 + 2 * lane + 1) * 4 + hd] = b1;
            if (lane == 0) { usc[unit * 4 + 0] = Mc; usc[unit * 4 + 1] = gtot; }
        }
        __syncthreads();
        const bf16_t* Acm = CMs;
        {
            f32x16 acc[4];
            zero_acc<4>(acc);
            wave_mma<4, 8>(acc, Acm + (wave * 32) * KW_LD, KW_LD, WqT + (size_t)hd * 16384, 128, lane);
            {
                bf16_t* qb = Qm + (t0 + wave * 32 + 4 * h) * 512 + hd * 128 + r;
#pragma unroll
                for (int i4 = 0; i4 < 4; ++i4) {
                    bf16_t* q2 = qb + (size_t)i4 * 8 * 512;
                    LAUNDER(q2);
#pragma unroll
                    for (int ii = 0; ii < 4; ++ii)
#pragma unroll
                        for (int nt = 0; nt < 4; ++nt) q2[ii * 512 + nt * 32] = f2bf(acc[nt][i4 * 4 + ii]);
                }
            }
            zero_acc<4>(acc);
            wave_mma<4, 8>(acc, Acm + (wave * 32) * KW_LD, KW_LD, WkT + (size_t)hd * 16384, 128, lane);
            {
                bf16_t* qb = Km + (t0 + wave * 32 + 4 * h) * 512 + hd * 128 + r;
#pragma unroll
                for (int i4 = 0; i4 < 4; ++i4) {
                    bf16_t* q2 = qb + (size_t)i4 * 8 * 512;
                    LAUNDER(q2);
#pragma unroll
                    for (int ii = 0; ii < 4; ++ii)
#pragma unroll
                        for (int nt = 0; nt < 4; ++nt) q2[ii * 512 + nt * 32] = f2bf(acc[nt][i4 * 4 + ii]);
                }
            }
        }
        {
            f32x16 acc[4];
            zero_acc<4>(acc);
            wave_mma<4, 8>(acc, WkT + (size_t)hd * 16384 + (size_t)(wave * 32) * 128, 128, Acm, KW_LD, lane);
#pragma unroll
            for (int nt = 0; nt < 4; ++nt) {
                const float w = wv[nt * 32 + r];
#pragma unroll
                for (int i = 0; i < 16; ++i) KwT[(wave * 32 + crow(i, h)) * KW_LD + nt * 32 + r] = f2bf(acc[nt][i] * w);
            }
        }
        __syncthreads();
        if (tid < 128) {
            float s = 0.f;
            for (int q = 0; q < 128; ++q) s += bf2f(KwT[tid * KW_LD + q]);
            ND[(size_t)unit * 128 + tid] = s;
        }
        {
            f32x16 acc[4];
            zero_acc<4>(acc);
            const bf16_t* Av = VT + ((size_t)b * 512 + hd * 128 + wave * 32) * 2048 + c * 128;
            wave_mma<4, 8>(acc, Av, 2048, KwT, KW_LD, lane);
            float* dst = DT + (size_t)unit * 16384 + (wave * 32 + 4 * h) * 128 + r;
#pragma unroll
            for (int i4 = 0; i4 < 4; ++i4) {
                float* d2 = dst + i4 * 8 * 128;
                LAUNDER(d2);
#pragma unroll
                for (int ii = 0; ii < 4; ++ii)
#pragma unroll
                    for (int nt = 0; nt < 4; ++nt) d2[ii * 128 + nt * 32] = acc[nt][i4 * 4 + ii];
            }
        }
    }
    __syncthreads();
}

DI void phase_m2(const Params& p, char* ws) {
    (void)p;
    const float* DT = (const float*)(ws + OFF_R5);
    bf16_t* Cin = (bf16_t*)(ws + OFF_R2);
    float* usc = (float*)(ws + OFF_USC);
    const float* ND = (const float*)(ws + OFF_ND);
    float* NIN = (float*)(ws + OFF_NIN);
    const size_t gtid = (size_t)blockIdx.x * 256 + get_tid(), gsz = (size_t)gridDim.x * 256;
    const size_t total = (size_t)64 * (16384 + 128);
    for (size_t it = gtid; it < total; it += gsz) {
        const int bh = (int)(it / (16384 + 128));
        const int idx = (int)(it % (16384 + 128));
        const bool isC = idx < 16384;
        const float* src = isC ? DT + (size_t)bh * 16 * 16384 + idx : ND + (size_t)bh * 16 * 128 + (idx - 16384);
        const size_t cstride = isC ? 16384 : 128;
        float dv[16], dec[16], sc[16];
#pragma unroll
        for (int c = 0; c < 16; ++c) dv[c] = src[(size_t)c * cstride];
        float m = NEG_INF_F;
#pragma unroll
        for (int c = 0; c < 16; ++c) {
            const int unit = bh * 16 + c;
            const float Mc = usc[unit * 4 + 0], gt = usc[unit * 4 + 1];
            const float mnew = fmaxf(gt + m, Mc);
            dec[c] = __expf(gt + m - mnew); sc[c] = __expf(Mc - mnew);
            if (idx == 16384) usc[unit * 4 + 2] = m;
            m = mnew;
        }
        float st = 0.f;
#pragma unroll
        for (int c = 0; c < 16; ++c) {
            const int unit = bh * 16 + c;
            if (isC) Cin[(size_t)unit * 16384 + idx] = f2bf(st);
            else NIN[(size_t)unit * 128 + (idx - 16384)] = st;
            st = dec[c] * st + sc[c] * dv[c];
        }
    }
}

template <int NT, int KSTEPS>
DI void wave_mma_regA_ldsB(f32x16 (&acc)[NT], const bf16x8 (&af)[KSTEPS], const bf16_t* B, int ldb, int lane) {
    const int r = lane & 31, h = lane >> 5;
#pragma unroll
    for (int ks = 0; ks < KSTEPS; ++ks) {
#pragma unroll
        for (int nt = 0; nt < NT; ++nt) acc[nt] = MFMA32(af[ks], *(const bf16x8*)(B + (nt * 32 + r) * ldb + ks * 16 + h * 8), acc[nt]);
        if (ks & 1) __builtin_amdgcn_sched_barrier(0);
    }
}
template <int NT, int KSTEPS>
DI void wave_mma_ldsAB(f32x16 (&acc)[NT], const bf16_t* A, int lda, const bf16_t* B, int ldb, int lane) {
    const int r = lane & 31, h = lane >> 5;
#pragma unroll
    for (int ks = 0; ks < KSTEPS; ++ks) {
        const bf16x8 a = *(const bf16x8*)(A + r * lda + ks * 16 + h * 8);
#pragma unroll
        for (int nt = 0; nt < NT; ++nt) acc[nt] = MFMA32(a, *(const bf16x8*)(B + (nt * 32 + r) * ldb + ks * 16 + h * 8), acc[nt]);
        if (ks & 1) asm volatile("" ::: "memory");
    }
}
DI void phase_m3(const Params& p, char* ws, char* smem) {
    const bf16_t* R3 = (const bf16_t*)(ws + OFF_R3);
    const bf16_t* VT = R3 + (size_t)T_TOK * 512;
    const bf16_t* Zb = R3 + (size_t)2 * T_TOK * 512;
    const bf16_t* CM = (const bf16_t*)(ws + OFF_R5 + 64ull * MiB);
    const bf16_t* Qm = (const bf16_t*)(ws + OFF_R1);
    const bf16_t* Km = (const bf16_t*)(ws + OFF_R1 + 32ull * MiB);
    const bf16_t* Cin = (const bf16_t*)(ws + OFF_R2);
    const bf16_t* PWT = (const bf16_t*)(ws + OFF_PWT);
    const float* Gc = (const float*)(ws + OFF_G);
    const float* Bv = (const float*)(ws + OFF_BV);
    const float* usc = (const float*)(ws + OFF_USC);
    const float* NIN = (const float*)(ws + OFF_NIN);
    bf16_t* MIX = (bf16_t*)(ws + OFF_R4);
    const int tid = get_tid(), lane = tid & 63, wave = tid >> 6;
    const int r = lane & 31, h = lane >> 5;
    bf16_t* Sp = (bf16_t*)smem + (size_t)wave * 32 * KW_LD;
    bf16_t* OPB = (bf16_t*)(smem + 4 * 32 * KW_LD * 2);
    float* fb = (float*)(smem + 2 * 4 * 32 * KW_LD * 2);
    float* gs = fb;
    float* bs = fb + 128;
    float* mxs = fb + 256;
    float* nin = fb + 384;
    float* qns = fb + 512;
    const int srow = tid >> 4, sch = tid & 15;
    for (int u2 = blockIdx.x; u2 < 1024; u2 += gridDim.x) {
        const int g = u2 & 3, c = (u2 >> 2) & 15, b = u2 >> 6;
        const size_t t0 = (size_t)b * SEQ + c * 128;
        u32x4_t R[8];
#pragma unroll
        for (int q = 0; q < 8; ++q) R[q] = *(const u32x4_t*)(PWT + (size_t)g * 16384 + (size_t)(srow + 16 * q) * 128 + sch * 8);
        __syncthreads();
#pragma unroll
        for (int q = 0; q < 8; ++q) *(u32x4_t*)(OPB + (srow + 16 * q) * KW_LD + sch * 8) = R[q];
        {
            const bf16_t* UP = (const bf16_t*)(ws + OFF_R3) + (size_t)3 * T_TOK * 512;
            const int pvc = tid & 15, psub = tid >> 4;
            const int ch0 = g * 128 + pvc * 8;
            const int W = 2 << g;
            const int s0 = c * 128 + psub * 8;
            const size_t tbase = (size_t)b * SEQ;
            float sum[8];
#pragma unroll
            for (int e = 0; e < 8; ++e) sum[e] = 0.f;
            for (int q = 1; q < W; ++q) {
                const int sq = s0 - q;
                if (sq >= 0) {
                    const u32x4_t rw = *(const u32x4_t*)(UP + (tbase + sq) * 512 + ch0);
                    const unsigned w[4] = {rw.x, rw.y, rw.z, rw.w};
#pragma unroll
                    for (int e = 0; e < 4; ++e) { sum[2 * e] += __uint_as_float(w[e] << 16); sum[2 * e + 1] += __uint_as_float(w[e] & 0xffff0000u); }
                }
            }
            u32x4_t rawb[8], rlb[8];
#pragma unroll
            for (int q = 0; q < 8; ++q) {
                const int sq = s0 + q;
                rawb[q] = *(const u32x4_t*)(UP + (tbase + sq) * 512 + ch0);
                const int sl_ = sq - W + 1;
                rlb[q] = (u32x4_t){0u, 0u, 0u, 0u};
                if (sl_ >= 0) rlb[q] = *(const u32x4_t*)(UP + (tbase + sl_) * 512 + ch0);
            }
#pragma unroll
            for (int q = 0; q < 8; ++q) {
                const int sq = s0 + q;
                const unsigned w[4] = {rawb[q].x, rawb[q].y, rawb[q].z, rawb[q].w};
                float cur[8], o[8];
#pragma unroll
                for (int e = 0; e < 4; ++e) { cur[2 * e] = __uint_as_float(w[e] << 16); cur[2 * e + 1] = __uint_as_float(w[e] & 0xffff0000u); }
                const int cnt = (sq + 1 < W) ? (sq + 1) : W;
                const float inv = 1.f / (float)cnt;
#pragma unroll
                for (int e = 0; e < 8; ++e) { sum[e] += cur[e]; o[e] = sum[e] * inv - cur[e]; }
                u32x4_t ov;
                ov.x = pack2bf(o[0], o[1]); ov.y = pack2bf(o[2], o[3]); ov.z = pack2bf(o[4], o[5]); ov.w = pack2bf(o[6], o[7]);
                *(u32x4_t*)((bf16_t*)smem + (psub * 8 + q) * KW_LD + pvc * 8) = ov;
                const unsigned wl[4] = {rlb[q].x, rlb[q].y, rlb[q].z, rlb[q].w};
#pragma unroll
                for (int e = 0; e < 4; ++e) { sum[2 * e] -= __uint_as_float(wl[e] << 16); sum[2 * e + 1] -= __uint_as_float(wl[e] & 0xffff0000u); }
            }
        }
        __syncthreads();
        f32x16 acc[4];
        zero_acc<4>(acc);
        wave_mma_ldsAB<4, 8>(acc, (const bf16_t*)smem + wave * 32 * KW_LD, KW_LD, OPB, KW_LD, lane);
        bf16_t* mb = MIX + (t0 + wave * 32 + 4 * h) * 1024 + 512 + g * 128 + r;
#pragma unroll
        for (int i4 = 0; i4 < 4; ++i4) {
            bf16_t* m2 = mb + (size_t)i4 * 8 * 1024;
            LAUNDER(m2);
#pragma unroll
            for (int ii = 0; ii < 4; ++ii)
#pragma unroll
                for (int nt = 0; nt < 4; ++nt) m2[ii * 1024 + nt * 32] = f2bf(acc[nt][i4 * 4 + ii]);
        }
    }
    for (int unit = blockIdx.x; unit < 1024; unit += gridDim.x) {
        const int c = unit & 15, hd = (unit >> 4) & 3, b = unit >> 6;
        const size_t t0 = (size_t)b * SEQ + c * 128;
        const float m_in = usc[unit * 4 + 2];
        const int l0 = wave * 32;
        bf16x8 qf[8];
#pragma unroll
        for (int ks = 0; ks < 8; ++ks) qf[ks] = *(const bf16x8*)(Qm + (t0 + l0 + r) * 512 + hd * 128 + ks * 16 + h * 8);
        __syncthreads();
        if (wave == 0) {
            const float b0 = Bv[(t0 + 2 * lane) * 4 + hd], b1 = Bv[(t0 + 2 * lane + 1) * 4 + hd];
            float s = fmaxf(b0, b1);
#pragma unroll
            for (int d = 1; d < 64; d <<= 1) { const float t = __shfl_up(s, d); if (lane >= d) s = fmaxf(s, t); }
            float prev = __shfl_up(s, 1);
            if (lane == 0) prev = NEG_INF_F;
            const float pm0 = fmaxf(prev, b0), pm1 = s;
            bs[2 * lane] = b0; bs[2 * lane + 1] = b1;
            mxs[2 * lane] = fmaxf(m_in, pm0); mxs[2 * lane + 1] = fmaxf(m_in, pm1);
        } else if (wave == 1) {
            gs[2 * lane] = Gc[(t0 + 2 * lane) * 4 + hd]; gs[2 * lane + 1] = Gc[(t0 + 2 * lane + 1) * 4 + hd];
            nin[2 * lane] = NIN[(size_t)unit * 128 + 2 * lane]; nin[2 * lane + 1] = NIN[(size_t)unit * 128 + 2 * lane + 1];
        }
        {
            u32x4_t R[8];
#pragma unroll
            for (int q = 0; q < 8; ++q) R[q] = *(const u32x4_t*)(Km + (t0 + srow + 16 * q) * 512 + hd * 128 + sch * 8);
#pragma unroll
            for (int q = 0; q < 8; ++q) *(u32x4_t*)(OPB + (srow + 16 * q) * KW_LD + sch * 8) = R[q];
        }
        __syncthreads();
        if (lane < 32) {
            const bf16_t* qr = Qm + (t0 + l0 + lane) * 512 + hd * 128;
            float s = 0.f;
            for (int d8 = 0; d8 < 16; ++d8) {
                const uint4 raw = *(const uint4*)(qr + d8 * 8);
                const unsigned w[4] = {raw.x, raw.y, raw.z, raw.w};
#pragma unroll
                for (int e = 0; e < 4; ++e) s += bf2f((bf16_t)(w[e] & 0xffff)) * nin[d8 * 8 + 2 * e] + bf2f((bf16_t)(w[e] >> 16)) * nin[d8 * 8 + 2 * e + 1];
            }
            qns[wave * 32 + lane] = s;
        }
        float den2[16];
        {
            f32x16 acc[4];
            zero_acc<4>(acc);
            wave_mma_regA_ldsB<4, 8>(acc, qf, OPB, KW_LD, lane);
#pragma unroll
            for (int i = 0; i < 16; ++i) {
                const int l = l0 + crow(i, h);
                const float mxl = mxs[l];
                float rs = 0.f;
#pragma unroll
                for (int nt = 0; nt < 4; ++nt) {
                    const int sx = nt * 32 + r;
                    float v = 0.f;
                    if (sx <= l) v = acc[nt][i] * __expf(fminf(bs[sx] - mxl, 0.f));
                    rs += v;
                    Sp[crow(i, h) * KW_LD + sx] = f2bf(v);
                }
                den2[i] = half_sum(rs);
            }
        }
#pragma unroll
        for (int ks = 0; ks < 8; ++ks) qf[ks] = *(const bf16x8*)(Qm + (t0 + l0 + r) * 512 + hd * 128 + ks * 16 + h * 8);
        __syncthreads();
        {
            u32x4_t R[8];
#pragma unroll
            for (int q = 0; q < 8; ++q) R[q] = *(const u32x4_t*)(Cin + (size_t)unit * 16384 + (size_t)(srow + 16 * q) * 128 + sch * 8);
#pragma unroll
            for (int q = 0; q < 8; ++q) *(u32x4_t*)(OPB + (srow + 16 * q) * KW_LD + sch * 8) = R[q];
        }
        __syncthreads();
        f32x16 acc[4];
        zero_acc<4>(acc);
        wave_mma_regA_ldsB<4, 8>(acc, qf, OPB, KW_LD, lane);
#pragma unroll
        for (int i = 0; i < 16; ++i) {
            const int l = l0 + crow(i, h);
            const float inter_i = __expf(m_in - mxs[l]);
#pragma unroll
            for (int nt = 0; nt < 4; ++nt) acc[nt][i] *= inter_i;
        }
        __syncthreads();
        {
            u32x4_t R[8];
#pragma unroll
            for (int q = 0; q < 8; ++q) R[q] = *(const u32x4_t*)(VT + ((size_t)b * 512 + hd * 128 + srow + 16 * q) * 2048 + c * 128 + sch * 8);
#pragma unroll
            for (int q = 0; q < 8; ++q) *(u32x4_t*)(OPB + (srow + 16 * q) * KW_LD + sch * 8) = R[q];
        }
        __syncthreads();
        wave_mma_ldsAB<4, 8>(acc, Sp, KW_LD, OPB, KW_LD, lane);
#pragma unroll
        for (int i = 0; i < 16; ++i) {
            const int lr = crow(i, h), l = l0 + lr;
            const float den = __expf(m_in - mxs[l]) * qns[wave * 32 + lr] + den2[i];
            const float mrow = gs[l] + mxs[l];
            const float dn = fmaxf(fabsf(den), __expf(-mrow)) + 1e-6f;
            const float inv = 1.f / dn;
            float hv[4];
            float sm = 0.f;
#pragma unroll
            for (int nt = 0; nt < 4; ++nt) { hv[nt] = acc[nt][i] * inv; sm += hv[nt]; }
            const float mu = half_sum(sm) * (1.f / 128.f);
            float sq = 0.f;
#pragma unroll
            for (int nt = 0; nt < 4; ++nt) { const float d = hv[nt] - mu; sq += d * d; }
            const float var = half_sum(sq) * (1.f / 128.f);
            const float rstd = rsqrtf(var + 1e-6f);
#pragma unroll
            for (int nt = 0; nt < 4; ++nt) Sp[lr * KW_LD + nt * 32 + r] = f2bf((hv[nt] - mu) * rstd);
        }
        {
            const int c8 = lane & 15;
            const bf16_t* zrow = Zb + (t0 + l0 + (lane >> 4)) * 512 + hd * 128 + c8 * 8;
            const bf16_t* crow_ = CM + (t0 + l0 + (lane >> 4)) * 512 + hd * 128 + c8 * 8;
            bf16_t* mrow = MIX + (t0 + l0 + (lane >> 4)) * 1024 + hd * 128 + c8 * 8;
            const float* hgp = p.head_g + hd * 128 + c8 * 8;
            const float* skp = p.skip + hd * 128 + c8 * 8;
            LAUNDER(zrow); LAUNDER(crow_); LAUNDER(mrow); LAUNDER(hgp); LAUNDER(skp);
            const float4 hgA = *(const float4*)(hgp), hgB = *(const float4*)(hgp + 4);
            const float4 skA = *(const float4*)(skp), skB = *(const float4*)(skp + 4);
#pragma unroll
            for (int hb = 0; hb < 2; ++hb) {
                uint4 zq[4], cq[4];
#pragma unroll
                for (int it = 0; it < 4; ++it) {
                    zq[it] = *(const uint4*)(zrow + (size_t)(hb * 4 + it) * 4 * 512);
                    cq[it] = *(const uint4*)(crow_ + (size_t)(hb * 4 + it) * 4 * 512);
                }
#pragma unroll
                for (int it = 0; it < 4; ++it) {
                    const int row = (hb * 4 + it) * 4 + (lane >> 4);
                    const uint4 hq = *(const uint4*)(Sp + row * KW_LD + c8 * 8);
#define M3_GATE(HW, ZW, CW, G0, G1, S0, S1, OUTW)                                                             \
                    {                                                                                           \
                        const float h0_ = __uint_as_float((HW) << 16), h1_ = __uint_as_float((HW) & 0xffff0000u); \
                        const float z0_ = __uint_as_float((ZW) << 16), z1_ = __uint_as_float((ZW) & 0xffff0000u); \
                        const float m0_ = __uint_as_float((CW) << 16), m1_ = __uint_as_float((CW) & 0xffff0000u); \
                        OUTW = pack2bf(sigmoidf_(z0_) * (h0_ * (G0) + (S0) * m0_), sigmoidf_(z1_) * (h1_ * (G1) + (S1) * m1_)); \
                    }
                    uint4 ov;
                    M3_GATE(hq.x, zq[it].x, cq[it].x, hgA.x, hgA.y, skA.x, skA.y, ov.x)
                    M3_GATE(hq.y, zq[it].y, cq[it].y, hgA.z, hgA.w, skA.z, skA.w, ov.y)
                    M3_GATE(hq.z, zq[it].z, cq[it].z, hgB.x, hgB.y, skB.x, skB.y, ov.z)
                    M3_GATE(hq.w, zq[it].w, cq[it].w, hgB.z, hgB.w, skB.z, skB.w, ov.w)
                    *(uint4*)(mrow + (size_t)(hb * 4 + it) * 4 * 1024) = ov;
                }
                asm volatile("" ::: "memory");
            }
        }
    }
    __syncthreads();
}

DI void phase_pre_scoremat(const Params& p, char* ws, char* smem) {
    bf16_t* As = (bf16_t*)smem;
    bf16_t* Bs = (bf16_t*)(smem + 128 * KW_LD * 2);
    float* M = (float*)(ws + OFF_M);
    const int tid = get_tid(), lane = tid & 63, wave = tid >> 6, r = lane & 31, h = lane >> 5;
    for (int u = (int)gridDim.x - 1 - (int)blockIdx.x; u < 256; u += gridDim.x) {
        const int layer = u >> 7, hp = (u >> 3) & 15, c0 = (u & 7) * 128;
        __syncthreads();
        for (int i = tid; i < 128 * 32; i += 256) {
            const int row = i >> 5, ch = i & 31;
            const float4 v = *(const float4*)(p.peer_wq + ((size_t)layer * 1024 + c0 + row) * 2048 + hp * 128 + ch * 4);
            *(uint2*)(As + row * KW_LD + ch * 4) = make_uint2(pack2bf(v.x, v.y), pack2bf(v.z, v.w));
            const float4 w = *(const float4*)(p.peer_keys + (((size_t)layer * 16 + hp) * 128 + row) * 128 + ch * 4);
            *(uint2*)(Bs + row * KW_LD + ch * 4) = make_uint2(pack2bf(w.x, w.y), pack2bf(w.z, w.w));
        }
        __syncthreads();
        f32x16 acc[4];
        zero_acc<4>(acc);
        wave_mma_ldsAB<4, 8>(acc, As + wave * 32 * KW_LD, KW_LD, Bs, KW_LD, lane);
        float* mb = M + ((size_t)layer * 1024 + c0 + wave * 32 + 4 * h) * 2048 + hp * 128 + r;
#pragma unroll
        for (int i4 = 0; i4 < 4; ++i4) {
            float* m2 = mb + (size_t)i4 * 8 * 2048;
            LAUNDER(m2);
#pragma unroll
            for (int ii = 0; ii < 4; ++ii)
#pragma unroll
                for (int nt = 0; nt < 4; ++nt) m2[ii * 2048 + nt * 32] = acc[nt][i4 * 4 + ii];
        }
    }
    __syncthreads();
}

DI unsigned f2ord(float x) { const unsigned u = __float_as_uint(x); return (u & 0x80000000u) ? ~u : (u | 0x80000000u); }
DI float ord2f(unsigned k) { const unsigned u = (k & 0x80000000u) ? (k & 0x7fffffffu) : ~k; return __uint_as_float(u); }

DI void convert_row_load(const Params& p, int layer, int row, int lane, float (&v)[16]) {
    const int tab = row >> 14, e = row & 16383;
    const float* src = (tab ? p.peer_v : p.peer_u) + ((size_t)layer * 16384 + e) * 1024 + lane * 16;
#pragma unroll
    for (int i = 0; i < 4; ++i) {
        const f32x4n_t q = __builtin_nontemporal_load((const f32x4n_t*)(src + i * 4));
        v[i * 4 + 0] = q.x; v[i * 4 + 1] = q.y; v[i * 4 + 2] = q.z; v[i * 4 + 3] = q.w;
    }
}
#define TAB_V_OFF (8ull * MiB)
DI void convert_row_finish(char* ws, int layer, int row, int lane, const float (&v)[16]) {
    unsigned char* T8 = (unsigned char*)(ws + OFF_R4);
    float2* SC = (float2*)(ws + OFF_SC) + (size_t)layer * 16384;
    const int tab = row >> 14, e = row & 16383;
    float am = 0.f, ss = 0.f;
#pragma unroll
    for (int i = 0; i < 16; ++i) { am = fmaxf(am, fabsf(v[i])); ss += v[i] * v[i]; }
    am = wave_max_dpp(am); ss = wave_sum_dpp(ss);
    const float step = fminf(0.3352f * sqrtf(ss * (1.f / 1024.f)), am * (1.f / 7.5f));
    const float sc = (step > 0.f) ? 1.f / step : 0.f;
    unsigned w[2];
#pragma unroll
    for (int j = 0; j < 2; ++j) {
        unsigned acc = 0;
#pragma unroll
        for (int k = 0; k < 8; ++k) {
            int n = (int)floorf(v[j * 8 + k] * sc) + 8;
            n = n < 0 ? 0 : (n > 15 ? 15 : n);
            const int nibU = (k < 4) ? 2 * k : 2 * (k - 4) + 1;
            const int pos = (tab == 0) ? nibU : k;
            acc |= (unsigned)((pos & 1) ? (n ^ 8) : n) << (4 * pos);
        }
        w[j] = acc;
    }
    *(uint2*)(T8 + (tab ? TAB_V_OFF : 0) + (size_t)(lane >> 4) * (16384 * 128) + (size_t)e * 128 + (lane & 15) * 8) = make_uint2(w[0], w[1]);
    if (lane == 0) { if (tab == 0) SC[e].x = step * (1.f / 16.f); else SC[e].y = step; }
}

typedef float f32x4 __attribute__((ext_vector_type(4)));
#define MFMA16(a, b, c) __builtin_amdgcn_mfma_f32_16x16x32_bf16((a), (b), (c), 0, 0, 0)
#define DPPU(v, ctrl) ((unsigned)__builtin_amdgcn_mov_dpp((int)(v), (ctrl), 0xF, 0xF, true))
DI unsigned umax_(unsigned a, unsigned b) { return a > b ? a : b; }
DI unsigned row16_umax(unsigned v) {
    v = umax_(v, DPPU(v, 0xB1)); v = umax_(v, DPPU(v, 0x4E)); v = umax_(v, DPPU(v, 0x141)); v = umax_(v, DPPU(v, 0x140));
    return v;
}
DI float row16_sum(float v) {
    v += __int_as_float(__builtin_amdgcn_mov_dpp(__float_as_int(v), 0xB1, 0xF, 0xF, true));
    v += __int_as_float(__builtin_amdgcn_mov_dpp(__float_as_int(v), 0x4E, 0xF, 0xF, true));
    v += __int_as_float(__builtin_amdgcn_mov_dpp(__float_as_int(v), 0x141, 0xF, 0xF, true));
    v += __int_as_float(__builtin_amdgcn_mov_dpp(__float_as_int(v), 0x140, 0xF, 0xF, true));
    return v;
}
DI void cand_pair(int c, int& ia, int& ib) {
    if (c < 16) { ia = 0; ib = c; }
    else if (c < 24) { ia = 1; ib = c - 16; }
    else if (c < 29) { ia = 2; ib = c - 24; }
    else if (c < 33) { ia = 3; ib = c - 29; }
    else if (c < 36) { ia = 4; ib = c - 33; }
    else if (c < 38) { ia = 5; ib = c - 36; }
    else if (c < 40) { ia = 6; ib = c - 38; }
    else if (c < 42) { ia = 7; ib = c - 40; }
    else { ia = c - 34; ib = 0; }
}
DI void phase_topk(const Params& p, char* ws, int layer, char* smem) {
    const bf16_t* Sc = (const bf16_t*)(ws + OFF_R3);
    unsigned* LIST = (unsigned*)(ws + OFF_R5);
    const int tid = get_tid(), lane = tid & 63, wave = tid >> 6;
    const int c16 = lane & 15, q4 = lane >> 4, rowbase = lane & 48;
    int ca[4], cb[4];
#pragma unroll
    for (int q = 0; q < 4; ++q) cand_pair(c16 + 16 * q, ca[q], cb[q]);
    const int hd = (int)blockIdx.x & 7;
    const int nblk = ((int)gridDim.x - hd + 7) >> 3;
    const int wv = ((int)blockIdx.x >> 3) * 4 + wave, nwv = nblk * 4;
    __syncthreads();
    const int gw = (int)blockIdx.x * 4 + wave, ngw = (int)gridDim.x * 4;
    int crow_i = gw;
    u32x4_t sfc[2][4], sfn[2][4];
    {
        const int tl0 = wv < T_TOK / 16 ? wv : T_TOK / 16 - 1;
#pragma unroll
        for (int pp = 0; pp < 2; ++pp)
#pragma unroll
            for (int rg = 0; rg < 4; ++rg) sfc[pp][rg] = *(const u32x4_t*)(Sc + ((size_t)tl0 * 16 + q4 * 4 + rg) * 2048 + (hd * 2 + pp) * 128 + c16 * 8);
    }
    for (int tile = wv; tile < T_TOK / 16; tile += nwv) {
        const size_t t0 = (size_t)tile * 16;
        {
            const int tnx = (tile + nwv < T_TOK / 16) ? tile + nwv : T_TOK / 16 - 1;
#pragma unroll
            for (int pp = 0; pp < 2; ++pp)
#pragma unroll
                for (int rg = 0; rg < 4; ++rg) sfn[pp][rg] = *(const u32x4_t*)(Sc + ((size_t)tnx * 16 + q4 * 4 + rg) * 2048 + (hd * 2 + pp) * 128 + c16 * 8);
        }
        float cva[16], cvb[16];
        const int cr0 = crow_i < 32768 ? crow_i : 32767, cr1 = crow_i + ngw < 32768 ? crow_i + ngw : 32767;
        convert_row_load(p, layer, cr0, lane, cva);
        convert_row_load(p, layer, cr1, lane, cvb);
        crow_i += 2 * ngw;
        unsigned top[2][4];
#pragma unroll
        for (int pp = 0; pp < 2; ++pp) {
            unsigned kk[8][4];
#pragma unroll
            for (int rg = 0; rg < 4; ++rg) {
                const unsigned w[4] = {sfc[pp][rg].x, sfc[pp][rg].y, sfc[pp][rg].z, sfc[pp][rg].w};
#pragma unroll
                for (int e = 0; e < 4; ++e) {
                    kk[2 * e][rg] = (f2ord(__uint_as_float(w[e] << 16)) & ~127u) | (unsigned)(127 - (c16 * 8 + 2 * e));
                    kk[2 * e + 1][rg] = (f2ord(__uint_as_float(w[e] & 0xffff0000u)) & ~127u) | (unsigned)(127 - (c16 * 8 + 2 * e + 1));
                }
            }
#pragma unroll
            for (int rg = 0; rg < 4; ++rg) top[pp][rg] = 0u;
#define CE8(a, b) { const unsigned hi_ = umax_(kk[a][rg], kk[b][rg]); const unsigned lo_ = kk[a][rg] < kk[b][rg] ? kk[a][rg] : kk[b][rg]; kk[a][rg] = hi_; kk[b][rg] = lo_; }
#pragma unroll
            for (int rg = 0; rg < 4; ++rg) {
                CE8(0, 1) CE8(2, 3) CE8(4, 5) CE8(6, 7) CE8(0, 2) CE8(1, 3) CE8(4, 6) CE8(5, 7) CE8(1, 2) CE8(5, 6)
                CE8(0, 4) CE8(3, 7) CE8(1, 5) CE8(2, 6) CE8(1, 4) CE8(3, 6) CE8(2, 4) CE8(3, 5) CE8(3, 4)
            }
            unsigned* hl = (unsigned*)smem + wave * (4 * 64 * 9);
            unsigned head[4], haddr[4];
#pragma unroll
            for (int rg = 0; rg < 4; ++rg) {
                unsigned* hp_ = hl + (rg * 64 + lane) * 9;
#pragma unroll
                for (int j = 0; j < 8; ++j) hp_[j] = kk[j][rg];
                hp_[8] = 0u;
                head[rg] = kk[0][rg];
                haddr[rg] = (unsigned)((rg * 64 + lane) * 9) * 4u;
            }
#pragma unroll 1
            for (int it = 0; it < 16; ++it) {
#pragma unroll
                for (int rg = 0; rg < 4; ++rg) {
                    const unsigned m = row16_umax(head[rg]);
                    if (c16 == it) top[pp][rg] = m;
                    haddr[rg] += (head[rg] == m) ? 4u : 0u;
                    head[rg] = *(const unsigned*)((const char*)hl + haddr[rg]);
                }
            }
        }
        unsigned ck[4][4], win[4];
#pragma unroll
        for (int rg = 0; rg < 4; ++rg) {
            const float va = ord2f(top[0][rg] & ~127u), vb = ord2f(top[1][rg] & ~127u);
#pragma unroll
            for (int q = 0; q < 4; ++q) {
                const float a = __shfl(va, rowbase + ca[q]);
                const float bq = __shfl(vb, rowbase + cb[q]);
                const int c = c16 + 16 * q;
                ck[q][rg] = (c < 50) ? ((f2ord(a + bq) & ~63u) | (unsigned)(63 - c)) : 0u;
            }
            win[rg] = 0u;
        }
#define CE4(a, b) { const unsigned hi_ = umax_(ck[a][rg], ck[b][rg]); const unsigned lo_ = ck[a][rg] < ck[b][rg] ? ck[a][rg] : ck[b][rg]; ck[a][rg] = hi_; ck[b][rg] = lo_; }
#pragma unroll
        for (int rg = 0; rg < 4; ++rg) { CE4(0, 1) CE4(2, 3) CE4(0, 2) CE4(1, 3) CE4(1, 2) }
#pragma unroll 1
        for (int it = 0; it < 16; ++it) {
#pragma unroll
            for (int rg = 0; rg < 4; ++rg) {
                const unsigned m = row16_umax(ck[0][rg]);
                if (c16 == it) win[rg] = m;
                const bool won = (ck[0][rg] == m);
                ck[0][rg] = won ? ck[1][rg] : ck[0][rg];
                ck[1][rg] = won ? ck[2][rg] : ck[1][rg];
                ck[2][rg] = won ? ck[3][rg] : ck[2][rg];
                ck[3][rg] = won ? 0u : ck[3][rg];
            }
        }
#pragma unroll
        for (int rg = 0; rg < 4; ++rg) {
            int ia, ib;
            cand_pair(63 - (int)(win[rg] & 63u), ia, ib);
            ia &= 15; ib &= 15;
            const unsigned ta = (unsigned)__shfl((int)top[0][rg], rowbase + ia);
            const unsigned tb = (unsigned)__shfl((int)top[1][rg], rowbase + ib);
            const int e = (127 - (int)(ta & 127u)) * 128 + (127 - (int)(tb & 127u));
            const float cv = ord2f(win[rg] & ~63u);
            const float cmax = __shfl(cv, rowbase);
            const float ex = __expf(cv - cmax);
            const float den = row16_sum(ex);
            const float g = ex / den;
            const size_t t = t0 + q4 * 4 + rg;
            ((unsigned short*)LIST)[t * 128 + hd * 16 + c16] = (unsigned short)e;
            ((unsigned short*)LIST)[(size_t)T_TOK * 128 + t * 128 + hd * 16 + c16] = f2bf(g);
        }
        convert_row_finish(ws, layer, cr0, lane, cva);
        convert_row_finish(ws, layer, cr1, lane, cvb);
#pragma unroll
        for (int pp = 0; pp < 2; ++pp)
#pragma unroll
            for (int rg = 0; rg < 4; ++rg) sfc[pp][rg] = sfn[pp][rg];
    }
    for (; crow_i < 32768; crow_i += ngw) {
        float cv[16];
        convert_row_load(p, layer, crow_i, lane, cv);
        convert_row_finish(ws, layer, crow_i, lane, cv);
    }
}

typedef float f32x2 __attribute__((ext_vector_type(2)));
DI void fp8x16_to_f32(const uint4& q, float (&f)[16]) {
    const unsigned w[4] = {q.x, q.y, q.z, q.w};
#pragma unroll
    for (int i = 0; i < 4; ++i) {
        const f32x2 lo = __builtin_amdgcn_cvt_pk_f32_fp8((int)w[i], false);
        const f32x2 hi = __builtin_amdgcn_cvt_pk_f32_fp8((int)w[i], true);
        f[i * 4 + 0] = lo.x; f[i * 4 + 1] = lo.y; f[i * 4 + 2] = hi.x; f[i * 4 + 3] = hi.y;
    }
}

DI uint4 nt_load_u4(const void* ptr) { const u32x4_t v = __builtin_nontemporal_load((const u32x4_t*)ptr); return make_uint4(v.x, v.y, v.z, v.w); }
DI float4 nt_load_f4(const void* ptr) { const f32x4n_t v = __builtin_nontemporal_load((const f32x4n_t*)ptr); return make_float4(v.x, v.y, v.z, v.w); }
DI void slice_assign(int& x, int& wv, int& nwv) {
    const int G = (int)gridDim.x;
    x = (int)blockIdx.x & 7;
    const int nblk = (G - x + 7) >> 3;
    wv = ((int)blockIdx.x >> 3) * 4 + (get_tid() >> 6);
    nwv = nblk * 4;
}
DI void peer_issue(const unsigned char* tab, const uint4 (&E)[2], int half, unsigned coloff, uint4 (&buf)[8]) {
    const uint4 ea = half ? E[1] : E[0];
    unsigned w4[4] = {ea.x, ea.y, ea.z, ea.w};
    asm volatile("" : "+v"(w4[0]), "+v"(w4[1]), "+v"(w4[2]), "+v"(w4[3]));
#pragma unroll
    for (int j = 0; j < 8; ++j) {
        const unsigned e = (j & 1) ? (w4[j >> 1] >> 16) : (w4[j >> 1] & 0xffffu);
        buf[j] = *(const uint4*)(tab + (e * 128u + coloff));
    }
}
DI void slice_assign4(int& x, int& wv, int& nwv) {
    const int G = (int)gridDim.x, L = (int)blockIdx.x & 7;
    x = L & 3;
    const int nb_lo = (G - x + 7) >> 3, nb_hi = (G - (x + 4) + 7) >> 3;
    wv = ((L >> 2) ? nb_lo * 4 : 0) + ((int)blockIdx.x >> 3) * 4 + (get_tid() >> 6);
    nwv = (nb_lo + nb_hi) * 4;
}
DI void peer_u_compute(const uint4 (&buf)[8], const uint4& hA_in, const uint4& hB_in, int init, int c, int& keep) {
    unsigned h0 = hA_in.x, h1 = hA_in.y, h2 = hA_in.z, h3 = hA_in.w, h4 = hB_in.x, h5 = hB_in.y, h6 = hB_in.z, h7 = hB_in.w;
    asm volatile("" : "+v"(h0), "+v"(h1), "+v"(h2), "+v"(h3), "+v"(h4), "+v"(h5), "+v"(h6), "+v"(h7), "+v"(keep), "+v"(init));
    const unsigned ML = 0x0F0F0F0Fu, MH = 0xF0F0F0F0u;
#pragma unroll
    for (int j = 0; j < 8; ++j) {
        int accL, accH;
        asm("v_dot4_i32_i8 %0, %1, %2, 0" : "=v"(accL) : "v"(buf[j].x & ML), "v"(h0));
        asm("v_dot4_i32_i8 %0, %1, %2, %3" : "=v"(accH) : "v"(buf[j].x & MH), "v"(h1), "v"(init));
        accL = __builtin_amdgcn_sdot4((int)(buf[j].y & ML), (int)h2, accL, false);
        accH = __builtin_amdgcn_sdot4((int)(buf[j].y & MH), (int)h3, accH, false);
        accL = __builtin_amdgcn_sdot4((int)(buf[j].z & ML), (int)h4, accL, false);
        accH = __builtin_amdgcn_sdot4((int)(buf[j].z & MH), (int)h5, accH, false);
        accL = __builtin_amdgcn_sdot4((int)(buf[j].w & ML), (int)h6, accL, false);
        accH = __builtin_amdgcn_sdot4((int)(buf[j].w & MH), (int)h7, accH, false);
        int acc = accL * 16 + accH;
        acc += __builtin_amdgcn_mov_dpp(acc, 0xB1, 0xF, 0xF, true);
        acc += __builtin_amdgcn_mov_dpp(acc, 0x4E, 0xF, 0xF, true);
        acc += __builtin_amdgcn_mov_dpp(acc, 0x141, 0xF, 0xF, true);
        if (c == j) keep = acc;
    }
    asm volatile("" : "+v"(keep));
}
DI int peer_u_init(const uint4& hA, const uint4& hB) {
    int sl_ = __builtin_amdgcn_sdot4((int)hA.x, 0x01010101, 0, false);
    int sh_ = __builtin_amdgcn_sdot4((int)hA.y, 0x01010101, 0, false);
    sl_ = __builtin_amdgcn_sdot4((int)hA.z, 0x01010101, sl_, false);
    sh_ = __builtin_amdgcn_sdot4((int)hA.w, 0x01010101, sh_, false);
    sl_ = __builtin_amdgcn_sdot4((int)hB.x, 0x01010101, sl_, false);
    sh_ = __builtin_amdgcn_sdot4((int)hB.y, 0x01010101, sh_, false);
    sl_ = __builtin_amdgcn_sdot4((int)hB.z, 0x01010101, sl_, false);
    sh_ = __builtin_amdgcn_sdot4((int)hB.w, 0x01010101, sh_, false);
    return 8 * sh_ - 120 * sl_;
}
DI void phase_peer_u(const Params& p, char* ws, int layer) {
    (void)p; (void)layer;
    const unsigned char* H8 = (const unsigned char*)(ws + OFF_R5 + 16ull * MiB);
    const unsigned* LIST = (const unsigned*)(ws + OFF_R5);
    const unsigned char* U4 = (const unsigned char*)(ws + OFF_R4);
    int* PART = (int*)(ws + OFF_R3);
    const int lane = get_tid() & 63;
    const int sl = lane >> 3, c = lane & 7;
    int x, wv, nwv;
    slice_assign4(x, wv, nwv);
    const unsigned coloff = (unsigned)x * (16384u * 128u) + (unsigned)c * 16u;
    const int n = (T_TOK - wv + nwv - 1) / nwv;
    if (n <= 0) return;
    const unsigned short* EID = (const unsigned short*)LIST;
    uint4 E0[2], E1[2], LE0[2], LE1[2], hA0, hB0, hA1, hB1, lhA0, lhB0, lhA1, lhB1, b0[8], b1[8], b2[8], b3[8];
    int in0, in1;
#define UTOK(I) ((unsigned)wv + __umul24((unsigned)(I), (unsigned)nwv))
#define U_LOAD_E(E, I) { const size_t t_ = UTOK(I); E[0] = nt_load_u4(EID + t_ * 128 + sl * 16); E[1] = nt_load_u4(EID + t_ * 128 + sl * 16 + 8); }
#define U_LOAD_H(HA, HB, I) { const size_t t_ = UTOK(I); HA = nt_load_u4(H8 + t_ * 1024 + x * 256 + c * 32); HB = nt_load_u4(H8 + t_ * 1024 + x * 256 + c * 32 + 16); }
#define U_STORE(I, K0, K1) { int* dst_ = PART + ((size_t)x * T_TOK + UTOK(I)) * 128 + sl * 16 + c; __builtin_nontemporal_store(K0, dst_); __builtin_nontemporal_store(K1, dst_ + 8); }
#define U_ROT(E, HA, HB, INI, LE, LHA, LHB)                                                                    \
    {                                                                                                           \
        asm volatile("" : "+v"(LE[0].x), "+v"(LE[0].y), "+v"(LE[0].z), "+v"(LE[0].w), "+v"(LE[1].x), "+v"(LE[1].y), "+v"(LE[1].z), "+v"(LE[1].w)); \
        asm volatile("" : "+v"(LHA.x), "+v"(LHA.y), "+v"(LHA.z), "+v"(LHA.w), "+v"(LHB.x), "+v"(LHB.y), "+v"(LHB.z), "+v"(LHB.w)); \
        E[0] = LE[0]; E[1] = LE[1]; HA = LHA; HB = LHB; INI = peer_u_init(LHA, LHB);                            \
    }
#define UCL(I) ((I) < n ? (I) : n - 1)
    U_LOAD_E(E0, 0)
    U_LOAD_E(E1, UCL(1))
    peer_issue(U4, E0, 0, coloff, b0);
    peer_issue(U4, E0, 1, coloff, b1);
    peer_issue(U4, E1, 0, coloff, b2);
    peer_issue(U4, E1, 1, coloff, b3);
    U_LOAD_E(LE0, UCL(2)) U_LOAD_H(lhA0, lhB0, 0)
    U_LOAD_E(LE1, UCL(3)) U_LOAD_H(lhA1, lhB1, UCL(1))
    U_ROT(E0, hA0, hB0, in0, LE0, lhA0, lhB0)
    U_ROT(E1, hA1, hB1, in1, LE1, lhA1, lhB1)
#pragma unroll 1
    for (int i = 0; i < n; i += 2) {
        U_LOAD_E(LE0, UCL(i + 4)) U_LOAD_H(lhA0, lhB0, UCL(i + 2))
        U_LOAD_E(LE1, UCL(i + 5)) U_LOAD_H(lhA1, lhB1, UCL(i + 3))
        {
            int k0 = 0, k1 = 0;
            peer_u_compute(b0, hA0, hB0, in0, c, k0);
            peer_issue(U4, E0, 0, coloff, b0);
            peer_u_compute(b1, hA0, hB0, in0, c, k1);
            peer_issue(U4, E0, 1, coloff, b1);
            U_STORE(i, k0, k1)
        }
        {
            int k0 = 0, k1 = 0;
            peer_u_compute(b2, hA1, hB1, in1, c, k0);
            peer_issue(U4, E1, 0, coloff, b2);
            peer_u_compute(b3, hA1, hB1, in1, c, k1);
            peer_issue(U4, E1, 1, coloff, b3);
            U_STORE(UCL(i + 1), k0, k1)
        }
        U_ROT(E0, hA0, hB0, in0, LE0, lhA0, lhB0)
        U_ROT(E1, hA1, hB1, in1, LE1, lhA1, lhB1)
    }
#undef UTOK
}

DI void phase_peer_act(const Params& p, char* ws, int layer) {
    (void)p;
    const unsigned short* EID = (const unsigned short*)(ws + OFF_R5);
    const unsigned short* GW = EID + (size_t)T_TOK * 128;
    const int* PART = (const int*)(ws + OFF_R3);
    unsigned short* ACT8 = (unsigned short*)(ws + OFF_R2);
    float* AS = (float*)(ws + OFF_AS);
    const float2* SC = (const float2*)(ws + OFF_SC) + (size_t)layer * 16384;
    const float* HS = (const float*)(ws + OFF_HS);
    const int tid = get_tid(), lane = tid & 63, wave = tid >> 6;
    for (int tb = (blockIdx.x * 4 + wave) * 4; tb < T_TOK; tb += gridDim.x * 16) {
        uint2 q[4][4];
        unsigned ew[4], gw[4];
        float hs[4];
#pragma unroll
        for (int u = 0; u < 4; ++u) {
            const size_t i = (size_t)(tb + u) * 128 + 2 * lane;
#pragma unroll
            for (int x = 0; x < 4; ++x) q[u][x] = *(const uint2*)(PART + (size_t)x * T_TOK * 128 + i);
            ew[u] = *(const unsigned*)(EID + i); gw[u] = *(const unsigned*)(GW + i);
            hs[u] = HS[tb + u];
        }
        float2 c0[4], c1[4];
#pragma unroll
        for (int u = 0; u < 4; ++u) { c0[u] = SC[ew[u] & 0xffffu]; c1[u] = SC[ew[u] >> 16]; }
        float a0[4], a1[4], am[4];
#pragma unroll
        for (int u = 0; u < 4; ++u) {
            const int s0 = (int)q[u][0].x + (int)q[u][1].x + (int)q[u][2].x + (int)q[u][3].x;
            const int s1 = (int)q[u][0].y + (int)q[u][1].y + (int)q[u][2].y + (int)q[u][3].y;
            a0[u] = gelu_tanh((float)s0 * c0[u].x * hs[u]) * __uint_as_float(gw[u] << 16) * c0[u].y;
            a1[u] = gelu_tanh((float)s1 * c1[u].x * hs[u]) * __uint_as_float(gw[u] & 0xffff0000u) * c1[u].y;
            am[u] = fmaxf(fabsf(a0[u]), fabsf(a1[u]));
        }
#pragma unroll
        for (int u = 0; u < 4; ++u) am[u] = wave_max_dpp(am[u]);
#pragma unroll
        for (int u = 0; u < 4; ++u) {
            const float qs = (am[u] > 0.f) ? 127.f / am[u] : 0.f;
            const int q0 = __float2int_rn(a0[u] * qs), q1 = __float2int_rn(a1[u] * qs);
            ACT8[(size_t)(tb + u) * 64 + lane] = (unsigned short)(((unsigned)q0 & 0xffu) | (((unsigned)q1 & 0xffu) << 8));
            if (lane == 0) AS[tb + u] = am[u] * (1.f / 127.f);
        }
    }
}

template <bool FIRST>
DI void peer_v_compute(const uint4 (&buf)[4], unsigned a4, int (&out)[32]) {
    unsigned sA = 0x05010400u, sB = 0x07030602u, sC = 0x05040100u, sD = 0x07060302u;
    asm volatile("" : "+s"(sA), "+s"(sB), "+s"(sC), "+s"(sD));
    const unsigned M = 0x0F0F0F0Fu;
    const unsigned r0[4] = {buf[0].x, buf[0].y, buf[0].z, buf[0].w}, r1[4] = {buf[1].x, buf[1].y, buf[1].z, buf[1].w};
    const unsigned r2[4] = {buf[2].x, buf[2].y, buf[2].z, buf[2].w}, r3[4] = {buf[3].x, buf[3].y, buf[3].z, buf[3].w};
#pragma unroll
    for (int d = 0; d < 4; ++d) {
        const unsigned t01l = __builtin_amdgcn_perm(r1[d], r0[d], sA);
        const unsigned t01h = __builtin_amdgcn_perm(r1[d], r0[d], sB);
        const unsigned t23l = __builtin_amdgcn_perm(r3[d], r2[d], sA);
        const unsigned t23h = __builtin_amdgcn_perm(r3[d], r2[d], sB);
        unsigned T[4];
        T[0] = __builtin_amdgcn_perm(t23l, t01l, sC);
        T[1] = __builtin_amdgcn_perm(t23l, t01l, sD);
        T[2] = __builtin_amdgcn_perm(t23h, t01h, sC);
        T[3] = __builtin_amdgcn_perm(t23h, t01h, sD);
#pragma unroll
        for (int m = 0; m < 4; ++m) {
            if (FIRST) {
                asm("v_dot4_i32_i8 %0, %1, %2, 0" : "=v"(out[8 * d + 2 * m]) : "v"(T[m] & M), "v"(a4));
                asm("v_dot4_i32_i8 %0, %1, %2, 0" : "=v"(out[8 * d + 2 * m + 1]) : "v"(T[m]), "v"(a4));
            } else {
                out[8 * d + 2 * m]     = __builtin_amdgcn_sdot4((int)(T[m] & M), (int)a4, out[8 * d + 2 * m], false);
                out[8 * d + 2 * m + 1] = __builtin_amdgcn_sdot4((int)T[m], (int)a4, out[8 * d + 2 * m + 1], false);
            }
        }
    }
    asm volatile("" : "+v"(out[0]), "+v"(out[1]), "+v"(out[2]), "+v"(out[3]), "+v"(out[4]), "+v"(out[5]), "+v"(out[6]), "+v"(out[7]));
    asm volatile("" : "+v"(out[8]), "+v"(out[9]), "+v"(out[10]), "+v"(out[11]), "+v"(out[12]), "+v"(out[13]), "+v"(out[14]), "+v"(out[15]));
    asm volatile("" : "+v"(out[16]), "+v"(out[17]), "+v"(out[18]), "+v"(out[19]), "+v"(out[20]), "+v"(out[21]), "+v"(out[22]), "+v"(out[23]));
    asm volatile("" : "+v"(out[24]), "+v"(out[25]), "+v"(out[26]), "+v"(out[27]), "+v"(out[28]), "+v"(out[29]), "+v"(out[30]), "+v"(out[31]));
}
DI void peer_issue4(const unsigned char* tab, unsigned w_lo, unsigned w_hi, unsigned coloff, uint4 (&buf)[4]) {
    asm volatile("" : "+v"(w_lo), "+v"(w_hi));
    buf[0] = *(const uint4*)(tab + ((w_lo & 0xffffu) * 128u + coloff));
    buf[1] = *(const uint4*)(tab + ((w_lo >> 16) * 128u + coloff));
    buf[2] = *(const uint4*)(tab + ((w_hi & 0xffffu) * 128u + coloff));
    buf[3] = *(const uint4*)(tab + ((w_hi >> 16) * 128u + coloff));
}
DI void peer_v_reduce(const int (&out)[32], int sl, int (&r4)[4]) {
    int r16[16];
#pragma unroll
    for (int k = 0; k < 16; ++k) {
        const auto q = __builtin_amdgcn_permlane32_swap((unsigned)out[k], (unsigned)out[16 + k], false, false);
        r16[k] = (int)q[0] + (int)q[1];
    }
    int r8[8];
#pragma unroll
    for (int k = 0; k < 8; ++k) {
        const auto q = __builtin_amdgcn_permlane16_swap((unsigned)r16[k], (unsigned)r16[8 + k], false, false);
        r8[k] = (int)q[0] + (int)q[1];
    }
#pragma unroll
    for (int k = 0; k < 4; ++k) {
        const int mine = (sl & 1) ? r8[4 + k] : r8[k];
        const int send = (sl & 1) ? r8[k] : r8[4 + k];
        r4[k] = mine + __builtin_amdgcn_mov_dpp(send, 0x128, 0xF, 0xF, true);
    }
}
DI int peer_v_asum(const uint4& a) {
    int sa = __builtin_amdgcn_sdot4((int)a.x, 0x01010101, 0, false);
    sa = __builtin_amdgcn_sdot4((int)a.y, 0x01010101, sa, false);
    sa = __builtin_amdgcn_sdot4((int)a.z, 0x01010101, sa, false);
    sa = __builtin_amdgcn_sdot4((int)a.w, 0x01010101, sa, false);
    { const auto q = __builtin_amdgcn_permlane32_swap((unsigned)sa, (unsigned)sa, false, false); sa = (int)q[0] + (int)q[1]; }
    { const auto q = __builtin_amdgcn_permlane16_swap((unsigned)sa, (unsigned)sa, false, false); sa = (int)q[0] + (int)q[1]; }
    sa += __builtin_amdgcn_mov_dpp(sa, 0x128, 0xF, 0xF, true);
    return sa;
}
template <bool DRY>
DI void phase_peer_v(const Params& p, char* ws, char* smem, int layer) {
    bf16_t* X = (bf16_t*)(ws + OFF_R1);
    bf16_t* XO = DRY ? (bf16_t*)p.out : X;
    const int lj = layer * 2 + 1;
    const float* mods = (const float*)(ws + OFF_MODS) + (size_t)lj * 16 * 3072;
    const unsigned short* EID = (const unsigned short*)(ws + OFF_R5);
    const unsigned char* ACT8 = (const unsigned char*)(ws + OFF_R2);
    const float* AS = (const float*)(ws + OFF_AS);
    const unsigned char* V4 = (const unsigned char*)(ws + OFF_R4) + TAB_V_OFF;
    const int tid = get_tid(), lane = tid & 63;
    const int sl = lane >> 3, c = lane & 7;
    int x, wv, nwv;
    slice_assign4(x, wv, nwv);
    float* Gs = (float*)smem;
    for (int i = tid; i < 16 * 256; i += 256) Gs[i] = mods[(size_t)(i >> 8) * 3072 + 2048 + x * 256 + (i & 255)];
    __syncthreads();
    const unsigned coloff = (unsigned)x * (16384u * 128u) + (unsigned)c * 16u;
    const int n = (T_TOK - wv + nwv - 1) / nwv;
    if (n <= 0) return;
    const int colL = c * 32 + 4 * sl;
    const int col0 = x * 256 + colL;
    uint4 E0[2], E1[2], LE0[2], LE1[2], q0[4], q1[4], q2[4], q3[4];
    uint4 a0, a1, la0, la1;
    float as0, as1, las0, las1;
    u32x2_t x0, x1, lx0, lx1;
#define VTOK(I) ((unsigned)wv + __umul24((unsigned)(I), (unsigned)nwv))
#define VCL(I) ((I) < n ? (I) : n - 1)
#define V_LOAD_E(E, I) { const size_t t_ = VTOK(I); E[0] = nt_load_u4(EID + t_ * 128 + sl * 16); E[1] = nt_load_u4(EID + t_ * 128 + sl * 16 + 8); }
#define V_LOAD_M(A, ASV, XV, I)                                                                                \
    {                                                                                                           \
        const size_t t_ = VTOK(I);                                                                              \
        A = nt_load_u4(ACT8 + t_ * 128 + sl * 16);                                                              \
        ASV = AS[t_];                                                                                           \
        XV = __builtin_nontemporal_load((const u32x2_t*)(X + t_ * 1024 + col0));                                \
    }
#define V_ROT(E, A, ASV, XV, LE, LA, LASV, LXV)                                                                \
    {                                                                                                           \
        asm volatile("" : "+v"(LE[0].x), "+v"(LE[0].y), "+v"(LE[0].z), "+v"(LE[0].w), "+v"(LE[1].x), "+v"(LE[1].y), "+v"(LE[1].z), "+v"(LE[1].w)); \
        asm volatile("" : "+v"(LA.x), "+v"(LA.y), "+v"(LA.z), "+v"(LA.w), "+v"(LASV), "+v"(LXV.x), "+v"(LXV.y)); \
        E[0] = LE[0]; E[1] = LE[1]; A = LA; ASV = LASV; XV = LXV;                                               \
    }
#define V_SECTION(I, E, A, ASV, XV, DOIT)                                                                      \
    {                                                                                                           \
        int out[32];                                                                                            \
        peer_v_compute<true>(q0, A.x, out);                                                                     \
        peer_issue4(V4, E[0].x, E[0].y, coloff, q0);                                                            \
        peer_v_compute<false>(q1, A.y, out);                                                                           \
        peer_issue4(V4, E[0].z, E[0].w, coloff, q1);                                                            \
        peer_v_compute<false>(q2, A.z, out);                                                                           \
        peer_issue4(V4, E[1].x, E[1].y, coloff, q2);                                                            \
        peer_v_compute<false>(q3, A.w, out);                                                                           \
        peer_issue4(V4, E[1].z, E[1].w, coloff, q3);                                                            \
        int r4_[4];                                                                                             \
        peer_v_reduce(out, sl, r4_);                                                                            \
        const float sa_ = (float)peer_v_asum(A);                                                                \
        const unsigned tt_ = VTOK(I);                                                                           \
        const float4 g_ = *(const float4*)(Gs + (tt_ >> 11) * 256 + colL);                                     \
        const float xa_ = __uint_as_float(XV.x << 16), xb_ = __uint_as_float(XV.x & 0xffff0000u);               \
        const float xc_ = __uint_as_float(XV.y << 16), xd_ = __uint_as_float(XV.y & 0xffff0000u);               \
          \
        const float oa_ = xa_ + g_.x * (((float)r4_[0] - 7.5f * sa_) * (ASV));                                  \
        const float ob_ = xb_ + g_.y * (((float)(r4_[1] - r4_[0]) * 0.0625f + 0.5f * sa_) * (ASV));             \
        const float oc_ = xc_ + g_.z * (((float)r4_[2] - 7.5f * sa_) * (ASV));                                  \
        const float od_ = xd_ + g_.w * (((float)(r4_[3] - r4_[2]) * 0.0625f + 0.5f * sa_) * (ASV));             \
        u32x2_t ov__; ov__.x = pack2bf(oa_, ob_); ov__.y = pack2bf(oc_, od_);                                   \
        bf16_t* op__ = (DOIT) ? XO + (size_t)tt_ * 1024 + col0 : (bf16_t*)(ws + OFF_PTRS + 4096) + lane * 4;   \
        __builtin_nontemporal_store(ov__, (u32x2_t*)op__);                                                      \
    }
    V_LOAD_E(E0, 0)
    peer_issue4(V4, E0[0].x, E0[0].y, coloff, q0);
    peer_issue4(V4, E0[0].z, E0[0].w, coloff, q1);
    peer_issue4(V4, E0[1].x, E0[1].y, coloff, q2);
    peer_issue4(V4, E0[1].z, E0[1].w, coloff, q3);
    V_LOAD_E(LE0, VCL(1))
    V_LOAD_M(la0, las0, lx0, 0)
    V_LOAD_E(LE1, VCL(2))
    V_LOAD_M(la1, las1, lx1, VCL(1))
    V_ROT(E0, a0, as0, x0, LE0, la0, las0, lx0)
    V_ROT(E1, a1, as1, x1, LE1, la1, las1, lx1)
#pragma unroll 1
    for (int i = 0; i < n; i += 2) {
        V_LOAD_E(LE0, VCL(i + 3))
        V_LOAD_M(la0, las0, lx0, VCL(i + 2))
        V_LOAD_E(LE1, VCL(i + 4))
        V_LOAD_M(la1, las1, lx1, VCL(i + 3))
        V_SECTION(i, E0, a0, as0, x0, true)
        V_SECTION(VCL(i + 1), E1, a1, as1, x1, (i + 1 < n))
        V_ROT(E0, a0, as0, x0, LE0, la0, las0, lx0)
        V_ROT(E1, a1, as1, x1, LE1, la1, las1, lx1)
    }
#undef VTOK
}

#define AK_LD 72
#define AV_LD 200
#define AP_LD 40
DI void phase_attn(const Params& p, char* ws, char* smem) {
    const bf16_t* Qa = (const bf16_t*)(ws + OFF_R3);
    const bf16_t* Ka = Qa + (size_t)T_TOK * 1024;
    const bf16_t* VT2 = Ka + (size_t)T_TOK * 128;
    bf16_t* ATT = (bf16_t*)(ws + OFF_R4);
    const int tid = get_tid(), lane = tid & 63, wave = tid >> 6;
    const int r = lane & 31, h = lane >> 5;
    bf16_t* Ks = (bf16_t*)smem;
    bf16_t* Vs = (bf16_t*)(smem + 27648);
    float* btab = (float*)(smem + 27648 + 25600);
    bf16_t* Pw = (bf16_t*)(smem + 27648 + 25600 + 4096) + (size_t)wave * 32 * AP_LD;
    for (int unit = blockIdx.x; unit < 1024; unit += gridDim.x) {
        const int kvh = unit & 1, qh = (unit >> 1) & 31, b = unit >> 6;
        const size_t tb = (size_t)b * SEQ;
        const int Qh = qh * 64;
        const int Kb = Qh - 128;
        __syncthreads();
#pragma unroll
        for (int q = 0; q < 6; ++q) {
            const int c = tid + 256 * q, row = c >> 3, ch = c & 7;
            int kpos = Kb + row; if (kpos < 0) kpos = 0;
            *(uint4*)(Ks + row * AK_LD + ch * 8) = *(const uint4*)(Ka + (tb + kpos) * 128 + kvh * 64 + ch * 8);
        }
#pragma unroll
        for (int q = 0; q < 6; ++q) {
            const int c = tid + 256 * q, row = c / 24, ch = c % 24;
            int kpos = Kb + ch * 8; if (kpos < 0) kpos = 0;
            *(uint4*)(Vs + row * AV_LD + ch * 8) = *(const uint4*)(VT2 + ((size_t)b * 128 + kvh * 64 + row) * 2048 + kpos);
        }
        for (int i = tid; i < 8 * 128; i += 256) {
            const int g = i >> 7, n = i & 127;
            int bk = n;
            if (n >= 16) {
                const float lr = logf((float)n / 16.f) / 2.0794415416798357f;
                bk = 16 + (int)(lr * 16.f);
                if (bk > 31) bk = 31;
            }
            btab[i] = p.rel_bias[bk * 16 + kvh * 8 + g];
        }
        __syncthreads();
        for (int sub = 0; sub < 4; ++sub) {
            const int g = wave * 2 + (sub >> 1), qs = sub & 1;
            const int hq = kvh * 8 + g;
            const int Q0 = Qh + qs * 32;
            const int K0 = Q0 - 128;
            const int kl0 = K0 - Kb;
            f32x16 sacc[5];
            zero_acc<5>(sacc);
            {
                const bf16_t* Bq = Qa + (tb + Q0 + r) * 1024 + hq * 64 + h * 8;
                bf16x8 bq[4];
#pragma unroll
                for (int ks = 0; ks < 4; ++ks) bq[ks] = *(const bf16x8*)(Bq + ks * 16);
#pragma unroll
                for (int ks = 0; ks < 4; ++ks)
#pragma unroll
                    for (int kt = 0; kt < 5; ++kt)
                        sacc[kt] = MFMA32(*(const bf16x8*)(Ks + (kl0 + kt * 32 + r) * AK_LD + ks * 16 + h * 8), bq[ks], sacc[kt]);
            }
            const float sink = p.sinks[hq];
            float mx = sink;
#pragma unroll
            for (int kt = 0; kt < 5; ++kt)
#pragma unroll
                for (int i = 0; i < 16; ++i) {
                    const int kpos = K0 + kt * 32 + crow(i, h);
                    const int dist = Q0 + r - kpos;
                    float lg = NEG_INF_F;
                    if (dist >= 0 && dist < 128 && kpos >= 0) lg = sacc[kt][i] * 0.125f + btab[g * 128 + dist];
                    sacc[kt][i] = lg;
                    mx = fmaxf(mx, lg);
                }
            mx = fmaxf(mx, __shfl_xor(mx, 32));
            float sum = 0.f;
#pragma unroll
            for (int kt = 0; kt < 5; ++kt)
#pragma unroll
                for (int i = 0; i < 16; ++i) {
                    const float e = (sacc[kt][i] > -1e29f) ? __expf(sacc[kt][i] - mx) : 0.f;
                    sacc[kt][i] = e;
                    sum += e;
                }
            sum += __shfl_xor(sum, 32);
            sum += __expf(sink - mx);
            const float inv = 1.f / sum;
            f32x16 oacc[2];
            zero_acc<2>(oacc);
#pragma unroll
            for (int kt = 0; kt < 5; ++kt) {
#pragma unroll
                for (int q4 = 0; q4 < 4; ++q4) {
                    uint2 o;
                    o.x = pack2bf(sacc[kt][q4 * 4 + 0] * inv, sacc[kt][q4 * 4 + 1] * inv);
                    o.y = pack2bf(sacc[kt][q4 * 4 + 2] * inv, sacc[kt][q4 * 4 + 3] * inv);
                    *(uint2*)(Pw + r * AP_LD + q4 * 8 + h * 4) = o;
                }
#pragma unroll
                for (int ks = 0; ks < 2; ++ks) {
                    const bf16x8 ap = *(const bf16x8*)(Pw + r * AP_LD + ks * 16 + h * 8);
#pragma unroll
                    for (int nt = 0; nt < 2; ++nt)
                        oacc[nt] = MFMA32(ap, *(const bf16x8*)(Vs + (nt * 32 + r) * AV_LD + kl0 + kt * 32 + ks * 16 + h * 8), oacc[nt]);
                }
            }
            {
                bf16_t* ab = ATT + (tb + Q0 + 4 * h) * 1024 + hq * 64 + r;
#pragma unroll
                for (int i4 = 0; i4 < 4; ++i4) {
                    bf16_t* a2 = ab + (size_t)i4 * 8 * 1024;
                    LAUNDER(a2);
#pragma unroll
                    for (int ii = 0; ii < 4; ++ii)
#pragma unroll
                        for (int nt = 0; nt < 2; ++nt) a2[ii * 1024 + nt * 32] = f2bf(oacc[nt][i4 * 4 + ii]);
                }
            }
        }
    }
    __syncthreads();
}

DI void phase_final(const Params& p, const bf16_t* __restrict__ X) {
    const int tid = get_tid(), lane = tid & 63, wave = tid >> 6;
    for (int t = blockIdx.x * 4 + wave; t < T_TOK; t += gridDim.x * 4) {
        float xv[16];
        float ss = 0.f;
#pragma unroll
        for (int i = 0; i < 4; ++i) {
            const uint2 q = *(const uint2*)(X + (size_t)t * 1024 + i * 256 + lane * 4);
            const float4 v = make_float4(__uint_as_float(q.x << 16), __uint_as_float(q.x & 0xffff0000u), __uint_as_float(q.y << 16), __uint_as_float(q.y & 0xffff0000u));
            xv[i * 4 + 0] = v.x; xv[i * 4 + 1] = v.y; xv[i * 4 + 2] = v.z; xv[i * 4 + 3] = v.w;
            ss += v.x * v.x + v.y * v.y + v.z * v.z + v.w * v.w;
        }
        ss = wave_sum_dpp(ss);
        const float rinv = rsqrtf(ss * (1.f / 1024.f) + 1e-6f);
#pragma unroll
        for (int i = 0; i < 4; ++i) {
            const int col = i * 256 + lane * 4;
            const float4 g4 = *(const float4*)(p.final_g + col);
            float4 o;
            o.x = xv[i * 4 + 0] * rinv * g4.x; o.y = xv[i * 4 + 1] * rinv * g4.y;
            o.z = xv[i * 4 + 2] * rinv * g4.z; o.w = xv[i * 4 + 3] * rinv * g4.w;
            *(float4*)(p.out + (size_t)t * 1024 + col) = o;
        }
    }
}

#define NPHASES 25
template <int PH>
DI void run_phase(const Params& pk, char* smem) {
    typedef __attribute__((address_space(1))) char gchar_t;
    gchar_t* wsg = (gchar_t*)pk.ws;
    asm volatile("" : "+s"(wsg));
    char* ws = (char*)wsg;
    Params p;
    if (PH == 0) {
        p = pk;
        if (threadIdx.x < 29) {
            const void* v = pk.x;
            switch (threadIdx.x) {
                case 0: v = pk.x; break; case 1: v = pk.c; break; case 2: v = pk.ada_w; break; case 3: v = pk.ada_b; break;
                case 4: v = pk.norm_g; break; case 5: v = pk.w_in; break; case 6: v = pk.b_if; break; case 7: v = pk.conv_w; break;
                case 8: v = pk.conv_b; break; case 9: v = pk.w_q; break; case 10: v = pk.w_k; break; case 11: v = pk.head_g; break;
                case 12: v = pk.skip; break; case 13: v = pk.pool_w; break; case 14: v = pk.pool_scale; break; case 15: v = pk.w_out; break;
                case 16: v = pk.w_qkv; break; case 17: v = pk.b_qkv; break; case 18: v = pk.sinks; break; case 19: v = pk.w_o; break;
                case 20: v = pk.b_o; break; case 21: v = pk.rel_bias; break; case 22: v = pk.peer_wq; break; case 23: v = pk.peer_keys; break;
                case 24: v = pk.peer_u; break; case 25: v = pk.peer_v; break; case 26: v = pk.final_g; break; case 27: v = pk.out; break;
                default: v = pk.ws; break;
            }
            ((const void**)(ws + OFF_PTRS))[threadIdx.x] = v;
        }
    } else {
        const float* const* tab = (const float* const*)(ws + OFF_PTRS);
        p.x = tab[0]; p.c = tab[1]; p.ada_w = tab[2]; p.ada_b = tab[3]; p.norm_g = tab[4]; p.w_in = tab[5]; p.b_if = tab[6]; p.conv_w = tab[7];
        p.conv_b = tab[8]; p.w_q = tab[9]; p.w_k = tab[10]; p.head_g = tab[11]; p.skip = tab[12]; p.pool_w = tab[13]; p.pool_scale = tab[14];
        p.w_out = tab[15]; p.w_qkv = tab[16]; p.b_qkv = tab[17]; p.sinks = tab[18]; p.w_o = tab[19]; p.b_o = tab[20]; p.rel_bias = tab[21];
        p.peer_wq = tab[22]; p.peer_keys = tab[23]; p.peer_u = tab[24]; p.peer_v = tab[25]; p.final_g = tab[26]; p.out = (float*)tab[27]; p.ws = ws;
    }
    bf16_t* X = (bf16_t*)(ws + OFF_R1);
    const float* mods = (const float*)(ws + OFF_MODS);
    if (PH == 0) { phase_pre_mods(p, ws, smem); phase_pre_scoremat(p, ws, smem); }
    else if (PH == 1) { phase_adanorm<true, true, false>(p, ws, p.x, 0, smem); phase_pre_weights(p, ws, smem); }
    else if (PH == 2) { GemmArgs ga{}; ga.A = (const bf16_t*)(ws + OFF_R5 + 16ull * MiB); ga.Bt = (const bf16_t*)(ws + OFF_WINT); ga.N = 2048; ga.hs = (const float*)(ws + OFF_HS); ga.wsc = (const float*)(ws + OFF_WSC); phase_gemm<GM_INPROJ, true>(p, ws, ga, smem); }
    else if (PH == 3) {   }
    else if (PH == 4) phase_m1b(p, ws, smem);
    else if (PH == 5) phase_m2(p, ws);
    else if (PH == 6) phase_m3(p, ws, smem);
    else if (PH == 7) {
        GemmArgs ga{}; ga.A = (const bf16_t*)(ws + OFF_R4); ga.Bt = (const bf16_t*)(ws + OFF_WOUTT); ga.N = 1024;
        ga.xin = p.x; ga.xout = X; ga.gate = mods + (size_t)0 * 16 * 3072 + 2048; ga.bias = nullptr;
        phase_gemm<GM_RESID, false>(p, ws, ga, smem);
    }
    else if (PH == 8) phase_adanorm<false, true, true>(p, ws, X, 1, smem);
    else if (PH == 9) { GemmArgs ga{}; ga.A = (const bf16_t*)(ws + OFF_R5 + 16ull * MiB); ga.Bt = (const bf16_t*)(ws + OFF_WPQT); ga.N = 2048; ga.out = (bf16_t*)(ws + OFF_R3); ga.hs = (const float*)(ws + OFF_HS); ga.wsc = (const float*)(ws + OFF_WSC) + 3328; phase_gemm<GM_PLAIN, true>(p, ws, ga, smem); }
    else if (PH == 10) phase_topk(p, ws, 0, smem);
    else if (PH == 11) phase_peer_u(p, ws, 0);
    else if (PH == 12) phase_peer_act(p, ws, 0);
    else if (PH == 13) phase_peer_v<false>(p, ws, smem, 0);
    else if (PH == 14) phase_adanorm<false, true, true>(p, ws, X, 2, smem);
    else if (PH == 15) { GemmArgs ga{}; ga.A = (const bf16_t*)(ws + OFF_R5 + 16ull * MiB); ga.Bt = (const bf16_t*)(ws + OFF_WQKVT); ga.N = 1280; ga.hs = (const float*)(ws + OFF_HS); ga.wsc = (const float*)(ws + OFF_WSC) + 2048; phase_gemm<GM_QKV, true>(p, ws, ga, smem); }
    else if (PH == 16) phase_attn(p, ws, smem);
    else if (PH == 17 || PH == 27) {
        GemmArgs ga{}; ga.A = (const bf16_t*)(ws + OFF_R4); ga.Bt = (const bf16_t*)(ws + OFF_WOT); ga.N = 1024;
        ga.xin = X; ga.xout = (PH == 27) ? (bf16_t*)p.out : X; ga.gate = mods + (size_t)2 * 16 * 3072 + 2048; ga.bias = p.b_o;
        phase_gemm<GM_RESID_BF, false>(p, ws, ga, smem);
    }
    else if (PH == 18) phase_adanorm<false, true, true>(p, ws, X, 3, smem);
    else if (PH == 19) { GemmArgs ga{}; ga.A = (const bf16_t*)(ws + OFF_R5 + 16ull * MiB); ga.Bt = (const bf16_t*)(ws + OFF_WPQT + (size_t)2048 * 1024); ga.N = 2048; ga.out = (bf16_t*)(ws + OFF_R3); ga.hs = (const float*)(ws + OFF_HS); ga.wsc = (const float*)(ws + OFF_WSC) + 5376; phase_gemm<GM_PLAIN, true>(p, ws, ga, smem); }
    else if (PH == 20) phase_topk(p, ws, 1, smem);
    else if (PH == 21) phase_peer_u(p, ws, 1);
    else if (PH == 22) phase_peer_act(p, ws, 1);
    else if (PH == 23) phase_peer_v<false>(p, ws, smem, 1);
    else if (PH == 24) phase_final(p, X);
    else if (PH == 25) phase_peer_v<true>(p, ws, smem, 0);
    else if (PH == 26) phase_peer_v<true>(p, ws, smem, 1);
}

extern __shared__ __attribute__((aligned(16))) char dyn_smem[];

#define LDS_GEMM 73728
#define LDS_BYTES (LDS_GEMM + 16)

#if !ONE_LAUNCH
template <int PH>
__global__ void __launch_bounds__(256, 2) k_phase(Params p) { run_phase<PH>(p, dyn_smem); }

template <int PH>
static void launch_phase(const Params& p, int grid, hipStream_t stream) {
    (void)hipFuncSetAttribute((const void*)k_phase<PH>, hipFuncAttributeMaxDynamicSharedMemorySize, LDS_BYTES);
    hipLaunchKernelGGL(k_phase<PH>, dim3(grid), dim3(256), LDS_BYTES, stream, p);
}
template <int PH>
static void launch_all(const Params& p, int grid, hipStream_t stream) {
    launch_phase<PH>(p, grid, stream);
    if constexpr (PH + 1 < NPHASES) launch_all<PH + 1>(p, grid, stream);
}
#else
template <int PH>
DI void fused_from(const Params& p, volatile LAS unsigned* st) {
    run_phase<PH>(p, dyn_smem);
    if ((PROBE_MASK >> PH) & 1u) run_phase<(PH == 13) ? 25 : (PH == 23) ? 26 : (PH == 17) ? 27 : PH>(p, dyn_smem);
    if constexpr (PH + 1 < NPHASES && PH != 3) {
        { XcdBarrier bar_; bar_.bar = (unsigned*)(p.ws + OFF_BAR); bar_.x = xb_xcc_id(); bar_.st = st; xcd_barrier(bar_); }
        fused_from<PH + 1>(p, st);
    } else if constexpr (PH + 1 < NPHASES) {
        fused_from<PH + 1>(p, st);
    }
}
__global__ void __launch_bounds__(256, 2) k_fused(Params p) {
    volatile LAS unsigned* st = (volatile LAS unsigned*)(dyn_smem + LDS_GEMM);
    if (threadIdx.x == 0) { st[0] = 0u; st[1] = 0u; st[2] = 0u; st[3] = 0u; }
    __syncthreads();
    (void)xcd_barrier_post((unsigned*)(p.ws + OFF_BAR), st);
    fused_from<0>(p, st);
}
#endif

extern "C" void kernel_launch(void* const* d_in, const int* in_sizes, int n_in, void* d_out, int out_size, void* d_ws, size_t ws_size,
                              hipStream_t stream) {
    (void)in_sizes; (void)n_in; (void)out_size;
    Params p{};
    const float** pp = (const float**)&p;
    for (int i = 0; i < 27; ++i) pp[i] = (const float*)d_in[i];
    p.out = (float*)d_out;
    p.ws = (char*)d_ws;
    if (ws_size < WS_NEEDED) fprintf(stderr, "workspace too small: %zu < %llu\n", ws_size, (unsigned long long)WS_NEEDED);
#if !ONE_LAUNCH
    const int grid = 512;
    launch_all<0>(p, grid, stream);
#else
    static int grid = 0;
    if (!grid) {
        int dev = 0, cus = 0, per_cu = 0;
        (void)hipGetDevice(&dev);
        (void)hipDeviceGetAttribute(&cus, hipDeviceAttributeMultiprocessorCount, dev);
        (void)hipFuncSetAttribute((const void*)k_fused, hipFuncAttributeMaxDynamicSharedMemorySize, LDS_BYTES);
        (void)hipOccupancyMaxActiveBlocksPerMultiprocessor(&per_cu, (const void*)k_fused, 256, LDS_BYTES);
        if (per_cu < 1) per_cu = 1;
        if (cus < 1) cus = 256;
        grid = cus * (per_cu < 2 ? per_cu : 2);
    }
    (void)hipMemsetAsync(d_ws, 0, XCD_BAR_WORDS * sizeof(unsigned), stream);
    hipLaunchKernelGGL(k_fused, dim3(grid), dim3(256), LDS_BYTES, stream, p);
#endif
}
```

```cpp
#include <hip/hip_runtime.h>
#include <stdint.h>
#include <stdio.h>

#ifndef ONE_LAUNCH
#define ONE_LAUNCH 1
#endif
#ifndef PROBE_MASK
#define PROBE_MASK 0u
#endif

#define DI __device__ __forceinline__
typedef unsigned short bf16_t;
typedef __attribute__((ext_vector_type(8))) short bf16x8;
typedef __attribute__((ext_vector_type(16))) float f32x16;
typedef unsigned u32x4_t __attribute__((ext_vector_type(4)));
typedef float f32x4n_t __attribute__((ext_vector_type(4)));
typedef unsigned u32x2_t __attribute__((ext_vector_type(2)));
#define MFMA32(a, b, c) __builtin_amdgcn_mfma_f32_32x32x16_bf16((a), (b), (c), 0, 0, 0)

#define T_TOK 32768
#define SEQ 2048
#define NBATCH 16
#define DM 1024
#define NEG_INF_F (-1e30f)

#define MiB (1024ull * 1024ull)
#define OFF_BAR     0ull
#define OFF_MODS    (16ull * 1024)
#define OFF_WGT     (1ull * MiB)
#define OFF_IPRE    (OFF_WGT + 64ull * 1024)
#define OFF_LOGF    (OFF_IPRE + 512ull * 1024)
#define OFF_G       (OFF_LOGF + 512ull * 1024)
#define OFF_BV      (OFF_G + 512ull * 1024)
#define OFF_USC     (OFF_BV + 512ull * 1024)
#define OFF_ND      (OFF_USC + 64ull * 1024)
#define OFF_NIN     (OFF_ND + 512ull * 1024)
#define OFF_HS      (27ull * MiB)
#define OFF_PTRS    (27ull * MiB + 512ull * 1024)
#define OFF_AS      (27ull * MiB + 256ull * 1024)
#define OFF_WSC     (27ull * MiB + 768ull * 1024)
#define OFF_SC      (26ull * MiB)
#define OFF_WINT    (4ull * MiB)
#define OFF_WOUTT   (8ull * MiB)
#define OFF_WQKVT   (10ull * MiB)
#define OFF_WOT     (13ull * MiB)
#define OFF_WPQT    (15ull * MiB)
#define OFF_WQT     (23ull * MiB)
#define OFF_WKT     (OFF_WQT + 128ull * 1024)
#define OFF_PWT     (OFF_WKT + 128ull * 1024)
#define OFF_KEYS    (24ull * MiB)
#define OFF_R1      (32ull * MiB)
#define OFF_M       (OFF_R1 + 64ull * MiB)
#define OFF_R2      (160ull * MiB)
#define OFF_R3      (224ull * MiB)
#define OFF_R4      (352ull * MiB)
#define OFF_R5      (416ull * MiB)
#define WS_NEEDED   (512ull * MiB)

struct Params {
    const float *x, *c, *ada_w, *ada_b, *norm_g, *w_in, *b_if, *conv_w, *conv_b, *w_q, *w_k, *head_g, *skip, *pool_w,
        *pool_scale, *w_out, *w_qkv, *b_qkv, *sinks, *w_o, *b_o, *rel_bias, *peer_wq, *peer_keys, *peer_u, *peer_v, *final_g;
    float* out;
    char* ws;
};


#define XB_TMO      128
#define XB_XCNT(j)  (256  + 64 * (j))
#define XB_XSUB(j)  (1280 + 64 * (j))
#define XB_XGEN(j)  (2304 + 64 * (j))
#define XB_TOP      3328
#define XB_TOPGEN   3392
#define XCD_BAR_WORDS 3456
#define XB_SPIN_CAP (1u << 18)
#define LAS __attribute__((address_space(3)))

__device__ __forceinline__ unsigned xb_ld(unsigned* p)              { return __hip_atomic_load(p, __ATOMIC_RELAXED, __HIP_MEMORY_SCOPE_AGENT); }
__device__ __forceinline__ unsigned xb_add(unsigned* p, unsigned v) { return __hip_atomic_fetch_add(p, v, __ATOMIC_RELAXED, __HIP_MEMORY_SCOPE_AGENT); }
__device__ __forceinline__ unsigned xb_xcc_id() { return (unsigned)__builtin_amdgcn_s_getreg((3 << 11) | 20) & 0xFu; }
#define XB_SPIN(cond, bar) do { unsigned _sp = 0; while (cond) { __builtin_amdgcn_s_sleep(1); \
    if ((++_sp & 255u) == 0u) { if (xb_ld(&(bar)[XB_TMO])) break; if (_sp > XB_SPIN_CAP) { atomicAdd(&(bar)[XB_TMO], 1u); break; } } } } while (0)

struct XcdBarrier {
    unsigned* bar; unsigned x;
    volatile LAS unsigned* st;
};

__device__ __forceinline__ XcdBarrier xcd_barrier_post(unsigned* bar, volatile LAS unsigned* st) {
    XcdBarrier b; b.bar = bar; b.x = xb_xcc_id(); b.st = st;
    if (threadIdx.x == 0) (void)xb_add(&bar[XB_XCNT(b.x)], 1u);
    return b;
}
__device__ __forceinline__ void xcd_barrier_complete(unsigned* bar, unsigned x, unsigned& nloc, unsigned& nx) {
    const unsigned G = gridDim.x * gridDim.y * gridDim.z;
    unsigned sum, cnt, mine, sp = 0u;
    for (;;) {
        sum = 0u; cnt = 0u; mine = 0u;
#pragma unroll
        for (unsigned j = 0; j < 16; ++j) { const unsigned c = xb_ld(&bar[XB_XCNT(j)]); sum += c; cnt += (c > 0u) ? 1u : 0u; mine = (j == x) ? c : mine; }
        if (sum == G) break;
        __builtin_amdgcn_s_sleep(1);
        if ((++sp & 255u) == 0u) { if (xb_ld(&bar[XB_TMO])) break; if (sp > XB_SPIN_CAP) { atomicAdd(&bar[XB_TMO], 1u); break; } }
    }
    nloc = mine > 0u ? mine : 1u; nx = cnt > 0u ? cnt : 1u;
}
__device__ __forceinline__ void xcd_barrier(const XcdBarrier& b) {
    asm volatile("s_waitcnt vmcnt(0)" ::: "memory");
    __syncthreads();
    if (threadIdx.x == 0) {
        unsigned* bar = b.bar;
        __builtin_amdgcn_s_waitcnt(0);
        unsigned nloc = b.st[0], nx = b.st[1];
        if (nloc == 0u) { xcd_barrier_complete(bar, b.x, nloc, nx); b.st[0] = nloc; b.st[1] = nx; }
        const unsigned old = xb_add(&bar[XB_XSUB(b.x)], 1u);
        const unsigned gen = old / nloc;
        if (old + 1u == (gen + 1u) * nloc) {
            __builtin_amdgcn_fence(__ATOMIC_RELEASE, "agent");
            asm volatile("s_waitcnt vmcnt(0)" ::: "memory");
            const unsigned og = xb_add(&bar[XB_TOP], 1u);
            const unsigned tg = og / nx;
            if (og + 1u == (tg + 1u) * nx) xb_add(&bar[XB_TOPGEN], 1u);
            else XB_SPIN(xb_ld(&bar[XB_TOPGEN]) == tg, bar);
            __builtin_amdgcn_fence(__ATOMIC_ACQUIRE, "agent");
            xb_add(&bar[XB_XGEN(b.x)], 1u);
            asm volatile("s_waitcnt vmcnt(0)" ::: "memory");
        } else {
            XB_SPIN(xb_ld(&bar[XB_XGEN(b.x)]) == gen, bar);
            __builtin_amdgcn_fence(__ATOMIC_ACQUIRE, "agent");
            asm volatile("s_waitcnt vmcnt(0)" ::: "memory");
        }
    }
    __syncthreads();
}

typedef __bf16 bf16x2_t __attribute__((ext_vector_type(2)));
typedef float f32x2v_t __attribute__((ext_vector_type(2)));
DI unsigned pack2bf(float a, float b) { const f32x2v_t v = {a, b}; return __builtin_bit_cast(unsigned, __builtin_convertvector(v, bf16x2_t)); }
DI bf16_t f2bf(float x) { return __builtin_bit_cast(bf16_t, (__bf16)x); }
DI float bf2f(bf16_t h) { return __uint_as_float(((unsigned)h) << 16); }
DI int get_tid() { int t = (int)threadIdx.x; asm volatile("" : "+v"(t)); return t; }
DI int crow(int i, int h) { return (i & 3) + 8 * (i >> 2) + 4 * h; }
DI float wave_sum(float v) {
#pragma unroll
    for (int o = 32; o >= 1; o >>= 1) v += __shfl_xor(v, o);
    return v;
}
DI float wave_sum_dpp(float v) {
    v += __int_as_float(__builtin_amdgcn_mov_dpp(__float_as_int(v), 0xB1, 0xF, 0xF, true));
    v += __int_as_float(__builtin_amdgcn_mov_dpp(__float_as_int(v), 0x4E, 0xF, 0xF, true));
    v += __int_as_float(__builtin_amdgcn_mov_dpp(__float_as_int(v), 0x141, 0xF, 0xF, true));
    v += __int_as_float(__builtin_amdgcn_mov_dpp(__float_as_int(v), 0x140, 0xF, 0xF, true));
    return __int_as_float(__builtin_amdgcn_readlane(__float_as_int(v), 0)) + __int_as_float(__builtin_amdgcn_readlane(__float_as_int(v), 16)) +
           __int_as_float(__builtin_amdgcn_readlane(__float_as_int(v), 32)) + __int_as_float(__builtin_amdgcn_readlane(__float_as_int(v), 48));
}
DI float wave_max_dpp(float v) {
    v = fmaxf(v, __int_as_float(__builtin_amdgcn_mov_dpp(__float_as_int(v), 0xB1, 0xF, 0xF, true)));
    v = fmaxf(v, __int_as_float(__builtin_amdgcn_mov_dpp(__float_as_int(v), 0x4E, 0xF, 0xF, true)));
    v = fmaxf(v, __int_as_float(__builtin_amdgcn_mov_dpp(__float_as_int(v), 0x141, 0xF, 0xF, true)));
    v = fmaxf(v, __int_as_float(__builtin_amdgcn_mov_dpp(__float_as_int(v), 0x140, 0xF, 0xF, true)));
    return fmaxf(fmaxf(__int_as_float(__builtin_amdgcn_readlane(__float_as_int(v), 0)), __int_as_float(__builtin_amdgcn_readlane(__float_as_int(v), 16))),
                 fmaxf(__int_as_float(__builtin_amdgcn_readlane(__float_as_int(v), 32)), __int_as_float(__builtin_amdgcn_readlane(__float_as_int(v), 48))));
}
DI float half_sum(float v) {
    v += __int_as_float(__builtin_amdgcn_mov_dpp(__float_as_int(v), 0xB1, 0xF, 0xF, true));
    v += __int_as_float(__builtin_amdgcn_mov_dpp(__float_as_int(v), 0x4E, 0xF, 0xF, true));
    v += __int_as_float(__builtin_amdgcn_mov_dpp(__float_as_int(v), 0x141, 0xF, 0xF, true));
    v += __int_as_float(__builtin_amdgcn_mov_dpp(__float_as_int(v), 0x140, 0xF, 0xF, true));
    const auto q = __builtin_amdgcn_permlane16_swap(__float_as_uint(v), __float_as_uint(v), false, false);
    return __uint_as_float(q[0]) + __uint_as_float(q[1]);
}
DI float half_max(float v) {
    v = fmaxf(v, __int_as_float(__builtin_amdgcn_mov_dpp(__float_as_int(v), 0xB1, 0xF, 0xF, true)));
    v = fmaxf(v, __int_as_float(__builtin_amdgcn_mov_dpp(__float_as_int(v), 0x4E, 0xF, 0xF, true)));
    v = fmaxf(v, __int_as_float(__builtin_amdgcn_mov_dpp(__float_as_int(v), 0x141, 0xF, 0xF, true)));
    v = fmaxf(v, __int_as_float(__builtin_amdgcn_mov_dpp(__float_as_int(v), 0x140, 0xF, 0xF, true)));
    const auto q = __builtin_amdgcn_permlane16_swap(__float_as_uint(v), __float_as_uint(v), false, false);
    return fmaxf(__uint_as_float(q[0]), __uint_as_float(q[1]));
}
DI unsigned half_umax(unsigned v) {
#pragma unroll
    for (int o = 16; o >= 1; o >>= 1) { unsigned t = (unsigned)__shfl_xor((int)v, o); v = v > t ? v : t; }
    return v;
}
DI float sigmoidf_(float x) { return __builtin_amdgcn_rcpf(1.f + __expf(-x)); }
DI float siluf_(float x) { return x * sigmoidf_(x); }
DI float gelu_tanh(float x) {
    const float k0 = 0.7978845608028654f, k1 = 0.044715f;
    float u = k0 * (x + k1 * x * x * x);
    float t = 1.f - 2.f * __builtin_amdgcn_rcpf(1.f + __expf(2.f * u));
    return 0.5f * x * (1.f + t);
}
DI float logsigmoidf_(float x) { return fminf(x, 0.f) - log1pf(__expf(-fabsf(x))); }

template <int N> DI void zero_acc(f32x16 (&acc)[N]) {
#pragma unroll
    for (int n = 0; n < N; ++n)
#pragma unroll
        for (int i = 0; i < 16; ++i) acc[n][i] = 0.f;
}

template <int NT, int KSTEPS, typename PA, typename PB>
DI void wave_mma(f32x16 (&acc)[NT], PA A, int lda, PB B, int ldb, int lane) {
    const int r = lane & 31, h = lane >> 5;
    bf16x8 a0, b0[NT], a1, b1[NT];
    a0 = *(const bf16x8*)(A + (size_t)r * lda + h * 8);
#pragma unroll
    for (int nt = 0; nt < NT; ++nt) b0[nt] = *(const bf16x8*)(B + (size_t)(nt * 32 + r) * ldb + h * 8);
#pragma unroll
    for (int ks = 0; ks < KSTEPS; ks += 2) {
        if (ks + 1 < KSTEPS) {
            a1 = *(const bf16x8*)(A + (size_t)r * lda + (ks + 1) * 16 + h * 8);
#pragma unroll
            for (int nt = 0; nt < NT; ++nt) b1[nt] = *(const bf16x8*)(B + (size_t)(nt * 32 + r) * ldb + (ks + 1) * 16 + h * 8);
        }
        asm volatile("" ::: "memory");
#pragma unroll
        for (int nt = 0; nt < NT; ++nt) acc[nt] = MFMA32(a0, b0[nt], acc[nt]);
        if (ks + 1 < KSTEPS) {
            if (ks + 2 < KSTEPS) {
                a0 = *(const bf16x8*)(A + (size_t)r * lda + (ks + 2) * 16 + h * 8);
#pragma unroll
                for (int nt = 0; nt < NT; ++nt) b0[nt] = *(const bf16x8*)(B + (size_t)(nt * 32 + r) * ldb + (ks + 2) * 16 + h * 8);
            }
            asm volatile("" ::: "memory");
#pragma unroll
            for (int nt = 0; nt < NT; ++nt) acc[nt] = MFMA32(a1, b1[nt], acc[nt]);
        }
    }
}

DI void phase_pre_mods(const Params& p, char* ws, char* smem) {
    float* cond = (float*)smem;
    float* mods = (float*)(ws + OFF_MODS);
    const int tid = get_tid();
    for (int unit = blockIdx.x; unit < 384; unit += gridDim.x) {
        const int lj = unit / 96, n0 = (unit % 96) * 32;
        __syncthreads();
#pragma unroll 1
        for (int i0 = 0; i0 < 16 * 1024; i0 += 16 * 256) {
            float t[16];
#pragma unroll
            for (int u = 0; u < 16; ++u) t[u] = p.c[i0 + u * 256 + tid];
#pragma unroll
            for (int u = 0; u < 16; ++u) cond[i0 + u * 256 + tid] = siluf_(t[u]);
        }
        __syncthreads();
        const int ksl = tid >> 5, col = tid & 31;
        const float* W = p.ada_w + (size_t)lj * 1024 * 3072 + n0 + col;
        float acc[16];
#pragma unroll
        for (int b = 0; b < 16; ++b) acc[b] = 0.f;
        for (int kk0 = 0; kk0 < 128; kk0 += 16) {
            float wv_[16];
#pragma unroll
            for (int q = 0; q < 16; ++q) wv_[q] = W[(size_t)(ksl * 128 + kk0 + q) * 3072];
#pragma unroll
            for (int q = 0; q < 16; ++q) {
                const int k = ksl * 128 + kk0 + q;
#pragma unroll
                for (int b = 0; b < 16; ++b) acc[b] += cond[b * 1024 + k] * wv_[q];
            }
        }
        __syncthreads();
        float* red = (float*)smem;
#pragma unroll
        for (int b = 0; b < 16; ++b) red[(ksl * 16 + b) * 32 + col] = acc[b];
        __syncthreads();
        for (int o = tid; o < 512; o += 256) {
            const int b = o >> 5, cc = o & 31;
            float s = 0.f;
#pragma unroll
            for (int q = 0; q < 8; ++q) s += red[(q * 16 + b) * 32 + cc];
            mods[((size_t)lj * 16 + b) * 3072 + n0 + cc] = s + p.ada_b[(size_t)lj * 3072 + n0 + cc];
        }
    }
    __syncthreads();
}

DI void transpose_job(const float* __restrict__ src, int ldsrc, int K, int N, bf16_t* __restrict__ dst, const float* nscale, float cscale,
                      int tile, float* tl) {
    const int tiles_n = N / 32;
    const int tk = tile / tiles_n, tn = tile % tiles_n;
    const int tid_ = get_tid();
    const int tx = tid_ & 31, ty = tid_ >> 5;
    __syncthreads();
#pragma unroll
    for (int q = 0; q < 4; ++q) {
        const int k = tk * 32 + ty + q * 8;
        tl[(ty + q * 8) * 33 + tx] = src[(size_t)k * ldsrc + tn * 32 + tx];
    }
    __syncthreads();
#pragma unroll
    for (int q = 0; q < 4; ++q) {
        const int n = tn * 32 + ty + q * 8;
        float v = tl[tx * 33 + ty + q * 8] * cscale;
        if (nscale) v *= nscale[n];
        dst[(size_t)n * K + tk * 32 + tx] = f2bf(v);
    }
}

DI void quant_job(const float* __restrict__ src, int ldsrc, unsigned char* __restrict__ dst, float* __restrict__ wsc, int n0, float* red) {
    const int tid = get_tid(), tx = tid & 31, ty = tid >> 5;
    const float* col = src + n0 + tx;
    float am = 0.f;
#pragma unroll 1
    for (int k0 = 0; k0 < 1024; k0 += 128) {
        float t[16];
#pragma unroll
        for (int u = 0; u < 16; ++u) t[u] = col[(size_t)(k0 + ty + 8 * u) * ldsrc];
#pragma unroll
        for (int u = 0; u < 16; ++u) am = fmaxf(am, fabsf(t[u]));
    }
    __syncthreads();
    red[ty * 32 + tx] = am;
    __syncthreads();
#pragma unroll
    for (int q = 0; q < 8; ++q) am = fmaxf(am, red[q * 32 + tx]);
    const float sc = (am > 0.f) ? 127.f / am : 0.f;
    if (ty == 0) wsc[n0 + tx] = am * (1.f / 127.f);
    unsigned char* drow = dst + (size_t)(n0 + tx) * 1024 + ty * 128;
    for (int k4 = 0; k4 < 32; k4 += 4) {
        unsigned w[4];
#pragma unroll
        for (int q = 0; q < 4; ++q) {
            const int k = ty * 128 + (k4 + q) * 4;
            const int q0 = __float2int_rn(col[(size_t)(k + 0) * ldsrc] * sc), q1 = __float2int_rn(col[(size_t)(k + 1) * ldsrc] * sc);
            const int q2 = __float2int_rn(col[(size_t)(k + 2) * ldsrc] * sc), q3 = __float2int_rn(col[(size_t)(k + 3) * ldsrc] * sc);
            w[q] = ((unsigned)q0 & 0xffu) | (((unsigned)q1 & 0xffu) << 8) | (((unsigned)q2 & 0xffu) << 16) | (((unsigned)q3 & 0xffu) << 24);
        }
        *(uint4*)(drow + k4 * 4) = make_uint4(w[0], w[1], w[2], w[3]);
    }
}
DI void phase_pre_weights(const Params& p, char* ws, char* smem) {
    {
        float* red = (float*)smem;
        float* wsc = (float*)(ws + OFF_WSC);
        for (int j = blockIdx.x; j < 64 + 40 + 64 + 64 + 32 + 32; j += gridDim.x) {
            if (j < 64) quant_job(p.w_in, 2056, (unsigned char*)(ws + OFF_WINT), wsc, j * 32, red);
            else if (j < 104) quant_job(p.w_qkv, 1280, (unsigned char*)(ws + OFF_WQKVT), wsc + 2048, (j - 64) * 32, red);
            else if (j < 168) quant_job((const float*)(ws + OFF_M), 2048, (unsigned char*)(ws + OFF_WPQT), wsc + 3328, (j - 104) * 32, red);
            else if (j < 232) quant_job((const float*)(ws + OFF_M) + (size_t)1024 * 2048, 2048, (unsigned char*)(ws + OFF_WPQT) + (size_t)2048 * 1024, wsc + 5376, (j - 168) * 32, red);
            else if (j < 264) quant_job(p.w_out, 1024, (unsigned char*)(ws + OFF_WOUTT), wsc + 7424, (j - 232) * 32, red);
            else quant_job(p.w_o, 1024, (unsigned char*)(ws + OFF_WOT), wsc + 8448, (j - 264) * 32, red);
        }
        __syncthreads();
    }
    float* tl = (float*)smem;
    const int J1 = 0;
    const int J3 = 0;
    const int J6 = 4 * 16;
    const int J7 = 4 * 16;
    const int J8 = 4 * 16;
    const int total = J1 + J3 + J6 + J7 + J8;
    for (int j = blockIdx.x; j < total; j += gridDim.x) {
        int t = j;
        if (t < J1) { transpose_job(p.w_out, 1024, 1024, 1024, (bf16_t*)(ws + OFF_WOUTT), nullptr, 1.f, t, tl); continue; }
        t -= J1;
        if (t < J3) { transpose_job(p.w_o, 1024, 1024, 1024, (bf16_t*)(ws + OFF_WOT), nullptr, 1.f, t, tl); continue; }
        t -= J3;
        if (t < J6) { const int hh = t / 16; transpose_job(p.w_q + (size_t)hh * 16384, 128, 128, 128, (bf16_t*)(ws + OFF_WQT) + (size_t)hh * 16384, nullptr, 1.f, t % 16, tl); continue; }
        t -= J6;
        if (t < J7) { const int hh = t / 16; transpose_job(p.w_k + (size_t)hh * 16384, 128, 128, 128, (bf16_t*)(ws + OFF_WKT) + (size_t)hh * 16384, nullptr, 0.08838834764831845f, t % 16, tl); continue; }
        t -= J7;
        { const int g = t / 16; transpose_job(p.pool_w + (size_t)g * 16384, 128, 128, 128, (bf16_t*)(ws + OFF_PWT) + (size_t)g * 16384, p.pool_scale + g * 128, 1.f, t % 16, tl); }
    }
    const size_t gtid = (size_t)blockIdx.x * 256 + get_tid(), gsz = (size_t)gridDim.x * 256;
    bf16_t* keys = (bf16_t*)(ws + OFF_KEYS);
    for (size_t i = gtid; i < (size_t)2 * 8 * 2 * 128 * 128; i += gsz) keys[i] = f2bf(p.peer_keys[i]);
    __syncthreads();
}

DI unsigned cvt_pk_bf16(float a, float b) { return pack2bf(a, b); }
DI float dot2_bf16(unsigned a, unsigned b, float c) { return __builtin_amdgcn_fdot2_f32_bf16(__builtin_bit_cast(bf16x2_t, a), __builtin_bit_cast(bf16x2_t, b), c, false); }
template <bool GATES, bool WITH_H8, bool XBF>
DI void phase_adanorm(const Params& p, char* ws, const void* __restrict__ Xv, int lj, char* smem) {
    unsigned char* H8 = (unsigned char*)(ws + OFF_R5 + 16ull * MiB);
    const float* mods = (const float*)(ws + OFF_MODS) + (size_t)lj * 16 * 3072;
    const float* ng = p.norm_g + (size_t)lj * 1024;
    const int tid = get_tid(), lane = tid & 63, wave = tid >> 6;
    (void)smem;
    unsigned wgp[8][8];
    if (GATES) {
#pragma unroll
        for (int q = 0; q < 8; ++q) {
            const int col = (q >> 1) * 256 + lane * 4 + (q & 1) * 2;
            const float4 a0 = *(const float4*)(p.w_in + (size_t)col * 2056 + 2048), a1 = *(const float4*)(p.w_in + (size_t)col * 2056 + 2052);
            const float4 b0 = *(const float4*)(p.w_in + (size_t)(col + 1) * 2056 + 2048), b1 = *(const float4*)(p.w_in + (size_t)(col + 1) * 2056 + 2052);
            wgp[0][q] = cvt_pk_bf16(a0.x, b0.x); wgp[1][q] = cvt_pk_bf16(a0.y, b0.y); wgp[2][q] = cvt_pk_bf16(a0.z, b0.z); wgp[3][q] = cvt_pk_bf16(a0.w, b0.w);
            wgp[4][q] = cvt_pk_bf16(a1.x, b1.x); wgp[5][q] = cvt_pk_bf16(a1.y, b1.y); wgp[6][q] = cvt_pk_bf16(a1.z, b1.z); wgp[7][q] = cvt_pk_bf16(a1.w, b1.w);
        }
    }
    for (int unit = blockIdx.x; unit < T_TOK / 64; unit += gridDim.x) {
        const int row0 = unit * 64, b = row0 >> 11;
        float am[16], sh[16];
#pragma unroll
        for (int i = 0; i < 4; ++i) {
            const int col = i * 256 + lane * 4;
            const float4 g4 = *(const float4*)(ng + col);
            const float4 s4 = *(const float4*)(mods + (size_t)b * 3072 + col);
            const float4 c4 = *(const float4*)(mods + (size_t)b * 3072 + 1024 + col);
            am[i * 4 + 0] = g4.x * (1.f + c4.x); am[i * 4 + 1] = g4.y * (1.f + c4.y);
            am[i * 4 + 2] = g4.z * (1.f + c4.z); am[i * 4 + 3] = g4.w * (1.f + c4.w);
            sh[i * 4 + 0] = s4.x; sh[i * 4 + 1] = s4.y; sh[i * 4 + 2] = s4.z; sh[i * 4 + 3] = s4.w;
        }
        constexpr int ROWS = GATES ? 2 : 4;
#pragma unroll 1
        for (int rb = 0; rb < 16; rb += ROWS) {
          float4 rawx[ROWS][4];
#pragma unroll
          for (int u = 0; u < ROWS; ++u) {
            const int t_ = row0 + wave + 4 * (rb + u);
#pragma unroll
            for (int i = 0; i < 4; ++i) {
                if (XBF) {
                    const uint2 q = *(const uint2*)((const bf16_t*)Xv + (size_t)t_ * 1024 + i * 256 + lane * 4);
                    rawx[u][i].x = __uint_as_float(q.x); rawx[u][i].y = __uint_as_float(q.y);
                } else rawx[u][i] = *(const float4*)((const float*)Xv + (size_t)t_ * 1024 + i * 256 + lane * 4);
            }
          }
#pragma unroll
          for (int u = 0; u < ROWS; ++u) {
            const int t = row0 + wave + 4 * (rb + u);
            float xv[16];
            float ss = 0.f;
#pragma unroll
            for (int i = 0; i < 4; ++i) {
                float4 v;
                if (XBF) {
                    const unsigned qx = __float_as_uint(rawx[u][i].x), qy = __float_as_uint(rawx[u][i].y);
                    v = make_float4(__uint_as_float(qx << 16), __uint_as_float(qx & 0xffff0000u), __uint_as_float(qy << 16), __uint_as_float(qy & 0xffff0000u));
                } else v = rawx[u][i];
                xv[i * 4 + 0] = v.x; xv[i * 4 + 1] = v.y; xv[i * 4 + 2] = v.z; xv[i * 4 + 3] = v.w;
                ss += v.x * v.x + v.y * v.y + v.z * v.z + v.w * v.w;
            }
            ss = wave_sum_dpp(ss);
            const float rinv = rsqrtf(ss * (1.f / 1024.f) + 1e-6f);
            float hv[16];
#pragma unroll
            for (int i = 0; i < 16; ++i) hv[i] = xv[i] * rinv * am[i] + sh[i];
            if (WITH_H8) {
                float amx = 0.f;
#pragma unroll
                for (int i = 0; i < 16; ++i) amx = fmaxf(amx, fabsf(hv[i]));
                amx = wave_max_dpp(amx);
                const float qs = (amx > 0.f) ? 127.f / amx : 0.f;
#pragma unroll
                for (int i = 0; i < 4; ++i) {
                    const int q0 = __float2int_rn(hv[i * 4 + 0] * qs), q1 = __float2int_rn(hv[i * 4 + 1] * qs);
                    const int q2 = __float2int_rn(hv[i * 4 + 2] * qs), q3 = __float2int_rn(hv[i * 4 + 3] * qs);
                    const unsigned w8 = ((unsigned)q0 & 0xffu) | (((unsigned)q1 & 0xffu) << 8) | (((unsigned)q2 & 0xffu) << 16) | (((unsigned)q3 & 0xffu) << 24);
                    *(unsigned*)(H8 + (size_t)t * 1024 + i * 256 + lane * 4) = w8;
                }
                if (lane == 0) ((float*)(ws + OFF_HS))[t] = amx * (1.f / 127.f);
            }
            if (GATES) {
                unsigned hp[8];
#pragma unroll
                for (int q = 0; q < 8; ++q) hp[q] = cvt_pk_bf16(hv[2 * q], hv[2 * q + 1]);
                float sg[8];
#pragma unroll
                for (int j = 0; j < 8; ++j) {
                    float a = 0.f;
#pragma unroll
                    for (int q = 0; q < 8; ++q) a = dot2_bf16(hp[q], wgp[j][q], a);
                    sg[j] = a;
                }
#define DPPF(v, ctrl) __int_as_float(__builtin_amdgcn_mov_dpp(__float_as_int(v), (ctrl), 0xF, 0xF, true))
                const bool b0 = lane & 1, b1 = lane & 2, b2 = lane & 4;
                float t4[4], u2[2];
#pragma unroll
                for (int k = 0; k < 4; ++k) { const float keep = b2 ? sg[4 + k] : sg[k], send = b2 ? sg[k] : sg[4 + k]; t4[k] = keep + DPPF(send, 0x141); }
#pragma unroll
                for (int k = 0; k < 2; ++k) { const float keep = b0 ? t4[2 + k] : t4[k], send = b0 ? t4[k] : t4[2 + k]; u2[k] = keep + DPPF(send, 0xB1); }
                float gsum;
                { const float keep = b1 ? u2[1] : u2[0], send = b1 ? u2[0] : u2[1]; gsum = keep + DPPF(send, 0x4E); }
                gsum += DPPF(gsum, 0x128);
                { const auto q = __builtin_amdgcn_permlane16_swap(__float_as_uint(gsum), __float_as_uint(gsum), false, false); gsum = __uint_as_float(q[0]) + __uint_as_float(q[1]); }
                { const auto q = __builtin_amdgcn_permlane32_swap(__float_as_uint(gsum), __float_as_uint(gsum), false, false); gsum = __uint_as_float(q[0]) + __uint_as_float(q[1]); }
#undef DPPF
                if (lane < 8) {
                    const int j = ((lane >> 2) & 1) * 4 + (lane & 1) * 2 + ((lane >> 1) & 1);
                    float* ipre = (float*)(ws + OFF_IPRE);
                    float* logf_ = (float*)(ws + OFF_LOGF);
                    if (j < 4) ipre[(size_t)t * 4 + j] = gsum + p.b_if[j];
                    else logf_[(size_t)t * 4 + (j - 4)] = logsigmoidf_(gsum + p.b_if[j]);
                }
            }
          }
        }
    }
}

#define GM_INPROJ 0
#define GM_RESID  1
#define GM_RESID_BF 4
#define GM_PLAIN  2
#define GM_QKV    3
#define LDS_ROW 72

struct GemmArgs {
    const bf16_t* A; const bf16_t* Bt; int N;
    const float* hs; const float* wsc;
    const void* xin; bf16_t* xout; const float* gate; const float* bias;
    bf16_t* out;
};

#define CT_LD 132
typedef __attribute__((address_space(1))) char gch_t;
#define LAUNDER(ptr) do { gch_t* _g = (gch_t*)(ptr); asm volatile("" : "+v"(_g)); (ptr) = (decltype(ptr))(char*)_g; } while (0)
template <int MODE>
DI void gemm_epilogue(const Params& p, char* ws, const GemmArgs& ga, const f32x16 (&acc)[2][2], int m0, int n0, int tn, int wm, int wn, int tid, bool swapped, float* Ct, const f32x4n_t (&xi)[16]) {
    const int lane = tid & 63, r = lane & 31, h = lane >> 5;
    {
#pragma unroll
        for (int mt = 0; mt < 2; ++mt)
#pragma unroll
            for (int nt = 0; nt < 2; ++nt) {
                float* dst = Ct + (wm * 64 + mt * 32 + 4 * h) * CT_LD + wn * 64 + nt * 32 + r;
#pragma unroll
                for (int i = 0; i < 16; ++i) dst[((i & 3) + 8 * (i >> 2)) * CT_LD] = acc[mt][nt][i];
            }
    }
    __syncthreads();
    if (MODE == GM_RESID || MODE == GM_RESID_BF) {
        const int c4 = tid & 31, rr = tid >> 5;
        const int n = n0 + c4 * 4, b = m0 >> 11;
        const float4 g4 = *(const float4*)(ga.gate + (size_t)b * 3072 + n);
        float4 b4 = make_float4(0.f, 0.f, 0.f, 0.f);
        if (ga.bias) b4 = *(const float4*)(ga.bias + n);
        float4 cs4 = make_float4(1.f, 1.f, 1.f, 1.f);
        if (ga.hs) cs4 = *(const float4*)(ga.wsc + n);
        bf16_t* op = ga.xout + (size_t)(m0 + rr) * 1024 + n;
        float rs16[16];
#pragma unroll
        for (int it = 0; it < 16; ++it) rs16[it] = 1.f;
        if (ga.hs) {
#pragma unroll
            for (int it = 0; it < 16; ++it) rs16[it] = ga.hs[m0 + rr + 8 * it];
        }
#pragma unroll
        for (int it = 0; it < 16; ++it) {
            float4 c = *(const float4*)(Ct + (rr + 8 * it) * CT_LD + c4 * 4);
            if (ga.hs) { const float rs_ = rs16[it]; c.x *= rs_ * cs4.x; c.y *= rs_ * cs4.y; c.z *= rs_ * cs4.z; c.w *= rs_ * cs4.w; }
            float4 xq;
            if (MODE == GM_RESID_BF) {
                const unsigned q0 = __float_as_uint(xi[it].x), q1 = __float_as_uint(xi[it].y);
                xq = make_float4(__uint_as_float(q0 << 16), __uint_as_float(q0 & 0xffff0000u), __uint_as_float(q1 << 16), __uint_as_float(q1 & 0xffff0000u));
            } else xq = make_float4(xi[it].x, xi[it].y, xi[it].z, xi[it].w);
            float4 o;
            o.x = xq.x + g4.x * (c.x + b4.x); o.y = xq.y + g4.y * (c.y + b4.y);
            o.z = xq.z + g4.z * (c.z + b4.z); o.w = xq.w + g4.w * (c.w + b4.w);
            { u32x2_t ov_; ov_.x = pack2bf(o.x, o.y); ov_.y = pack2bf(o.z, o.w); __builtin_nontemporal_store(ov_, (u32x2_t*)(op + (size_t)it * 8 * 1024)); }
        }
    } else {
        const int c8 = tid & 15, rr = tid >> 4;
        bf16_t* dst; size_t rstride; const float* colbias = nullptr; const float* rowbias = nullptr;
        bf16_t* R3 = (bf16_t*)(ws + OFF_R3);
        const int b = m0 >> 11, s0 = m0 & 2047;
        if (MODE == GM_PLAIN) { dst = ga.out + (size_t)m0 * ga.N + n0; rstride = (size_t)ga.N; }
        else if (MODE == GM_INPROJ) {
            if (!swapped) { dst = R3 + (size_t)(tn >> 2) * T_TOK * 512 + (size_t)m0 * 512 + (n0 & 511); rstride = 512; }
            else { dst = R3 + (size_t)T_TOK * 512 + ((size_t)b * 512 + (n0 - 512)) * 2048 + s0; rstride = 2048; }
        } else {
            if (tn < 8) { dst = R3 + (size_t)m0 * 1024 + n0; rstride = 1024; colbias = p.b_qkv + n0; }
            else if (tn == 8) { dst = R3 + (size_t)T_TOK * 1024 + (size_t)m0 * 128; rstride = 128; colbias = p.b_qkv + n0; }
            else { dst = R3 + (size_t)T_TOK * 1024 + (size_t)T_TOK * 128 + (size_t)b * 128 * 2048 + s0; rstride = 2048; rowbias = p.b_qkv + 1152; }
        }
        const float* rowscale = nullptr; const float* colscale = nullptr;
        if (ga.hs) { rowscale = swapped ? ga.wsc + n0 : ga.hs + m0; colscale = swapped ? ga.hs + m0 : ga.wsc + n0; }
        float csv[8];
#pragma unroll
        for (int e = 0; e < 8; ++e) csv[e] = 1.f;
        if (colscale) {
            const float4 a = *(const float4*)(colscale + c8 * 8), bq = *(const float4*)(colscale + c8 * 8 + 4);
            csv[0] = a.x; csv[1] = a.y; csv[2] = a.z; csv[3] = a.w; csv[4] = bq.x; csv[5] = bq.y; csv[6] = bq.z; csv[7] = bq.w;
        }
        float cbv[8];
#pragma unroll
        for (int e = 0; e < 8; ++e) cbv[e] = 0.f;
        if (colbias) {
            const float4 a = *(const float4*)(colbias + c8 * 8), bq = *(const float4*)(colbias + c8 * 8 + 4);
            cbv[0] = a.x; cbv[1] = a.y; cbv[2] = a.z; cbv[3] = a.w; cbv[4] = bq.x; cbv[5] = bq.y; cbv[6] = bq.z; cbv[7] = bq.w;
        }
        bf16_t* dp = dst + (size_t)rr * rstride + c8 * 8;
        float rsv8[8], rbv8[8];
#pragma unroll
        for (int it = 0; it < 8; ++it) { rsv8[it] = 1.f; rbv8[it] = 0.f; }
        if (rowscale) {
#pragma unroll
            for (int it = 0; it < 8; ++it) rsv8[it] = rowscale[rr + 16 * it];
        }
        if (rowbias) {
#pragma unroll
            for (int it = 0; it < 8; ++it) rbv8[it] = rowbias[rr + 16 * it];
        }
#pragma unroll
        for (int it = 0; it < 8; ++it) {
            const int row = rr + 16 * it;
            const float4 c0 = *(const float4*)(Ct + row * CT_LD + c8 * 8);
            const float4 c1 = *(const float4*)(Ct + row * CT_LD + c8 * 8 + 4);
            const float rbv = rbv8[it], rsv = rsv8[it];
            uint4 o;
            o.x = pack2bf(c0.x * rsv * csv[0] + cbv[0] + rbv, c0.y * rsv * csv[1] + cbv[1] + rbv);
            o.y = pack2bf(c0.z * rsv * csv[2] + cbv[2] + rbv, c0.w * rsv * csv[3] + cbv[3] + rbv);
            o.z = pack2bf(c1.x * rsv * csv[4] + cbv[4] + rbv, c1.y * rsv * csv[5] + cbv[5] + rbv);
            o.w = pack2bf(c1.z * rsv * csv[6] + cbv[6] + rbv, c1.w * rsv * csv[7] + cbv[7] + rbv);
            { u32x4_t ov_; ov_.x = o.x; ov_.y = o.y; ov_.z = o.z; ov_.w = o.w; __builtin_nontemporal_store(ov_, (u32x4_t*)(dp + (size_t)it * 16 * rstride)); }
        }
    }
    __syncthreads();
}

#define GT_BYTES 16384
typedef int i32x4_t __attribute__((ext_vector_type(4)));
typedef int i32x16_t __attribute__((ext_vector_type(16)));
template <int MODE, bool I8>
DI void phase_gemm(const Params& p, char* ws, const GemmArgs& ga, char* smem) {
    const int tid = get_tid(), lane = tid & 63, wave = tid >> 6;
    const int wm = wave >> 1, wn = wave & 1;
    const int r = lane & 31, h = lane >> 5;
    const int NT = ga.N / 128;
    const int total = 256 * NT;
    constexpr int RS = I8 ? 1024 : 2048;
    constexpr int NK = I8 ? 8 : 16;
    const int srow = wave * 8 + (lane >> 3);
    const int scg = (lane & 7) ^ ((((wave & 1) << 2) + (lane >> 4)) & 7);
    const size_t soff = (size_t)srow * RS + scg * 16;
    const int fsw = (r >> 1) & 7;
    int fo[4];
#pragma unroll
    for (int ks = 0; ks < 4; ++ks) fo[ks] = ((ks * 2 + h) ^ fsw) * 16;
    for (int ti = blockIdx.x; ti < total; ti += gridDim.x) {
        const int label = ti & 7, j = ti >> 3;
        const int tm = label * 32 + j / NT, tn = j % NT;
        const int m0 = tm * 128, n0 = tn * 128;
        bool swapped = false;
        if (MODE == GM_INPROJ) swapped = (tn >= 4 && tn < 8);
        if (MODE == GM_QKV) swapped = (tn == 9);
        const char* Ag = (const char*)ga.A + (size_t)m0 * RS + soff;
        const char* Bg = (const char*)ga.Bt + (size_t)n0 * RS + soff;
        f32x16 acc[2][2];
        i32x16_t acci[2][2];
#pragma unroll
        for (int a = 0; a < 2; ++a) {
            zero_acc<2>(acc[a]);
#pragma unroll
            for (int b2 = 0; b2 < 2; ++b2)
#pragma unroll
                for (int i = 0; i < 16; ++i) acci[a][b2][i] = 0;
        }
#define GEMM_STAGE(BUF, KT)                                                                                           \
        _Pragma("unroll") for (int i = 0; i < 4; ++i) {                                                                \
            __builtin_amdgcn_global_load_lds((const unsigned*)(Ag + (size_t)i * 32 * RS + (KT) * 128),                \
                                             (unsigned*)(smem + (BUF) * 2 * GT_BYTES + (i * 4 + wave) * 1024), 16, 0, 0); \
            __builtin_amdgcn_global_load_lds((const unsigned*)(Bg + (size_t)i * 32 * RS + (KT) * 128),                \
                                             (unsigned*)(smem + (BUF) * 2 * GT_BYTES + GT_BYTES + (i * 4 + wave) * 1024), 16, 0, 0); \
        }
        f32x4n_t xi[16];
        if (MODE == GM_RESID) {
            const float* xp = (const float*)ga.xin + (size_t)(m0 + (tid >> 5)) * 1024 + n0 + (tid & 31) * 4;
#pragma unroll
            for (int it = 0; it < 16; ++it) xi[it] = __builtin_nontemporal_load((const f32x4n_t*)(xp + (size_t)it * 8 * 1024));
        }
        if (MODE == GM_RESID_BF) {
            const bf16_t* xp = (const bf16_t*)ga.xin + (size_t)(m0 + (tid >> 5)) * 1024 + n0 + (tid & 31) * 4;
#pragma unroll
            for (int it = 0; it < 16; ++it) {
                const u32x2_t q = __builtin_nontemporal_load((const u32x2_t*)(xp + (size_t)it * 8 * 1024));
                xi[it].x = __uint_as_float(q.x); xi[it].y = __uint_as_float(q.y);
            }
        }
        GEMM_STAGE(0, 0)
        asm volatile("s_waitcnt vmcnt(0)" ::: "memory");
        __syncthreads();
        for (int kt = 0; kt < NK; ++kt) {
            const int cur = kt & 1;
            if (kt < NK - 1) { GEMM_STAGE(cur ^ 1, kt + 1) }
            const char* At = smem + cur * 2 * GT_BYTES + (swapped ? GT_BYTES : 0) + (wm * 64 + r) * 128;
            const char* Bt2 = smem + cur * 2 * GT_BYTES + (swapped ? 0 : GT_BYTES) + (wn * 64 + r) * 128;
#pragma unroll
            for (int ks = 0; ks < 4; ++ks) {
                if (I8) {
                    i32x4_t af[2], bfr[2];
                    af[0] = *(const i32x4_t*)(At + fo[ks]);
                    af[1] = *(const i32x4_t*)(At + 32 * 128 + fo[ks]);
                    bfr[0] = *(const i32x4_t*)(Bt2 + fo[ks]);
                    bfr[1] = *(const i32x4_t*)(Bt2 + 32 * 128 + fo[ks]);
#pragma unroll
                    for (int mt = 0; mt < 2; ++mt)
#pragma unroll
                        for (int nt = 0; nt < 2; ++nt) acci[mt][nt] = __builtin_amdgcn_mfma_i32_32x32x32_i8(af[mt], bfr[nt], acci[mt][nt], 0, 0, 0);
                } else {
                    bf16x8 af[2], bfr[2];
                    af[0] = *(const bf16x8*)(At + fo[ks]);
                    af[1] = *(const bf16x8*)(At + 32 * 128 + fo[ks]);
                    bfr[0] = *(const bf16x8*)(Bt2 + fo[ks]);
                    bfr[1] = *(const bf16x8*)(Bt2 + 32 * 128 + fo[ks]);
#pragma unroll
                    for (int mt = 0; mt < 2; ++mt)
#pragma unroll
                        for (int nt = 0; nt < 2; ++nt) acc[mt][nt] = MFMA32(af[mt], bfr[nt], acc[mt][nt]);
                }
            }
            asm volatile("s_waitcnt vmcnt(0) lgkmcnt(0)" ::: "memory");
            __syncthreads();
        }
        if (I8) {
#pragma unroll
            for (int mt = 0; mt < 2; ++mt)
#pragma unroll
                for (int nt = 0; nt < 2; ++nt)
#pragma unroll
                    for (int i = 0; i < 16; ++i) acc[mt][nt][i] = (float)acci[mt][nt][i];
        }
        gemm_epilogue<MODE>(p, ws, ga, acc, m0, n0, tn, wm, wn, tid, swapped, (float*)smem, xi);
    }
}

#define KW_LD 136
DI void phase_m1b(const Params& p, char* ws, char* smem) {
    const bf16_t* VT = (const bf16_t*)(ws + OFF_R3) + (size_t)T_TOK * 512;
    bf16_t* Qm = (bf16_t*)(ws + OFF_R1);
    bf16_t* Km = (bf16_t*)(ws + OFF_R1 + 32ull * MiB);
    float* DT = (float*)(ws + OFF_R5);
    const bf16_t* WqT = (const bf16_t*)(ws + OFF_WQT);
    const bf16_t* WkT = (const bf16_t*)(ws + OFF_WKT);
    const float* ipre = (const float*)(ws + OFF_IPRE);
    const float* logf_ = (const float*)(ws + OFF_LOGF);
    float* Gc = (float*)(ws + OFF_G);
    float* Bv = (float*)(ws + OFF_BV);
    float* usc = (float*)(ws + OFF_USC);
    float* ND = (float*)(ws + OFF_ND);
    bf16_t* KwT = (bf16_t*)smem;
    float* wv = (float*)(smem + 128 * KW_LD * 2);
    bf16_t* CMs = (bf16_t*)(smem + 128 * KW_LD * 2 + 512);
    bf16_t* CMg = (bf16_t*)(ws + OFF_R5 + 64ull * MiB);
    const bf16_t* UM = (const bf16_t*)(ws + OFF_R3);
    const int tid = get_tid(), lane = tid & 63, wave = tid >> 6;
    const int r = lane & 31, h = lane >> 5;
    const int cvc = tid & 15, csub = tid >> 4;
    for (int unit = blockIdx.x; unit < 1024; unit += gridDim.x) {
        const int c = unit & 15, hd = (unit >> 4) & 3, b = unit >> 6;
        const size_t t0 = (size_t)b * SEQ + c * 128;
        __syncthreads();
        {
            const int ch0 = hd * 128 + cvc * 8;
            float cw[4][8], cb[8];
#pragma unroll
            for (int jx = 0; jx < 4; ++jx) {
                const float4 a0 = *(const float4*)(p.conv_w + jx * 512 + ch0), a1 = *(const float4*)(p.conv_w + jx * 512 + ch0 + 4);
                cw[jx][0] = a0.x; cw[jx][1] = a0.y; cw[jx][2] = a0.z; cw[jx][3] = a0.w; cw[jx][4] = a1.x; cw[jx][5] = a1.y; cw[jx][6] = a1.z; cw[jx][7] = a1.w;
            }
            {
                const float4 a0 = *(const float4*)(p.conv_b + ch0), a1 = *(const float4*)(p.conv_b + ch0 + 4);
                cb[0] = a0.x; cb[1] = a0.y; cb[2] = a0.z; cb[3] = a0.w; cb[4] = a1.x; cb[5] = a1.y; cb[6] = a1.z; cb[7] = a1.w;
            }
            u32x4_t raw[11];
#pragma unroll
            for (int q = 0; q < 11; ++q) {
                const int sq = c * 128 + csub * 8 + q - 3;
                raw[q] = (u32x4_t){0u, 0u, 0u, 0u};
                if (sq >= 0) raw[q] = *(const u32x4_t*)(UM + ((size_t)b * SEQ + sq) * 512 + ch0);
            }
            float hist[3][8];
#pragma unroll
            for (int q = 0; q < 3; ++q) {
                const unsigned w[4] = {raw[q].x, raw[q].y, raw[q].z, raw[q].w};
#pragma unroll
                for (int e = 0; e < 4; ++e) { hist[q][2 * e] = __uint_as_float(w[e] << 16); hist[q][2 * e + 1] = __uint_as_float(w[e] & 0xffff0000u); }
            }
#pragma unroll
            for (int q = 0; q < 8; ++q) {
                const unsigned w[4] = {raw[q + 3].x, raw[q + 3].y, raw[q + 3].z, raw[q + 3].w};
                float cur[8], o[8];
#pragma unroll
                for (int e = 0; e < 4; ++e) { cur[2 * e] = __uint_as_float(w[e] << 16); cur[2 * e + 1] = __uint_as_float(w[e] & 0xffff0000u); }
#pragma unroll
                for (int e = 0; e < 8; ++e) {
                    const float a = cw[0][e] * hist[0][e] + cw[1][e] * hist[1][e] + cw[2][e] * hist[2][e] + cw[3][e] * cur[e] + cb[e];
                    o[e] = siluf_(a);
                    hist[0][e] = hist[1][e]; hist[1][e] = hist[2][e]; hist[2][e] = cur[e];
                }
                u32x4_t ov;
                ov.x = pack2bf(o[0], o[1]); ov.y = pack2bf(o[2], o[3]); ov.z = pack2bf(o[4], o[5]); ov.w = pack2bf(o[6], o[7]);
                const int sl_ = csub * 8 + q;
                *(u32x4_t*)(CMs + sl_ * KW_LD + cvc * 8) = ov;
                *(u32x4_t*)(CMg + (t0 + sl_) * 512 + ch0) = ov;
            }
        }
        if (wave == 0) {
            const float i0 = ipre[(t0 + 2 * lane) * 4 + hd], i1 = ipre[(t0 + 2 * lane + 1) * 4 + hd];
            const float f0 = logf_[(t0 + 2 * lane) * 4 + hd], f1 = logf_[(t0 + 2 * lane + 1) * 4 + hd];
            float s = f0 + f1;
#pragma unroll
            for (int d = 1; d < 64; d <<= 1) { const float t = __shfl_up(s, d); if (lane >= d) s += t; }
            const float g1 = s, g0 = s - f1;
            const float gtot = __shfl(s, 63);
            const float b0 = i0 - g0, b1 = i1 - g1;
            float bm = fmaxf(b0, b1);
#pragma unroll
            for (int o = 32; o >= 1; o >>= 1) bm = fmaxf(bm, __shfl_xor(bm, o));
            const float Mc = gtot + bm;
            wv[2 * lane] = __expf(b0 - bm);
            wv[2 * lane + 1] = __expf(b1 - bm);
            Gc[(t0 + 2 * lane) * 4 + hd] = g0; Gc[(t0 + 2 * lane + 1) * 4 + hd] = g1;
            Bv[(t0 + 2 * lane) * 4 + hd] = b0; Bv[(t0 + 2 * lane + 1) * 4 + hd] = b1;
            if (lane == 0) { usc[unit * 4 + 0] = Mc; usc[unit * 4 + 1] = gtot; }
        }
        __syncthreads();
        const bf16_t* Acm = CMs;
        {
            f32x16 acc[4];
            zero_acc<4>(acc);
            wave_mma<4, 8>(acc, Acm + (wave * 32) * KW_LD, KW_LD, WqT + (size_t)hd * 16384, 128, lane);
            {
                bf16_t* qb = Qm + (t0 + wave * 32 + 4 * h) * 512 + hd * 128 + r;
#pragma unroll
                for (int i4 = 0; i4 < 4; ++i4) {
                    bf16_t* q2 = qb + (size_t)i4 * 8 * 512;
                    LAUNDER(q2);
#pragma unroll
                    for (int ii = 0; ii < 4; ++ii)
#pragma unroll
                        for (int nt = 0; nt < 4; ++nt) q2[ii * 512 + nt * 32] = f2bf(acc[nt][i4 * 4 + ii]);
                }
            }
            zero_acc<4>(acc);
            wave_mma<4, 8>(acc, Acm + (wave * 32) * KW_LD, KW_LD, WkT + (size_t)hd * 16384, 128, lane);
            {
                bf16_t* qb = Km + (t0 + wave * 32 + 4 * h) * 512 + hd * 128 + r;
#pragma unroll
                for (int i4 = 0; i4 < 4; ++i4) {
                    bf16_t* q2 = qb + (size_t)i4 * 8 * 512;
                    LAUNDER(q2);
#pragma unroll
                    for (int ii = 0; ii < 4; ++ii)
#pragma unroll
                        for (int nt = 0; nt < 4; ++nt) q2[ii * 512 + nt * 32] = f2bf(acc[nt][i4 * 4 + ii]);
                }
            }
        }
        {
            f32x16 acc[4];
            zero_acc<4>(acc);
            wave_mma<4, 8>(acc, WkT + (size_t)hd * 16384 + (size_t)(wave * 32) * 128, 128, Acm, KW_LD, lane);
#pragma unroll
            for (int nt = 0; nt < 4; ++nt) {
                const float w = wv[nt * 32 + r];
#pragma unroll
                for (int i = 0; i < 16; ++i) KwT[(wave * 32 + crow(i, h)) * KW_LD + nt * 32 + r] = f2bf(acc[nt][i] * w);
            }
        }
        __syncthreads();
        if (tid < 128) {
            float s = 0.f;
            for (int q = 0; q < 128; ++q) s += bf2f(KwT[tid * KW_LD + q]);
            ND[(size_t)unit * 128 + tid] = s;
        }
        {
            f32x16 acc[4];
            zero_acc<4>(acc);
            const bf16_t* Av = VT + ((size_t)b * 512 + hd * 128 + wave * 32) * 2048 + c * 128;
            wave_mma<4, 8>(acc, Av, 2048, KwT, KW_LD, lane);
            float* dst = DT + (size_t)unit * 16384 + (wave * 32 + 4 * h) * 128 + r;
#pragma unroll
            for (int i4 = 0; i4 < 4; ++i4) {
                float* d2 = dst + i4 * 8 * 128;
                LAUNDER(d2);
#pragma unroll
                for (int ii = 0; ii < 4; ++ii)
#pragma unroll
                    for (int nt = 0; nt < 4; ++nt) d2[ii * 128 + nt * 32] = acc[nt][i4 * 4 + ii];
            }
        }
    }
    __syncthreads();
}

DI void phase_m2(const Params& p, char* ws) {
    (void)p;
    const float* DT = (const float*)(ws + OFF_R5);
    bf16_t* Cin = (bf16_t*)(ws + OFF_R2);
    float* usc = (float*)(ws + OFF_USC);
    const float* ND = (const float*)(ws + OFF_ND);
    float* NIN = (float*)(ws + OFF_NIN);
    const size_t gtid = (size_t)blockIdx.x * 256 + get_tid(), gsz = (size_t)gridDim.x * 256;
    const size_t total = (size_t)64 * (16384 + 128);
    for (size_t it = gtid; it < total; it += gsz) {
        const int bh = (int)(it / (16384 + 128));
        const int idx = (int)(it % (16384 + 128));
        const bool isC = idx < 16384;
        const float* src = isC ? DT + (size_t)bh * 16 * 16384 + idx : ND + (size_t)bh * 16 * 128 + (idx - 16384);
        const size_t cstride = isC ? 16384 : 128;
        float dv[16], dec[16], sc[16];
#pragma unroll
        for (int c = 0; c < 16; ++c) dv[c] = src[(size_t)c * cstride];
        float m = NEG_INF_F;
#pragma unroll
        for (int c = 0; c < 16; ++c) {
            const int unit = bh * 16 + c;
            const float Mc = usc[unit * 4 + 0], gt = usc[unit * 4 + 1];
            const float mnew = fmaxf(gt + m, Mc);
            dec[c] = __expf(gt + m - mnew); sc[c] = __expf(Mc - mnew);
            if (idx == 16384) usc[unit * 4 + 2] = m;
            m = mnew;
        }
        float st = 0.f;
#pragma unroll
        for (int c = 0; c < 16; ++c) {
            const int unit = bh * 16 + c;
            if (isC) Cin[(size_t)unit * 16384 + idx] = f2bf(st);
            else NIN[(size_t)unit * 128 + (idx - 16384)] = st;
            st = dec[c] * st + sc[c] * dv[c];
        }
    }
}

template <int NT, int KSTEPS>
DI void wave_mma_regA_ldsB(f32x16 (&acc)[NT], const bf16x8 (&af)[KSTEPS], const bf16_t* B, int ldb, int lane) {
    const int r = lane & 31, h = lane >> 5;
#pragma unroll
    for (int ks = 0; ks < KSTEPS; ++ks) {
#pragma unroll
        for (int nt = 0; nt < NT; ++nt) acc[nt] = MFMA32(af[ks], *(const bf16x8*)(B + (nt * 32 + r) * ldb + ks * 16 + h * 8), acc[nt]);
        if (ks & 1) __builtin_amdgcn_sched_barrier(0);
    }
}
template <int NT, int KSTEPS>
DI void wave_mma_ldsAB(f32x16 (&acc)[NT], const bf16_t* A, int lda, const bf16_t* B, int ldb, int lane) {
    const int r = lane & 31, h = lane >> 5;
#pragma unroll
    for (int ks = 0; ks < KSTEPS; ++ks) {
        const bf16x8 a = *(const bf16x8*)(A + r * lda + ks * 16 + h * 8);
#pragma unroll
        for (int nt = 0; nt < NT; ++nt) acc[nt] = MFMA32(a, *(const bf16x8*)(B + (nt * 32 + r) * ldb + ks * 16 + h * 8), acc[nt]);
        if (ks & 1) asm volatile("" ::: "memory");
    }
}
DI void phase_m3(const Params& p, char* ws, char* smem) {
    const bf16_t* R3 = (const bf16_t*)(ws + OFF_R3);
    const bf16_t* VT = R3 + (size_t)T_TOK * 512;
    const bf16_t* Zb = R3 + (size_t)2 * T_TOK * 512;
    const bf16_t* CM = (const bf16_t*)(ws + OFF_R5 + 64ull * MiB);
    const bf16_t* Qm = (const bf16_t*)(ws + OFF_R1);
    const bf16_t* Km = (const bf16_t*)(ws + OFF_R1 + 32ull * MiB);
    const bf16_t* Cin = (const bf16_t*)(ws + OFF_R2);
    const bf16_t* PWT = (const bf16_t*)(ws + OFF_PWT);
    const float* Gc = (const float*)(ws + OFF_G);
    const float* Bv = (const float*)(ws + OFF_BV);
    const float* usc = (const float*)(ws + OFF_USC);
    const float* NIN = (const float*)(ws + OFF_NIN);
    bf16_t* MIX = (bf16_t*)(ws + OFF_R4);
    const int tid = get_tid(), lane = tid & 63, wave = tid >> 6;
    const int r = lane & 31, h = lane >> 5;
    bf16_t* Sp = (bf16_t*)smem + (size_t)wave * 32 * KW_LD;
    bf16_t* OPB = (bf16_t*)(smem + 4 * 32 * KW_LD * 2);
    float* fb = (float*)(smem + 2 * 4 * 32 * KW_LD * 2);
    float* gs = fb;
    float* bs = fb + 128;
    float* mxs = fb + 256;
    float* nin = fb + 384;
    float* qns = fb + 512;
    const int srow = tid >> 4, sch = tid & 15;
    for (int u2 = blockIdx.x; u2 < 1024; u2 += gridDim.x) {
        const int g = u2 & 3, c = (u2 >> 2) & 15, b = u2 >> 6;
        const size_t t0 = (size_t)b * SEQ + c * 128;
        u32x4_t R[8];
#pragma unroll
        for (int q = 0; q < 8; ++q) R[q] = *(const u32x4_t*)(PWT + (size_t)g * 16384 + (size_t)(srow + 16 * q) * 128 + sch * 8);
        __syncthreads();
#pragma unroll
        for (int q = 0; q < 8; ++q) *(u32x4_t*)(OPB + (srow + 16 * q) * KW_LD + sch * 8) = R[q];
        {
            const bf16_t* UP = (const bf16_t*)(ws + OFF_R3) + (size_t)3 * T_TOK * 512;
            const int pvc = tid & 15, psub = tid >> 4;
            const int ch0 = g * 128 + pvc * 8;
            const int W = 2 << g;
            const int s0 = c * 128 + psub * 8;
            const size_t tbase = (size_t)b * SEQ;
            float sum[8];
#pragma unroll
            for (int e = 0; e < 8; ++e) sum[e] = 0.f;
            for (int q = 1; q < W; ++q) {
                const int sq = s0 - q;
                if (sq >= 0) {
                    const u32x4_t rw = *(const u32x4_t*)(UP + (tbase + sq) * 512 + ch0);
                    const unsigned w[4] = {rw.x, rw.y, rw.z, rw.w};
#pragma unroll
                    for (int e = 0; e < 4; ++e) { sum[2 * e] += __uint_as_float(w[e] << 16); sum[2 * e + 1] += __uint_as_float(w[e] & 0xffff0000u); }
                }
            }
            u32x4_t rawb[8], rlb[8];
#pragma unroll
            for (int q = 0; q < 8; ++q) {
                const int sq = s0 + q;
                rawb[q] = *(const u32x4_t*)(UP + (tbase + sq) * 512 + ch0);
                const int sl_ = sq - W + 1;
                rlb[q] = (u32x4_t){0u, 0u, 0u, 0u};
                if (sl_ >= 0) rlb[q] = *(const u32x4_t*)(UP + (tbase + sl_) * 512 + ch0);
            }
#pragma unroll
            for (int q = 0; q < 8; ++q) {
                const int sq = s0 + q;
                const unsigned w[4] = {rawb[q].x, rawb[q].y, rawb[q].z, rawb[q].w};
                float cur[8], o[8];
#pragma unroll
                for (int e = 0; e < 4; ++e) { cur[2 * e] = __uint_as_float(w[e] << 16); cur[2 * e + 1] = __uint_as_float(w[e] & 0xffff0000u); }
                const int cnt = (sq + 1 < W) ? (sq + 1) : W;
                const float inv = 1.f / (float)cnt;
#pragma unroll
                for (int e = 0; e < 8; ++e) { sum[e] += cur[e]; o[e] = sum[e] * inv - cur[e]; }
                u32x4_t ov;
                ov.x = pack2bf(o[0], o[1]); ov.y = pack2bf(o[2], o[3]); ov.z = pack2bf(o[4], o[5]); ov.w = pack2bf(o[6], o[7]);
                *(u32x4_t*)((bf16_t*)smem + (psub * 8 + q) * KW_LD + pvc * 8) = ov;
                const unsigned wl[4] = {rlb[q].x, rlb[q].y, rlb[q].z, rlb[q].w};
#pragma unroll
                for (int e = 0; e < 4; ++e) { sum[2 * e] -= __uint_as_float(wl[e] << 16); sum[2 * e + 1] -= __uint_as_float(wl[e] & 0xffff0000u); }
            }
        }
        __syncthreads();
        f32x16 acc[4];
        zero_acc<4>(acc);
        wave_mma_ldsAB<4, 8>(acc, (const bf16_t*)smem + wave * 32 * KW_LD, KW_LD, OPB, KW_LD, lane);
        bf16_t* mb = MIX + (t0 + wave * 32 + 4 * h) * 1024 + 512 + g * 128 + r;
#pragma unroll
        for (int i4 = 0; i4 < 4; ++i4) {
            bf16_t* m2 = mb + (size_t)i4 * 8 * 1024;
            LAUNDER(m2);
#pragma unroll
            for (int ii = 0; ii < 4; ++ii)
#pragma unroll
                for (int nt = 0; nt < 4; ++nt) m2[ii * 1024 + nt * 32] = f2bf(acc[nt][i4 * 4 + ii]);
        }
    }
    for (int unit = blockIdx.x; unit < 1024; unit += gridDim.x) {
        const int c = unit & 15, hd = (unit >> 4) & 3, b = unit >> 6;
        const size_t t0 = (size_t)b * SEQ + c * 128;
        const float m_in = usc[unit * 4 + 2];
        const int l0 = wave * 32;
        bf16x8 qf[8];
#pragma unroll
        for (int ks = 0; ks < 8; ++ks) qf[ks] = *(const bf16x8*)(Qm + (t0 + l0 + r) * 512 + hd * 128 + ks * 16 + h * 8);
        __syncthreads();
        if (wave == 0) {
            const float b0 = Bv[(t0 + 2 * lane) * 4 + hd], b1 = Bv[(t0 + 2 * lane + 1) * 4 + hd];
            float s = fmaxf(b0, b1);
#pragma unroll
            for (int d = 1; d < 64; d <<= 1) { const float t = __shfl_up(s, d); if (lane >= d) s = fmaxf(s, t); }
            float prev = __shfl_up(s, 1);
            if (lane == 0) prev = NEG_INF_F;
            const float pm0 = fmaxf(prev, b0), pm1 = s;
            bs[2 * lane] = b0; bs[2 * lane + 1] = b1;
            mxs[2 * lane] = fmaxf(m_in, pm0); mxs[2 * lane + 1] = fmaxf(m_in, pm1);
        } else if (wave == 1) {
            gs[2 * lane] = Gc[(t0 + 2 * lane) * 4 + hd]; gs[2 * lane + 1] = Gc[(t0 + 2 * lane + 1) * 4 + hd];
            nin[2 * lane] = NIN[(size_t)unit * 128 + 2 * lane]; nin[2 * lane + 1] = NIN[(size_t)unit * 128 + 2 * lane + 1];
        }
        {
            u32x4_t R[8];
#pragma unroll
            for (int q = 0; q < 8; ++q) R[q] = *(const u32x4_t*)(Km + (t0 + srow + 16 * q) * 512 + hd * 128 + sch * 8);
#pragma unroll
            for (int q = 0; q < 8; ++q) *(u32x4_t*)(OPB + (srow + 16 * q) * KW_LD + sch * 8) = R[q];
        }
        __syncthreads();
        if (lane < 32) {
            const bf16_t* qr = Qm + (t0 + l0 + lane) * 512 + hd * 128;
            float s = 0.f;
            uint4 raw16[16];
#pragma unroll
            for (int d8 = 0; d8 < 16; ++d8) raw16[d8] = *(const uint4*)(qr + d8 * 8);
#pragma unroll
            for (int d8 = 0; d8 < 16; ++d8) {
                const unsigned w[4] = {raw16[d8].x, raw16[d8].y, raw16[d8].z, raw16[d8].w};
#pragma unroll
                for (int e = 0; e < 4; ++e) s += bf2f((bf16_t)(w[e] & 0xffff)) * nin[d8 * 8 + 2 * e] + bf2f((bf16_t)(w[e] >> 16)) * nin[d8 * 8 + 2 * e + 1];
            }
            qns[wave * 32 + lane] = s;
        }
        float den2[16];
        {
            f32x16 acc[4];
            zero_acc<4>(acc);
            wave_mma_regA_ldsB<4, 8>(acc, qf, OPB, KW_LD, lane);
#pragma unroll
            for (int i = 0; i < 16; ++i) {
                const int l = l0 + crow(i, h);
                const float mxl = mxs[l];
                float rs = 0.f;
#pragma unroll
                for (int nt = 0; nt < 4; ++nt) {
                    const int sx = nt * 32 + r;
                    float v = 0.f;
                    if (sx <= l) v = acc[nt][i] * __expf(fminf(bs[sx] - mxl, 0.f));
                    rs += v;
                    Sp[crow(i, h) * KW_LD + sx] = f2bf(v);
                }
                den2[i] = half_sum(rs);
            }
        }
#pragma unroll
        for (int ks = 0; ks < 8; ++ks) qf[ks] = *(const bf16x8*)(Qm + (t0 + l0 + r) * 512 + hd * 128 + ks * 16 + h * 8);
        __syncthreads();
        {
            u32x4_t R[8];
#pragma unroll
            for (int q = 0; q < 8; ++q) R[q] = *(const u32x4_t*)(Cin + (size_t)unit * 16384 + (size_t)(srow + 16 * q) * 128 + sch * 8);
#pragma unroll
            for (int q = 0; q < 8; ++q) *(u32x4_t*)(OPB + (srow + 16 * q) * KW_LD + sch * 8) = R[q];
        }
        __syncthreads();
        f32x16 acc[4];
        zero_acc<4>(acc);
        wave_mma_regA_ldsB<4, 8>(acc, qf, OPB, KW_LD, lane);
#pragma unroll
        for (int i = 0; i < 16; ++i) {
            const int l = l0 + crow(i, h);
            const float inter_i = __expf(m_in - mxs[l]);
#pragma unroll
            for (int nt = 0; nt < 4; ++nt) acc[nt][i] *= inter_i;
        }
        __syncthreads();
        {
            u32x4_t R[8];
#pragma unroll
            for (int q = 0; q < 8; ++q) R[q] = *(const u32x4_t*)(VT + ((size_t)b * 512 + hd * 128 + srow + 16 * q) * 2048 + c * 128 + sch * 8);
#pragma unroll
            for (int q = 0; q < 8; ++q) *(u32x4_t*)(OPB + (srow + 16 * q) * KW_LD + sch * 8) = R[q];
        }
        __syncthreads();
        wave_mma_ldsAB<4, 8>(acc, Sp, KW_LD, OPB, KW_LD, lane);
#pragma unroll
        for (int i = 0; i < 16; ++i) {
            const int lr = crow(i, h), l = l0 + lr;
            const float den = __expf(m_in - mxs[l]) * qns[wave * 32 + lr] + den2[i];
            const float mrow = gs[l] + mxs[l];
            const float dn = fmaxf(fabsf(den), __expf(-mrow)) + 1e-6f;
            const float inv = 1.f / dn;
            float hv[4];
            float sm = 0.f;
#pragma unroll
            for (int nt = 0; nt < 4; ++nt) { hv[nt] = acc[nt][i] * inv; sm += hv[nt]; }
            const float mu = half_sum(sm) * (1.f / 128.f);
            float sq = 0.f;
#pragma unroll
            for (int nt = 0; nt < 4; ++nt) { const float d = hv[nt] - mu; sq += d * d; }
            const float var = half_sum(sq) * (1.f / 128.f);
            const float rstd = rsqrtf(var + 1e-6f);
#pragma unroll
            for (int nt = 0; nt < 4; ++nt) Sp[lr * KW_LD + nt * 32 + r] = f2bf((hv[nt] - mu) * rstd);
        }
        {
            const int c8 = lane & 15;
            const bf16_t* zrow = Zb + (t0 + l0 + (lane >> 4)) * 512 + hd * 128 + c8 * 8;
            const bf16_t* crow_ = CM + (t0 + l0 + (lane >> 4)) * 512 + hd * 128 + c8 * 8;
            bf16_t* mrow = MIX + (t0 + l0 + (lane >> 4)) * 1024 + hd * 128 + c8 * 8;
            const float* hgp = p.head_g + hd * 128 + c8 * 8;
            const float* skp = p.skip + hd * 128 + c8 * 8;
            LAUNDER(zrow); LAUNDER(crow_); LAUNDER(mrow); LAUNDER(hgp); LAUNDER(skp);
            const float4 hgA = *(const float4*)(hgp), hgB = *(const float4*)(hgp + 4);
            const float4 skA = *(const float4*)(skp), skB = *(const float4*)(skp + 4);
#pragma unroll
            for (int hb = 0; hb < 2; ++hb) {
                uint4 zq[4], cq[4];
#pragma unroll
                for (int it = 0; it < 4; ++it) {
                    zq[it] = *(const uint4*)(zrow + (size_t)(hb * 4 + it) * 4 * 512);
                    cq[it] = *(const uint4*)(crow_ + (size_t)(hb * 4 + it) * 4 * 512);
                }
#pragma unroll
                for (int it = 0; it < 4; ++it) {
                    const int row = (hb * 4 + it) * 4 + (lane >> 4);
                    const uint4 hq = *(const uint4*)(Sp + row * KW_LD + c8 * 8);
#define M3_GATE(HW, ZW, CW, G0, G1, S0, S1, OUTW)                                                             \
                    {                                                                                           \
                        const float h0_ = __uint_as_float((HW) << 16), h1_ = __uint_as_float((HW) & 0xffff0000u); \
                        const float z0_ = __uint_as_float((ZW) << 16), z1_ = __uint_as_float((ZW) & 0xffff0000u); \
                        const float m0_ = __uint_as_float((CW) << 16), m1_ = __uint_as_float((CW) & 0xffff0000u); \
                        OUTW = pack2bf(sigmoidf_(z0_) * (h0_ * (G0) + (S0) * m0_), sigmoidf_(z1_) * (h1_ * (G1) + (S1) * m1_)); \
                    }
                    uint4 ov;
                    M3_GATE(hq.x, zq[it].x, cq[it].x, hgA.x, hgA.y, skA.x, skA.y, ov.x)
                    M3_GATE(hq.y, zq[it].y, cq[it].y, hgA.z, hgA.w, skA.z, skA.w, ov.y)
                    M3_GATE(hq.z, zq[it].z, cq[it].z, hgB.x, hgB.y, skB.x, skB.y, ov.z)
                    M3_GATE(hq.w, zq[it].w, cq[it].w, hgB.z, hgB.w, skB.z, skB.w, ov.w)
                    *(uint4*)(mrow + (size_t)(hb * 4 + it) * 4 * 1024) = ov;
                }
                asm volatile("" ::: "memory");
            }
        }
    }
    __syncthreads();
}

DI void phase_pre_scoremat(const Params& p, char* ws, char* smem) {
    bf16_t* As = (bf16_t*)smem;
    bf16_t* Bs = (bf16_t*)(smem + 128 * KW_LD * 2);
    float* M = (float*)(ws + OFF_M);
    const int tid = get_tid(), lane = tid & 63, wave = tid >> 6, r = lane & 31, h = lane >> 5;
    for (int u = (int)gridDim.x - 1 - (int)blockIdx.x; u < 256; u += gridDim.x) {
        const int layer = u >> 7, hp = (u >> 3) & 15, c0 = (u & 7) * 128;
        __syncthreads();
#pragma unroll 1
        for (int i0 = 0; i0 < 128 * 32; i0 += 8 * 256) {
            float4 v[8], w[8];
#pragma unroll
            for (int u = 0; u < 8; ++u) {
                const int i = i0 + u * 256 + tid, row = i >> 5, ch = i & 31;
                v[u] = *(const float4*)(p.peer_wq + ((size_t)layer * 1024 + c0 + row) * 2048 + hp * 128 + ch * 4);
                w[u] = *(const float4*)(p.peer_keys + (((size_t)layer * 16 + hp) * 128 + row) * 128 + ch * 4);
            }
#pragma unroll
            for (int u = 0; u < 8; ++u) {
                const int i = i0 + u * 256 + tid, row = i >> 5, ch = i & 31;
                *(uint2*)(As + row * KW_LD + ch * 4) = make_uint2(pack2bf(v[u].x, v[u].y), pack2bf(v[u].z, v[u].w));
                *(uint2*)(Bs + row * KW_LD + ch * 4) = make_uint2(pack2bf(w[u].x, w[u].y), pack2bf(w[u].z, w[u].w));
            }
        }
        __syncthreads();
        f32x16 acc[4];
        zero_acc<4>(acc);
        wave_mma_ldsAB<4, 8>(acc, As + wave * 32 * KW_LD, KW_LD, Bs, KW_LD, lane);
        float* mb = M + ((size_t)layer * 1024 + c0 + wave * 32 + 4 * h) * 2048 + hp * 128 + r;
#pragma unroll
        for (int i4 = 0; i4 < 4; ++i4) {
            float* m2 = mb + (size_t)i4 * 8 * 2048;
            LAUNDER(m2);
#pragma unroll
            for (int ii = 0; ii < 4; ++ii)
#pragma unroll
                for (int nt = 0; nt < 4; ++nt) m2[ii * 2048 + nt * 32] = acc[nt][i4 * 4 + ii];
        }
    }
    __syncthreads();
}

DI unsigned f2ord(float x) { const unsigned u = __float_as_uint(x); return (u & 0x80000000u) ? ~u : (u | 0x80000000u); }
DI float ord2f(unsigned k) { const unsigned u = (k & 0x80000000u) ? (k & 0x7fffffffu) : ~k; return __uint_as_float(u); }

DI void convert_row_load(const Params& p, int layer, int row, int lane, float (&v)[16]) {
    const int tab = row >> 14, e = row & 16383;
    const float* src = (tab ? p.peer_v : p.peer_u) + ((size_t)layer * 16384 + e) * 1024 + lane * 16;
#pragma unroll
    for (int i = 0; i < 4; ++i) {
        const f32x4n_t q = __builtin_nontemporal_load((const f32x4n_t*)(src + i * 4));
        v[i * 4 + 0] = q.x; v[i * 4 + 1] = q.y; v[i * 4 + 2] = q.z; v[i * 4 + 3] = q.w;
    }
}
#define TAB_V_OFF (8ull * MiB)
DI void convert_row_finish(char* ws, int layer, int row, int lane, const float (&v)[16]) {
    unsigned char* T8 = (unsigned char*)(ws + OFF_R4);
    float2* SC = (float2*)(ws + OFF_SC) + (size_t)layer * 16384;
    const int tab = row >> 14, e = row & 16383;
    float am = 0.f, ss = 0.f;
#pragma unroll
    for (int i = 0; i < 16; ++i) { am = fmaxf(am, fabsf(v[i])); ss += v[i] * v[i]; }
    am = wave_max_dpp(am); ss = wave_sum_dpp(ss);
    const float step = fminf(0.3352f * sqrtf(ss * (1.f / 1024.f)), am * (1.f / 7.5f));
    const float sc = (step > 0.f) ? 1.f / step : 0.f;
    unsigned w[2];
#pragma unroll
    for (int j = 0; j < 2; ++j) {
        unsigned acc = 0;
#pragma unroll
        for (int k = 0; k < 8; ++k) {
            int n = (int)floorf(v[j * 8 + k] * sc) + 8;
            n = n < 0 ? 0 : (n > 15 ? 15 : n);
            const int nibU = (k < 4) ? 2 * k : 2 * (k - 4) + 1;
            const int pos = (tab == 0) ? nibU : k;
            acc |= (unsigned)((pos & 1) ? (n ^ 8) : n) << (4 * pos);
        }
        w[j] = acc;
    }
    *(uint2*)(T8 + (tab ? TAB_V_OFF : 0) + (size_t)(lane >> 4) * (16384 * 128) + (size_t)e * 128 + (lane & 15) * 8) = make_uint2(w[0], w[1]);
    if (lane == 0) { if (tab == 0) SC[e].x = step * (1.f / 16.f); else SC[e].y = step; }
}

typedef float f32x4 __attribute__((ext_vector_type(4)));
#define MFMA16(a, b, c) __builtin_amdgcn_mfma_f32_16x16x32_bf16((a), (b), (c), 0, 0, 0)
#define DPPU(v, ctrl) ((unsigned)__builtin_amdgcn_mov_dpp((int)(v), (ctrl), 0xF, 0xF, true))
DI unsigned umax_(unsigned a, unsigned b) { return a > b ? a : b; }
DI unsigned row16_umax(unsigned v) {
    v = umax_(v, DPPU(v, 0xB1)); v = umax_(v, DPPU(v, 0x4E)); v = umax_(v, DPPU(v, 0x141)); v = umax_(v, DPPU(v, 0x140));
    return v;
}
DI float row16_sum(float v) {
    v += __int_as_float(__builtin_amdgcn_mov_dpp(__float_as_int(v), 0xB1, 0xF, 0xF, true));
    v += __int_as_float(__builtin_amdgcn_mov_dpp(__float_as_int(v), 0x4E, 0xF, 0xF, true));
    v += __int_as_float(__builtin_amdgcn_mov_dpp(__float_as_int(v), 0x141, 0xF, 0xF, true));
    v += __int_as_float(__builtin_amdgcn_mov_dpp(__float_as_int(v), 0x140, 0xF, 0xF, true));
    return v;
}
DI void cand_pair(int c, int& ia, int& ib) {
    if (c < 16) { ia = 0; ib = c; }
    else if (c < 24) { ia = 1; ib = c - 16; }
    else if (c < 29) { ia = 2; ib = c - 24; }
    else if (c < 33) { ia = 3; ib = c - 29; }
    else if (c < 36) { ia = 4; ib = c - 33; }
    else if (c < 38) { ia = 5; ib = c - 36; }
    else if (c < 40) { ia = 6; ib = c - 38; }
    else if (c < 42) { ia = 7; ib = c - 40; }
    else { ia = c - 34; ib = 0; }
}
DI void phase_topk(const Params& p, char* ws, int layer, char* smem) {
    const bf16_t* Sc = (const bf16_t*)(ws + OFF_R3);
    unsigned* LIST = (unsigned*)(ws + OFF_R5);
    const int tid = get_tid(), lane = tid & 63, wave = tid >> 6;
    const int c16 = lane & 15, q4 = lane >> 4, rowbase = lane & 48;
    int ca[4], cb[4];
#pragma unroll
    for (int q = 0; q < 4; ++q) cand_pair(c16 + 16 * q, ca[q], cb[q]);
    const int hd = (int)blockIdx.x & 7;
    const int nblk = ((int)gridDim.x - hd + 7) >> 3;
    const int wv = ((int)blockIdx.x >> 3) * 4 + wave, nwv = nblk * 4;
    __syncthreads();
    const int gw = (int)blockIdx.x * 4 + wave, ngw = (int)gridDim.x * 4;
    int crow_i = gw;
    u32x4_t sfc[2][4], sfn[2][4];
    {
        const int tl0 = wv < T_TOK / 16 ? wv : T_TOK / 16 - 1;
#pragma unroll
        for (int pp = 0; pp < 2; ++pp)
#pragma unroll
            for (int rg = 0; rg < 4; ++rg) sfc[pp][rg] = *(const u32x4_t*)(Sc + ((size_t)tl0 * 16 + q4 * 4 + rg) * 2048 + (hd * 2 + pp) * 128 + c16 * 8);
    }
    for (int tile = wv; tile < T_TOK / 16; tile += nwv) {
        const size_t t0 = (size_t)tile * 16;
        {
            const int tnx = (tile + nwv < T_TOK / 16) ? tile + nwv : T_TOK / 16 - 1;
#pragma unroll
            for (int pp = 0; pp < 2; ++pp)
#pragma unroll
                for (int rg = 0; rg < 4; ++rg) sfn[pp][rg] = *(const u32x4_t*)(Sc + ((size_t)tnx * 16 + q4 * 4 + rg) * 2048 + (hd * 2 + pp) * 128 + c16 * 8);
        }
        float cva[16], cvb[16];
        const int cr0 = crow_i < 32768 ? crow_i : 32767, cr1 = crow_i + ngw < 32768 ? crow_i + ngw : 32767;
        convert_row_load(p, layer, cr0, lane, cva);
        convert_row_load(p, layer, cr1, lane, cvb);
        crow_i += 2 * ngw;
        unsigned top[2][4];
#pragma unroll
        for (int pp = 0; pp < 2; ++pp) {
            unsigned kk[8][4];
#pragma unroll
            for (int rg = 0; rg < 4; ++rg) {
                const unsigned w[4] = {sfc[pp][rg].x, sfc[pp][rg].y, sfc[pp][rg].z, sfc[pp][rg].w};
#pragma unroll
                for (int e = 0; e < 4; ++e) {
                    kk[2 * e][rg] = (f2ord(__uint_as_float(w[e] << 16)) & ~127u) | (unsigned)(127 - (c16 * 8 + 2 * e));
                    kk[2 * e + 1][rg] = (f2ord(__uint_as_float(w[e] & 0xffff0000u)) & ~127u) | (unsigned)(127 - (c16 * 8 + 2 * e + 1));
                }
            }
#pragma unroll
            for (int rg = 0; rg < 4; ++rg) top[pp][rg] = 0u;
#define CE8(a, b) { const unsigned hi_ = umax_(kk[a][rg], kk[b][rg]); const unsigned lo_ = kk[a][rg] < kk[b][rg] ? kk[a][rg] : kk[b][rg]; kk[a][rg] = hi_; kk[b][rg] = lo_; }
#pragma unroll
            for (int rg = 0; rg < 4; ++rg) {
                CE8(0, 1) CE8(2, 3) CE8(4, 5) CE8(6, 7) CE8(0, 2) CE8(1, 3) CE8(4, 6) CE8(5, 7) CE8(1, 2) CE8(5, 6)
                CE8(0, 4) CE8(3, 7) CE8(1, 5) CE8(2, 6) CE8(1, 4) CE8(3, 6) CE8(2, 4) CE8(3, 5) CE8(3, 4)
            }
            unsigned* hl = (unsigned*)smem + wave * (4 * 64 * 9);
            unsigned head[4], haddr[4];
#pragma unroll
            for (int rg = 0; rg < 4; ++rg) {
                unsigned* hp_ = hl + (rg * 64 + lane) * 9;
#pragma unroll
                for (int j = 0; j < 8; ++j) hp_[j] = kk[j][rg];
                hp_[8] = 0u;
                head[rg] = kk[0][rg];
                haddr[rg] = (unsigned)((rg * 64 + lane) * 9) * 4u;
            }
#pragma unroll 1
            for (int it = 0; it < 16; ++it) {
#pragma unroll
                for (int rg = 0; rg < 4; ++rg) {
                    const unsigned m = row16_umax(head[rg]);
                    if (c16 == it) top[pp][rg] = m;
                    haddr[rg] += (head[rg] == m) ? 4u : 0u;
                    head[rg] = *(const unsigned*)((const char*)hl + haddr[rg]);
                }
            }
        }
        unsigned ck[4][4], win[4];
#pragma unroll
        for (int rg = 0; rg < 4; ++rg) {
            const float va = ord2f(top[0][rg] & ~127u), vb = ord2f(top[1][rg] & ~127u);
#pragma unroll
            for (int q = 0; q < 4; ++q) {
                const float a = __shfl(va, rowbase + ca[q]);
                const float bq = __shfl(vb, rowbase + cb[q]);
                const int c = c16 + 16 * q;
                ck[q][rg] = (c < 50) ? ((f2ord(a + bq) & ~63u) | (unsigned)(63 - c)) : 0u;
            }
            win[rg] = 0u;
        }
#define CE4(a, b) { const unsigned hi_ = umax_(ck[a][rg], ck[b][rg]); const unsigned lo_ = ck[a][rg] < ck[b][rg] ? ck[a][rg] : ck[b][rg]; ck[a][rg] = hi_; ck[b][rg] = lo_; }
#pragma unroll
        for (int rg = 0; rg < 4; ++rg) { CE4(0, 1) CE4(2, 3) CE4(0, 2) CE4(1, 3) CE4(1, 2) }
#pragma unroll 1
        for (int it = 0; it < 16; ++it) {
#pragma unroll
            for (int rg = 0; rg < 4; ++rg) {
                const unsigned m = row16_umax(ck[0][rg]);
                if (c16 == it) win[rg] = m;
                const bool won = (ck[0][rg] == m);
                ck[0][rg] = won ? ck[1][rg] : ck[0][rg];
                ck[1][rg] = won ? ck[2][rg] : ck[1][rg];
                ck[2][rg] = won ? ck[3][rg] : ck[2][rg];
                ck[3][rg] = won ? 0u : ck[3][rg];
            }
        }
        convert_row_finish(ws, layer, cr0, lane, cva);
        convert_row_finish(ws, layer, cr1, lane, cvb);
#pragma unroll
        for (int rg = 0; rg < 4; ++rg) {
            int ia, ib;
            cand_pair(63 - (int)(win[rg] & 63u), ia, ib);
            ia &= 15; ib &= 15;
            const unsigned ta = (unsigned)__shfl((int)top[0][rg], rowbase + ia);
            const unsigned tb = (unsigned)__shfl((int)top[1][rg], rowbase + ib);
            const int e = (127 - (int)(ta & 127u)) * 128 + (127 - (int)(tb & 127u));
            const float cv = ord2f(win[rg] & ~63u);
            const float cmax = __shfl(cv, rowbase);
            const float ex = __expf(cv - cmax);
            const float den = row16_sum(ex);
            const float g = ex / den;
            const size_t t = t0 + q4 * 4 + rg;
            ((unsigned short*)LIST)[t * 128 + hd * 16 + c16] = (unsigned short)e;
            ((unsigned short*)LIST)[(size_t)T_TOK * 128 + t * 128 + hd * 16 + c16] = f2bf(g);
        }
#pragma unroll
        for (int pp = 0; pp < 2; ++pp)
#pragma unroll
            for (int rg = 0; rg < 4; ++rg) sfc[pp][rg] = sfn[pp][rg];
    }
    for (; crow_i < 32768; crow_i += ngw) {
        float cv[16];
        convert_row_load(p, layer, crow_i, lane, cv);
        convert_row_finish(ws, layer, crow_i, lane, cv);
    }
}

typedef float f32x2 __attribute__((ext_vector_type(2)));
DI void fp8x16_to_f32(const uint4& q, float (&f)[16]) {
    const unsigned w[4] = {q.x, q.y, q.z, q.w};
#pragma unroll
    for (int i = 0; i < 4; ++i) {
        const f32x2 lo = __builtin_amdgcn_cvt_pk_f32_fp8((int)w[i], false);
        const f32x2 hi = __builtin_amdgcn_cvt_pk_f32_fp8((int)w[i], true);
        f[i * 4 + 0] = lo.x; f[i * 4 + 1] = lo.y; f[i * 4 + 2] = hi.x; f[i * 4 + 3] = hi.y;
    }
}

DI uint4 nt_load_u4(const void* ptr) { const u32x4_t v = __builtin_nontemporal_load((const u32x4_t*)ptr); return make_uint4(v.x, v.y, v.z, v.w); }
DI float4 nt_load_f4(const void* ptr) { const f32x4n_t v = __builtin_nontemporal_load((const f32x4n_t*)ptr); return make_float4(v.x, v.y, v.z, v.w); }
DI void slice_assign(int& x, int& wv, int& nwv) {
    const int G = (int)gridDim.x;
    x = (int)blockIdx.x & 7;
    const int nblk = (G - x + 7) >> 3;
    wv = ((int)blockIdx.x >> 3) * 4 + (get_tid() >> 6);
    nwv = nblk * 4;
}
DI void peer_issue(const unsigned char* tab, const uint4 (&E)[2], int half, unsigned coloff, uint4 (&buf)[8]) {
    const uint4 ea = half ? E[1] : E[0];
    unsigned w4[4] = {ea.x, ea.y, ea.z, ea.w};
    asm volatile("" : "+v"(w4[0]), "+v"(w4[1]), "+v"(w4[2]), "+v"(w4[3]));
#pragma unroll
    for (int j = 0; j < 8; ++j) {
        const unsigned e = (j & 1) ? (w4[j >> 1] >> 16) : (w4[j >> 1] & 0xffffu);
        buf[j] = *(const uint4*)(tab + (e * 128u + coloff));
    }
}
DI void slice_assign4(int& x, int& wv, int& nwv) {
    const int G = (int)gridDim.x, L = (int)blockIdx.x & 7;
    x = L & 3;
    const int nb_lo = (G - x + 7) >> 3, nb_hi = (G - (x + 4) + 7) >> 3;
    wv = ((L >> 2) ? nb_lo * 4 : 0) + ((int)blockIdx.x >> 3) * 4 + (get_tid() >> 6);
    nwv = (nb_lo + nb_hi) * 4;
}
DI void peer_u_compute(const uint4 (&buf)[8], const uint4& hA_in, const uint4& hB_in, int init, int c, int& keep) {
    unsigned h0 = hA_in.x, h1 = hA_in.y, h2 = hA_in.z, h3 = hA_in.w, h4 = hB_in.x, h5 = hB_in.y, h6 = hB_in.z, h7 = hB_in.w;
    asm volatile("" : "+v"(h0), "+v"(h1), "+v"(h2), "+v"(h3), "+v"(h4), "+v"(h5), "+v"(h6), "+v"(h7), "+v"(keep), "+v"(init));
    const unsigned ML = 0x0F0F0F0Fu, MH = 0xF0F0F0F0u;
#pragma unroll
    for (int j = 0; j < 8; ++j) {
        int accL, accH;
        asm("v_dot4_i32_i8 %0, %1, %2, 0" : "=v"(accL) : "v"(buf[j].x & ML), "v"(h0));
        asm("v_dot4_i32_i8 %0, %1, %2, %3" : "=v"(accH) : "v"(buf[j].x & MH), "v"(h1), "v"(init));
        accL = __builtin_amdgcn_sdot4((int)(buf[j].y & ML), (int)h2, accL, false);
        accH = __builtin_amdgcn_sdot4((int)(buf[j].y & MH), (int)h3, accH, false);
        accL = __builtin_amdgcn_sdot4((int)(buf[j].z & ML), (int)h4, accL, false);
        accH = __builtin_amdgcn_sdot4((int)(buf[j].z & MH), (int)h5, accH, false);
        accL = __builtin_amdgcn_sdot4((int)(buf[j].w & ML), (int)h6, accL, false);
        accH = __builtin_amdgcn_sdot4((int)(buf[j].w & MH), (int)h7, accH, false);
        int acc = accL * 16 + accH;
        acc += __builtin_amdgcn_mov_dpp(acc, 0xB1, 0xF, 0xF, true);
        acc += __builtin_amdgcn_mov_dpp(acc, 0x4E, 0xF, 0xF, true);
        acc += __builtin_amdgcn_mov_dpp(acc, 0x141, 0xF, 0xF, true);
        if (c == j) keep = acc;
    }
    asm volatile("" : "+v"(keep));
}
DI int peer_u_init(const uint4& hA, const uint4& hB) {
    int sl_ = __builtin_amdgcn_sdot4((int)hA.x, 0x01010101, 0, false);
    int sh_ = __builtin_amdgcn_sdot4((int)hA.y, 0x01010101, 0, false);
    sl_ = __builtin_amdgcn_sdot4((int)hA.z, 0x01010101, sl_, false);
    sh_ = __builtin_amdgcn_sdot4((int)hA.w, 0x01010101, sh_, false);
    sl_ = __builtin_amdgcn_sdot4((int)hB.x, 0x01010101, sl_, false);
    sh_ = __builtin_amdgcn_sdot4((int)hB.y, 0x01010101, sh_, false);
    sl_ = __builtin_amdgcn_sdot4((int)hB.z, 0x01010101, sl_, false);
    sh_ = __builtin_amdgcn_sdot4((int)hB.w, 0x01010101, sh_, false);
    return 8 * sh_ - 120 * sl_;
}
DI void phase_peer_u(const Params& p, char* ws, int layer) {
    (void)p; (void)layer;
    const unsigned char* H8 = (const unsigned char*)(ws + OFF_R5 + 16ull * MiB);
    const unsigned* LIST = (const unsigned*)(ws + OFF_R5);
    const unsigned char* U4 = (const unsigned char*)(ws + OFF_R4);
    int* PART = (int*)(ws + OFF_R3);
    const int lane = get_tid() & 63;
    const int sl = lane >> 3, c = lane & 7;
    int x, wv, nwv;
    slice_assign4(x, wv, nwv);
    const unsigned coloff = (unsigned)x * (16384u * 128u) + (unsigned)c * 16u;
    const int n = (T_TOK - wv + nwv - 1) / nwv;
    if (n <= 0) return;
    const unsigned short* EID = (const unsigned short*)LIST;
    uint4 E0[2], E1[2], LE0[2], LE1[2], hA0, hB0, hA1, hB1, lhA0, lhB0, lhA1, lhB1, b0[8], b1[8], b2[8], b3[8];
    int in0, in1;
#define UTOK(I) ((unsigned)wv + __umul24((unsigned)(I), (unsigned)nwv))
#define U_LOAD_E(E, I) { const size_t t_ = UTOK(I); E[0] = nt_load_u4(EID + t_ * 128 + sl * 16); E[1] = nt_load_u4(EID + t_ * 128 + sl * 16 + 8); }
#define U_LOAD_H(HA, HB, I) { const size_t t_ = UTOK(I); HA = nt_load_u4(H8 + t_ * 1024 + x * 256 + c * 32); HB = nt_load_u4(H8 + t_ * 1024 + x * 256 + c * 32 + 16); }
#define U_STORE(I, K0, K1) { int* dst_ = PART + ((size_t)x * T_TOK + UTOK(I)) * 128 + sl * 16 + c; __builtin_nontemporal_store(K0, dst_); __builtin_nontemporal_store(K1, dst_ + 8); }
#define U_ROT(E, HA, HB, INI, LE, LHA, LHB)                                                                    \
    {                                                                                                           \
        asm volatile("" : "+v"(LE[0].x), "+v"(LE[0].y), "+v"(LE[0].z), "+v"(LE[0].w), "+v"(LE[1].x), "+v"(LE[1].y), "+v"(LE[1].z), "+v"(LE[1].w)); \
        asm volatile("" : "+v"(LHA.x), "+v"(LHA.y), "+v"(LHA.z), "+v"(LHA.w), "+v"(LHB.x), "+v"(LHB.y), "+v"(LHB.z), "+v"(LHB.w)); \
        E[0] = LE[0]; E[1] = LE[1]; HA = LHA; HB = LHB; INI = peer_u_init(LHA, LHB);                            \
    }
#define UCL(I) ((I) < n ? (I) : n - 1)
    U_LOAD_E(E0, 0)
    U_LOAD_E(E1, UCL(1))
    peer_issue(U4, E0, 0, coloff, b0);
    peer_issue(U4, E0, 1, coloff, b1);
    peer_issue(U4, E1, 0, coloff, b2);
    peer_issue(U4, E1, 1, coloff, b3);
    U_LOAD_E(LE0, UCL(2)) U_LOAD_H(lhA0, lhB0, 0)
    U_LOAD_E(LE1, UCL(3)) U_LOAD_H(lhA1, lhB1, UCL(1))
    U_ROT(E0, hA0, hB0, in0, LE0, lhA0, lhB0)
    U_ROT(E1, hA1, hB1, in1, LE1, lhA1, lhB1)
#pragma unroll 1
    for (int i = 0; i < n; i += 2) {
        U_LOAD_E(LE0, UCL(i + 4)) U_LOAD_H(lhA0, lhB0, UCL(i + 2))
        U_LOAD_E(LE1, UCL(i + 5)) U_LOAD_H(lhA1, lhB1, UCL(i + 3))
        {
            int k0 = 0, k1 = 0;
            peer_u_compute(b0, hA0, hB0, in0, c, k0);
            peer_issue(U4, E0, 0, coloff, b0);
            peer_u_compute(b1, hA0, hB0, in0, c, k1);
            peer_issue(U4, E0, 1, coloff, b1);
            U_STORE(i, k0, k1)
        }
        {
            int k0 = 0, k1 = 0;
            peer_u_compute(b2, hA1, hB1, in1, c, k0);
            peer_issue(U4, E1, 0, coloff, b2);
            peer_u_compute(b3, hA1, hB1, in1, c, k1);
            peer_issue(U4, E1, 1, coloff, b3);
            U_STORE(UCL(i + 1), k0, k1)
        }
        U_ROT(E0, hA0, hB0, in0, LE0, lhA0, lhB0)
        U_ROT(E1, hA1, hB1, in1, LE1, lhA1, lhB1)
    }
#undef UTOK
}

DI void phase_peer_act(const Params& p, char* ws, int layer) {
    (void)p;
    const unsigned short* EID = (const unsigned short*)(ws + OFF_R5);
    const unsigned short* GW = EID + (size_t)T_TOK * 128;
    const int* PART = (const int*)(ws + OFF_R3);
    unsigned short* ACT8 = (unsigned short*)(ws + OFF_R2);
    float* AS = (float*)(ws + OFF_AS);
    const float2* SC = (const float2*)(ws + OFF_SC) + (size_t)layer * 16384;
    const float* HS = (const float*)(ws + OFF_HS);
    const int tid = get_tid(), lane = tid & 63, wave = tid >> 6;
    for (int tb = (blockIdx.x * 4 + wave) * 8; tb < T_TOK; tb += gridDim.x * 32) {
        uint2 q[8][4];
        unsigned ew[8], gw[8];
        float hs[8];
#pragma unroll
        for (int u = 0; u < 8; ++u) {
            const size_t i = (size_t)(tb + u) * 128 + 2 * lane;
#pragma unroll
            for (int x = 0; x < 4; ++x) q[u][x] = *(const uint2*)(PART + (size_t)x * T_TOK * 128 + i);
            ew[u] = *(const unsigned*)(EID + i); gw[u] = *(const unsigned*)(GW + i);
            hs[u] = HS[tb + u];
        }
        float2 c0[8], c1[8];
#pragma unroll
        for (int u = 0; u < 8; ++u) { c0[u] = SC[ew[u] & 0xffffu]; c1[u] = SC[ew[u] >> 16]; }
        float a0[8], a1[8], am[8];
#pragma unroll
        for (int u = 0; u < 8; ++u) {
            const int s0 = (int)q[u][0].x + (int)q[u][1].x + (int)q[u][2].x + (int)q[u][3].x;
            const int s1 = (int)q[u][0].y + (int)q[u][1].y + (int)q[u][2].y + (int)q[u][3].y;
            a0[u] = gelu_tanh((float)s0 * c0[u].x * hs[u]) * __uint_as_float(gw[u] << 16) * c0[u].y;
            a1[u] = gelu_tanh((float)s1 * c1[u].x * hs[u]) * __uint_as_float(gw[u] & 0xffff0000u) * c1[u].y;
            am[u] = fmaxf(fabsf(a0[u]), fabsf(a1[u]));
        }
#pragma unroll
        for (int u = 0; u < 8; ++u) am[u] = wave_max_dpp(am[u]);
#pragma unroll
        for (int u = 0; u < 8; ++u) {
            const float qs = (am[u] > 0.f) ? 127.f / am[u] : 0.f;
            const int q0 = __float2int_rn(a0[u] * qs), q1 = __float2int_rn(a1[u] * qs);
            ACT8[(size_t)(tb + u) * 64 + lane] = (unsigned short)(((unsigned)q0 & 0xffu) | (((unsigned)q1 & 0xffu) << 8));
            if (lane == 0) AS[tb + u] = am[u] * (1.f / 127.f);
        }
    }
}

template <bool FIRST>
DI void peer_v_compute(const uint4 (&buf)[4], unsigned a4, int (&out)[32]) {
    unsigned sA = 0x05010400u, sB = 0x07030602u, sC = 0x05040100u, sD = 0x07060302u;
    asm volatile("" : "+s"(sA), "+s"(sB), "+s"(sC), "+s"(sD));
    const unsigned M = 0x0F0F0F0Fu;
    const unsigned r0[4] = {buf[0].x, buf[0].y, buf[0].z, buf[0].w}, r1[4] = {buf[1].x, buf[1].y, buf[1].z, buf[1].w};
    const unsigned r2[4] = {buf[2].x, buf[2].y, buf[2].z, buf[2].w}, r3[4] = {buf[3].x, buf[3].y, buf[3].z, buf[3].w};
#pragma unroll
    for (int d = 0; d < 4; ++d) {
        const unsigned t01l = __builtin_amdgcn_perm(r1[d], r0[d], sA);
        const unsigned t01h = __builtin_amdgcn_perm(r1[d], r0[d], sB);
        const unsigned t23l = __builtin_amdgcn_perm(r3[d], r2[d], sA);
        const unsigned t23h = __builtin_amdgcn_perm(r3[d], r2[d], sB);
        unsigned T[4];
        T[0] = __builtin_amdgcn_perm(t23l, t01l, sC);
        T[1] = __builtin_amdgcn_perm(t23l, t01l, sD);
        T[2] = __builtin_amdgcn_perm(t23h, t01h, sC);
        T[3] = __builtin_amdgcn_perm(t23h, t01h, sD);
#pragma unroll
        for (int m = 0; m < 4; ++m) {
            if (FIRST) {
                asm("v_dot4_i32_i8 %0, %1, %2, 0" : "=v"(out[8 * d + 2 * m]) : "v"(T[m] & M), "v"(a4));
                asm("v_dot4_i32_i8 %0, %1, %2, 0" : "=v"(out[8 * d + 2 * m + 1]) : "v"(T[m]), "v"(a4));
            } else {
                out[8 * d + 2 * m]     = __builtin_amdgcn_sdot4((int)(T[m] & M), (int)a4, out[8 * d + 2 * m], false);
                out[8 * d + 2 * m + 1] = __builtin_amdgcn_sdot4((int)T[m], (int)a4, out[8 * d + 2 * m + 1], false);
            }
        }
    }
    asm volatile("" : "+v"(out[0]), "+v"(out[1]), "+v"(out[2]), "+v"(out[3]), "+v"(out[4]), "+v"(out[5]), "+v"(out[6]), "+v"(out[7]));
    asm volatile("" : "+v"(out[8]), "+v"(out[9]), "+v"(out[10]), "+v"(out[11]), "+v"(out[12]), "+v"(out[13]), "+v"(out[14]), "+v"(out[15]));
    asm volatile("" : "+v"(out[16]), "+v"(out[17]), "+v"(out[18]), "+v"(out[19]), "+v"(out[20]), "+v"(out[21]), "+v"(out[22]), "+v"(out[23]));
    asm volatile("" : "+v"(out[24]), "+v"(out[25]), "+v"(out[26]), "+v"(out[27]), "+v"(out[28]), "+v"(out[29]), "+v"(out[30]), "+v"(out[31]));
}
DI void peer_issue4(const unsigned char* tab, unsigned w_lo, unsigned w_hi, unsigned coloff, uint4 (&buf)[4]) {
    asm volatile("" : "+v"(w_lo), "+v"(w_hi));
    buf[0] = *(const uint4*)(tab + ((w_lo & 0xffffu) * 128u + coloff));
    buf[1] = *(const uint4*)(tab + ((w_lo >> 16) * 128u + coloff));
    buf[2] = *(const uint4*)(tab + ((w_hi & 0xffffu) * 128u + coloff));
    buf[3] = *(const uint4*)(tab + ((w_hi >> 16) * 128u + coloff));
}
DI void peer_v_reduce(const int (&out)[32], int sl, int (&r4)[4]) {
    int r16[16];
#pragma unroll
    for (int k = 0; k < 16; ++k) {
        const auto q = __builtin_amdgcn_permlane32_swap((unsigned)out[k], (unsigned)out[16 + k], false, false);
        r16[k] = (int)q[0] + (int)q[1];
    }
    int r8[8];
#pragma unroll
    for (int k = 0; k < 8; ++k) {
        const auto q = __builtin_amdgcn_permlane16_swap((unsigned)r16[k], (unsigned)r16[8 + k], false, false);
        r8[k] = (int)q[0] + (int)q[1];
    }
#pragma unroll
    for (int k = 0; k < 4; ++k) {
        const int mine = (sl & 1) ? r8[4 + k] : r8[k];
        const int send = (sl & 1) ? r8[k] : r8[4 + k];
        r4[k] = mine + __builtin_amdgcn_mov_dpp(send, 0x128, 0xF, 0xF, true);
    }
}
DI int peer_v_asum(const uint4& a) {
    int sa = __builtin_amdgcn_sdot4((int)a.x, 0x01010101, 0, false);
    sa = __builtin_amdgcn_sdot4((int)a.y, 0x01010101, sa, false);
    sa = __builtin_amdgcn_sdot4((int)a.z, 0x01010101, sa, false);
    sa = __builtin_amdgcn_sdot4((int)a.w, 0x01010101, sa, false);
    { const auto q = __builtin_amdgcn_permlane32_swap((unsigned)sa, (unsigned)sa, false, false); sa = (int)q[0] + (int)q[1]; }
    { const auto q = __builtin_amdgcn_permlane16_swap((unsigned)sa, (unsigned)sa, false, false); sa = (int)q[0] + (int)q[1]; }
    sa += __builtin_amdgcn_mov_dpp(sa, 0x128, 0xF, 0xF, true);
    return sa;
}
template <bool DRY>
DI void phase_peer_v(const Params& p, char* ws, char* smem, int layer) {
    bf16_t* X = (bf16_t*)(ws + OFF_R1);
    bf16_t* XO = DRY ? (bf16_t*)p.out : X;
    const int lj = layer * 2 + 1;
    const float* mods = (const float*)(ws + OFF_MODS) + (size_t)lj * 16 * 3072;
    const unsigned short* EID = (const unsigned short*)(ws + OFF_R5);
    const unsigned char* ACT8 = (const unsigned char*)(ws + OFF_R2);
    const float* AS = (const float*)(ws + OFF_AS);
    const unsigned char* V4 = (const unsigned char*)(ws + OFF_R4) + TAB_V_OFF;
    const int tid = get_tid(), lane = tid & 63;
    const int sl = lane >> 3, c = lane & 7;
    int x, wv, nwv;
    slice_assign4(x, wv, nwv);
    float* Gs = (float*)smem;
    {
        float gt_[16];
#pragma unroll
        for (int u = 0; u < 16; ++u) gt_[u] = mods[(size_t)u * 3072 + 2048 + x * 256 + tid];
#pragma unroll
        for (int u = 0; u < 16; ++u) Gs[u * 256 + tid] = gt_[u];
    }
    __syncthreads();
    const unsigned coloff = (unsigned)x * (16384u * 128u) + (unsigned)c * 16u;
    const int n = (T_TOK - wv + nwv - 1) / nwv;
    if (n <= 0) return;
    const int colL = c * 32 + 4 * sl;
    const int col0 = x * 256 + colL;
    uint4 E0[2], E1[2], LE0[2], LE1[2], q0[4], q1[4], q2[4], q3[4];
    uint4 a0, a1, la0, la1;
    float as0, as1, las0, las1;
    u32x2_t x0, x1, lx0, lx1;
#define VTOK(I) ((unsigned)wv + __umul24((unsigned)(I), (unsigned)nwv))
#define VCL(I) ((I) < n ? (I) : n - 1)
#define V_LOAD_E(E, I) { const size_t t_ = VTOK(I); E[0] = nt_load_u4(EID + t_ * 128 + sl * 16); E[1] = nt_load_u4(EID + t_ * 128 + sl * 16 + 8); }
#define V_LOAD_M(A, ASV, XV, I)                                                                                \
    {                                                                                                           \
        const size_t t_ = VTOK(I);                                                                              \
        A = nt_load_u4(ACT8 + t_ * 128 + sl * 16);                                                              \
        ASV = AS[t_];                                                                                           \
        XV = __builtin_nontemporal_load((const u32x2_t*)(X + t_ * 1024 + col0));                                \
    }
#define V_ROT(E, A, ASV, XV, LE, LA, LASV, LXV)                                                                \
    {                                                                                                           \
        asm volatile("" : "+v"(LE[0].x), "+v"(LE[0].y), "+v"(LE[0].z), "+v"(LE[0].w), "+v"(LE[1].x), "+v"(LE[1].y), "+v"(LE[1].z), "+v"(LE[1].w)); \
        asm volatile("" : "+v"(LA.x), "+v"(LA.y), "+v"(LA.z), "+v"(LA.w), "+v"(LASV), "+v"(LXV.x), "+v"(LXV.y)); \
        E[0] = LE[0]; E[1] = LE[1]; A = LA; ASV = LASV; XV = LXV;                                               \
    }
#define V_SECTION(I, E, A, ASV, XV, DOIT)                                                                      \
    {                                                                                                           \
        int out[32];                                                                                            \
        peer_v_compute<true>(q0, A.x, out);                                                                     \
        peer_issue4(V4, E[0].x, E[0].y, coloff, q0);                                                            \
        peer_v_compute<false>(q1, A.y, out);                                                                           \
        peer_issue4(V4, E[0].z, E[0].w, coloff, q1);                                                            \
        peer_v_compute<false>(q2, A.z, out);                                                                           \
        peer_issue4(V4, E[1].x, E[1].y, coloff, q2);                                                            \
        peer_v_compute<false>(q3, A.w, out);                                                                           \
        peer_issue4(V4, E[1].z, E[1].w, coloff, q3);                                                            \
        int r4_[4];                                                                                             \
        peer_v_reduce(out, sl, r4_);                                                                            \
        const float sa_ = (float)peer_v_asum(A);                                                                \
        const unsigned tt_ = VTOK(I);                                                                           \
        const float4 g_ = *(const float4*)(Gs + (tt_ >> 11) * 256 + colL);                                     \
        const float xa_ = __uint_as_float(XV.x << 16), xb_ = __uint_as_float(XV.x & 0xffff0000u);               \
        const float xc_ = __uint_as_float(XV.y << 16), xd_ = __uint_as_float(XV.y & 0xffff0000u);               \
          \
        const float oa_ = xa_ + g_.x * (((float)r4_[0] - 7.5f * sa_) * (ASV));                                  \
        const float ob_ = xb_ + g_.y * (((float)(r4_[1] - r4_[0]) * 0.0625f + 0.5f * sa_) * (ASV));             \
        const float oc_ = xc_ + g_.z * (((float)r4_[2] - 7.5f * sa_) * (ASV));                                  \
        const float od_ = xd_ + g_.w * (((float)(r4_[3] - r4_[2]) * 0.0625f + 0.5f * sa_) * (ASV));             \
        u32x2_t ov__; ov__.x = pack2bf(oa_, ob_); ov__.y = pack2bf(oc_, od_);                                   \
        bf16_t* op__ = (DOIT) ? XO + (size_t)tt_ * 1024 + col0 : (bf16_t*)(ws + OFF_PTRS + 4096) + lane * 4;   \
        __builtin_nontemporal_store(ov__, (u32x2_t*)op__);                                                      \
    }
    V_LOAD_E(E0, 0)
    peer_issue4(V4, E0[0].x, E0[0].y, coloff, q0);
    peer_issue4(V4, E0[0].z, E0[0].w, coloff, q1);
    peer_issue4(V4, E0[1].x, E0[1].y, coloff, q2);
    peer_issue4(V4, E0[1].z, E0[1].w, coloff, q3);
    V_LOAD_E(LE0, VCL(1))
    V_LOAD_M(la0, las0, lx0, 0)
    V_LOAD_E(LE1, VCL(2))
    V_LOAD_M(la1, las1, lx1, VCL(1))
    V_ROT(E0, a0, as0, x0, LE0, la0, las0, lx0)
    V_ROT(E1, a1, as1, x1, LE1, la1, las1, lx1)
#pragma unroll 1
    for (int i = 0; i < n; i += 2) {
        V_LOAD_E(LE0, VCL(i + 3))
        V_LOAD_M(la0, las0, lx0, VCL(i + 2))
        V_LOAD_E(LE1, VCL(i + 4))
        V_LOAD_M(la1, las1, lx1, VCL(i + 3))
        V_SECTION(i, E0, a0, as0, x0, true)
        V_SECTION(VCL(i + 1), E1, a1, as1, x1, (i + 1 < n))
        V_ROT(E0, a0, as0, x0, LE0, la0, las0, lx0)
        V_ROT(E1, a1, as1, x1, LE1, la1, las1, lx1)
    }
#undef VTOK
}

DI void phase_rowquant(char* ws) {
    const bf16_t* S = (const bf16_t*)(ws + OFF_R4);
    unsigned char* H8 = (unsigned char*)(ws + OFF_R5 + 16ull * MiB);
    float* HS = (float*)(ws + OFF_HS);
    const int tid = get_tid(), lane = tid & 63, wave = tid >> 6;
    for (int tb = (blockIdx.x * 4 + wave) * 4; tb < T_TOK; tb += gridDim.x * 16) {
        uint4 q[4][2];
#pragma unroll
        for (int u = 0; u < 4; ++u)
#pragma unroll
            for (int i = 0; i < 2; ++i) q[u][i] = *(const uint4*)(S + (size_t)(tb + u) * 1024 + i * 512 + lane * 8);
#pragma unroll
        for (int u = 0; u < 4; ++u) {
            float v[16];
#pragma unroll
            for (int i = 0; i < 2; ++i) {
                const unsigned w[4] = {q[u][i].x, q[u][i].y, q[u][i].z, q[u][i].w};
#pragma unroll
                for (int e = 0; e < 4; ++e) { v[i * 8 + 2 * e] = __uint_as_float(w[e] << 16); v[i * 8 + 2 * e + 1] = __uint_as_float(w[e] & 0xffff0000u); }
            }
            float am = 0.f;
#pragma unroll
            for (int e = 0; e < 16; ++e) am = fmaxf(am, fabsf(v[e]));
            am = wave_max_dpp(am);
            const float qs = (am > 0.f) ? 127.f / am : 0.f;
#pragma unroll
            for (int i = 0; i < 2; ++i) {
                unsigned o[2];
#pragma unroll
                for (int d = 0; d < 2; ++d) {
                    const int q0 = __float2int_rn(v[i * 8 + d * 4 + 0] * qs), q1 = __float2int_rn(v[i * 8 + d * 4 + 1] * qs);
                    const int q2 = __float2int_rn(v[i * 8 + d * 4 + 2] * qs), q3 = __float2int_rn(v[i * 8 + d * 4 + 3] * qs);
                    o[d] = ((unsigned)q0 & 0xffu) | (((unsigned)q1 & 0xffu) << 8) | (((unsigned)q2 & 0xffu) << 16) | (((unsigned)q3 & 0xffu) << 24);
                }
                *(uint2*)(H8 + (size_t)(tb + u) * 1024 + i * 512 + lane * 8) = make_uint2(o[0], o[1]);
            }
            if (lane == 0) HS[tb + u] = am * (1.f / 127.f);
        }
    }
}

#define AK_LD 72
#define AV_LD 200
#define AP_LD 40
DI void phase_attn(const Params& p, char* ws, char* smem) {
    const bf16_t* Qa = (const bf16_t*)(ws + OFF_R3);
    const bf16_t* Ka = Qa + (size_t)T_TOK * 1024;
    const bf16_t* VT2 = Ka + (size_t)T_TOK * 128;
    bf16_t* ATT = (bf16_t*)(ws + OFF_R4);
    const int tid = get_tid(), lane = tid & 63, wave = tid >> 6;
    const int r = lane & 31, h = lane >> 5;
    bf16_t* Ks = (bf16_t*)smem;
    bf16_t* Vs = (bf16_t*)(smem + 27648);
    float* btab = (float*)(smem + 27648 + 25600);
    bf16_t* Pw = (bf16_t*)(smem + 27648 + 25600 + 4096) + (size_t)wave * 32 * AP_LD;
    for (int up = blockIdx.x; up < 512; up += gridDim.x) {
      for (int ku = 0; ku < 2; ++ku) {
        const int unit = up * 2 + ku;
        const int kvh = unit & 1, qh = (unit >> 1) & 31, b = unit >> 6;
        const size_t tb = (size_t)b * SEQ;
        const int Qh = qh * 64;
        const int Kb = Qh - 128;
        __syncthreads();
#pragma unroll
        for (int q = 0; q < 6; ++q) {
            const int c = tid + 256 * q, row = c >> 3, ch = c & 7;
            int kpos = Kb + row; if (kpos < 0) kpos = 0;
            *(uint4*)(Ks + row * AK_LD + ch * 8) = *(const uint4*)(Ka + (tb + kpos) * 128 + kvh * 64 + ch * 8);
        }
#pragma unroll
        for (int q = 0; q < 6; ++q) {
            const int c = tid + 256 * q, row = c / 24, ch = c % 24;
            int kpos = Kb + ch * 8; if (kpos < 0) kpos = 0;
            *(uint4*)(Vs + row * AV_LD + ch * 8) = *(const uint4*)(VT2 + ((size_t)b * 128 + kvh * 64 + row) * 2048 + kpos);
        }
        for (int i = tid; i < 8 * 128; i += 256) {
            const int g = i >> 7, n = i & 127;
            int bk = n;
            if (n >= 16) {
                const float lr = logf((float)n / 16.f) / 2.0794415416798357f;
                bk = 16 + (int)(lr * 16.f);
                if (bk > 31) bk = 31;
            }
            btab[i] = p.rel_bias[bk * 16 + kvh * 8 + g];
        }
        __syncthreads();
        for (int sub = 0; sub < 4; ++sub) {
            const int g = wave * 2 + (sub >> 1), qs = sub & 1;
            const int hq = kvh * 8 + g;
            const int Q0 = Qh + qs * 32;
            const int K0 = Q0 - 128;
            const int kl0 = K0 - Kb;
            f32x16 sacc[5];
            zero_acc<5>(sacc);
            {
                const bf16_t* Bq = Qa + (tb + Q0 + r) * 1024 + hq * 64 + h * 8;
                bf16x8 bq[4];
#pragma unroll
                for (int ks = 0; ks < 4; ++ks) bq[ks] = *(const bf16x8*)(Bq + ks * 16);
#pragma unroll
                for (int ks = 0; ks < 4; ++ks)
#pragma unroll
                    for (int kt = 0; kt < 5; ++kt)
                        sacc[kt] = MFMA32(*(const bf16x8*)(Ks + (kl0 + kt * 32 + r) * AK_LD + ks * 16 + h * 8), bq[ks], sacc[kt]);
            }
            const float sink = p.sinks[hq];
            float mx = sink;
#pragma unroll
            for (int kt = 0; kt < 5; ++kt)
#pragma unroll
                for (int i = 0; i < 16; ++i) {
                    const int kpos = K0 + kt * 32 + crow(i, h);
                    const int dist = Q0 + r - kpos;
                    float lg = NEG_INF_F;
                    if (dist >= 0 && dist < 128 && kpos >= 0) lg = sacc[kt][i] * 0.125f + btab[g * 128 + dist];
                    sacc[kt][i] = lg;
                    mx = fmaxf(mx, lg);
                }
            mx = fmaxf(mx, __shfl_xor(mx, 32));
            float sum = 0.f;
#pragma unroll
            for (int kt = 0; kt < 5; ++kt)
#pragma unroll
                for (int i = 0; i < 16; ++i) {
                    const float e = (sacc[kt][i] > -1e29f) ? __expf(sacc[kt][i] - mx) : 0.f;
                    sacc[kt][i] = e;
                    sum += e;
                }
            sum += __shfl_xor(sum, 32);
            sum += __expf(sink - mx);
            const float inv = 1.f / sum;
            f32x16 oacc[2];
            zero_acc<2>(oacc);
#pragma unroll
            for (int kt = 0; kt < 5; ++kt) {
#pragma unroll
                for (int q4 = 0; q4 < 4; ++q4) {
                    uint2 o;
                    o.x = pack2bf(sacc[kt][q4 * 4 + 0] * inv, sacc[kt][q4 * 4 + 1] * inv);
                    o.y = pack2bf(sacc[kt][q4 * 4 + 2] * inv, sacc[kt][q4 * 4 + 3] * inv);
                    *(uint2*)(Pw + r * AP_LD + q4 * 8 + h * 4) = o;
                }
#pragma unroll
                for (int ks = 0; ks < 2; ++ks) {
                    const bf16x8 ap = *(const bf16x8*)(Pw + r * AP_LD + ks * 16 + h * 8);
#pragma unroll
                    for (int nt = 0; nt < 2; ++nt)
                        oacc[nt] = MFMA32(ap, *(const bf16x8*)(Vs + (nt * 32 + r) * AV_LD + kl0 + kt * 32 + ks * 16 + h * 8), oacc[nt]);
                }
            }
            {
                bf16_t* ab = ATT + (tb + Q0 + 4 * h) * 1024 + hq * 64 + r;
#pragma unroll
                for (int i4 = 0; i4 < 4; ++i4) {
                    bf16_t* a2 = ab + (size_t)i4 * 8 * 1024;
                    LAUNDER(a2);
#pragma unroll
                    for (int ii = 0; ii < 4; ++ii)
#pragma unroll
                        for (int nt = 0; nt < 2; ++nt) a2[ii * 1024 + nt * 32] = f2bf(oacc[nt][i4 * 4 + ii]);
                }
            }
        }
      }
      {
        asm volatile("s_waitcnt vmcnt(0)" ::: "memory");
        __syncthreads();
        const int b = up >> 5, qh = up & 31;
        unsigned char* H8 = (unsigned char*)(ws + OFF_R5 + 16ull * MiB);
        float* HS = (float*)(ws + OFF_HS);
        const size_t trow0 = (size_t)b * SEQ + qh * 64 + wave * 16;
#pragma unroll 1
        for (int rb = 0; rb < 16; rb += 4) {
            uint4 q[4][2];
#pragma unroll
            for (int u = 0; u < 4; ++u)
#pragma unroll
                for (int i = 0; i < 2; ++i) q[u][i] = *(const uint4*)(ATT + (trow0 + rb + u) * 1024 + i * 512 + lane * 8);
#pragma unroll
            for (int u = 0; u < 4; ++u) {
                float v[16];
#pragma unroll
                for (int i = 0; i < 2; ++i) {
                    const unsigned w[4] = {q[u][i].x, q[u][i].y, q[u][i].z, q[u][i].w};
#pragma unroll
                    for (int e = 0; e < 4; ++e) { v[i * 8 + 2 * e] = __uint_as_float(w[e] << 16); v[i * 8 + 2 * e + 1] = __uint_as_float(w[e] & 0xffff0000u); }
                }
                float am = 0.f;
#pragma unroll
                for (int e = 0; e < 16; ++e) am = fmaxf(am, fabsf(v[e]));
                am = wave_max_dpp(am);
                const float qs = (am > 0.f) ? 127.f / am : 0.f;
#pragma unroll
                for (int i = 0; i < 2; ++i) {
                    unsigned o[2];
#pragma unroll
                    for (int d = 0; d < 2; ++d) {
                        const int q0 = __float2int_rn(v[i * 8 + d * 4 + 0] * qs), q1 = __float2int_rn(v[i * 8 + d * 4 + 1] * qs);
                        const int q2 = __float2int_rn(v[i * 8 + d * 4 + 2] * qs), q3 = __float2int_rn(v[i * 8 + d * 4 + 3] * qs);
                        o[d] = ((unsigned)q0 & 0xffu) | (((unsigned)q1 & 0xffu) << 8) | (((unsigned)q2 & 0xffu) << 16) | (((unsigned)q3 & 0xffu) << 24);
                    }
                    *(uint2*)(H8 + (trow0 + rb + u) * 1024 + i * 512 + lane * 8) = make_uint2(o[0], o[1]);
                }
                if (lane == 0) HS[trow0 + rb + u] = am * (1.f / 127.f);
            }
        }
      }
    }
    __syncthreads();
}

DI void phase_final(const Params& p, const bf16_t* __restrict__ X) {
    const int tid = get_tid(), lane = tid & 63, wave = tid >> 6;
    for (int t = blockIdx.x * 4 + wave; t < T_TOK; t += gridDim.x * 4) {
        float xv[16];
        float ss = 0.f;
#pragma unroll
        for (int i = 0; i < 4; ++i) {
            const uint2 q = *(const uint2*)(X + (size_t)t * 1024 + i * 256 + lane * 4);
            const float4 v = make_float4(__uint_as_float(q.x << 16), __uint_as_float(q.x & 0xffff0000u), __uint_as_float(q.y << 16), __uint_as_float(q.y & 0xffff0000u));
            xv[i * 4 + 0] = v.x; xv[i * 4 + 1] = v.y; xv[i * 4 + 2] = v.z; xv[i * 4 + 3] = v.w;
            ss += v.x * v.x + v.y * v.y + v.z * v.z + v.w * v.w;
        }
        ss = wave_sum_dpp(ss);
        const float rinv = rsqrtf(ss * (1.f / 1024.f) + 1e-6f);
#pragma unroll
        for (int i = 0; i < 4; ++i) {
            const int col = i * 256 + lane * 4;
            const float4 g4 = *(const float4*)(p.final_g + col);
            float4 o;
            o.x = xv[i * 4 + 0] * rinv * g4.x; o.y = xv[i * 4 + 1] * rinv * g4.y;
            o.z = xv[i * 4 + 2] * rinv * g4.z; o.w = xv[i * 4 + 3] * rinv * g4.w;
            *(float4*)(p.out + (size_t)t * 1024 + col) = o;
        }
    }
}

#define NPHASES 25
template <int PH>
DI void run_phase(const Params& pk, char* smem) {
    typedef __attribute__((address_space(1))) char gchar_t;
    gchar_t* wsg = (gchar_t*)pk.ws;
    asm volatile("" : "+s"(wsg));
    char* ws = (char*)wsg;
    Params p;
    if (PH == 0) {
        p = pk;
        if (threadIdx.x < 29) {
            const void* v = pk.x;
            switch (threadIdx.x) {
                case 0: v = pk.x; break; case 1: v = pk.c; break; case 2: v = pk.ada_w; break; case 3: v = pk.ada_b; break;
                case 4: v = pk.norm_g; break; case 5: v = pk.w_in; break; case 6: v = pk.b_if; break; case 7: v = pk.conv_w; break;
                case 8: v = pk.conv_b; break; case 9: v = pk.w_q; break; case 10: v = pk.w_k; break; case 11: v = pk.head_g; break;
                case 12: v = pk.skip; break; case 13: v = pk.pool_w; break; case 14: v = pk.pool_scale; break; case 15: v = pk.w_out; break;
                case 16: v = pk.w_qkv; break; case 17: v = pk.b_qkv; break; case 18: v = pk.sinks; break; case 19: v = pk.w_o; break;
                case 20: v = pk.b_o; break; case 21: v = pk.rel_bias; break; case 22: v = pk.peer_wq; break; case 23: v = pk.peer_keys; break;
                case 24: v = pk.peer_u; break; case 25: v = pk.peer_v; break; case 26: v = pk.final_g; break; case 27: v = pk.out; break;
                default: v = pk.ws; break;
            }
            ((const void**)(ws + OFF_PTRS))[threadIdx.x] = v;
        }
    } else {
        const float* const* tab = (const float* const*)(ws + OFF_PTRS);
        p.x = tab[0]; p.c = tab[1]; p.ada_w = tab[2]; p.ada_b = tab[3]; p.norm_g = tab[4]; p.w_in = tab[5]; p.b_if = tab[6]; p.conv_w = tab[7];
        p.conv_b = tab[8]; p.w_q = tab[9]; p.w_k = tab[10]; p.head_g = tab[11]; p.skip = tab[12]; p.pool_w = tab[13]; p.pool_scale = tab[14];
        p.w_out = tab[15]; p.w_qkv = tab[16]; p.b_qkv = tab[17]; p.sinks = tab[18]; p.w_o = tab[19]; p.b_o = tab[20]; p.rel_bias = tab[21];
        p.peer_wq = tab[22]; p.peer_keys = tab[23]; p.peer_u = tab[24]; p.peer_v = tab[25]; p.final_g = tab[26]; p.out = (float*)tab[27]; p.ws = ws;
    }
    bf16_t* X = (bf16_t*)(ws + OFF_R1);
    const float* mods = (const float*)(ws + OFF_MODS);
    if (PH == 0) { phase_pre_mods(p, ws, smem); phase_pre_scoremat(p, ws, smem); }
    else if (PH == 1) { phase_adanorm<true, true, false>(p, ws, p.x, 0, smem); phase_pre_weights(p, ws, smem); }
    else if (PH == 2) { GemmArgs ga{}; ga.A = (const bf16_t*)(ws + OFF_R5 + 16ull * MiB); ga.Bt = (const bf16_t*)(ws + OFF_WINT); ga.N = 2048; ga.hs = (const float*)(ws + OFF_HS); ga.wsc = (const float*)(ws + OFF_WSC); phase_gemm<GM_INPROJ, true>(p, ws, ga, smem); }
    else if (PH == 3) {   }
    else if (PH == 4) phase_m1b(p, ws, smem);
    else if (PH == 5) phase_m2(p, ws);
    else if (PH == 6) phase_m3(p, ws, smem);
    else if (PH == 7) {
        GemmArgs ga{}; ga.A = (const bf16_t*)(ws + OFF_R5 + 16ull * MiB); ga.Bt = (const bf16_t*)(ws + OFF_WOUTT); ga.N = 1024;
        ga.hs = (const float*)(ws + OFF_HS); ga.wsc = (const float*)(ws + OFF_WSC) + 7424;
        ga.xin = p.x; ga.xout = X; ga.gate = mods + (size_t)0 * 16 * 3072 + 2048; ga.bias = nullptr;
        phase_gemm<GM_RESID, true>(p, ws, ga, smem);
    }
    else if (PH == 8) phase_adanorm<false, true, true>(p, ws, X, 1, smem);
    else if (PH == 9) { GemmArgs ga{}; ga.A = (const bf16_t*)(ws + OFF_R5 + 16ull * MiB); ga.Bt = (const bf16_t*)(ws + OFF_WPQT); ga.N = 2048; ga.out = (bf16_t*)(ws + OFF_R3); ga.hs = (const float*)(ws + OFF_HS); ga.wsc = (const float*)(ws + OFF_WSC) + 3328; phase_gemm<GM_PLAIN, true>(p, ws, ga, smem); }
    else if (PH == 10) phase_topk(p, ws, 0, smem);
    else if (PH == 11) phase_peer_u(p, ws, 0);
    else if (PH == 12) phase_peer_act(p, ws, 0);
    else if (PH == 13) phase_peer_v<false>(p, ws, smem, 0);
    else if (PH == 14) phase_adanorm<false, true, true>(p, ws, X, 2, smem);
    else if (PH == 15) { GemmArgs ga{}; ga.A = (const bf16_t*)(ws + OFF_R5 + 16ull * MiB); ga.Bt = (const bf16_t*)(ws + OFF_WQKVT); ga.N = 1280; ga.hs = (const float*)(ws + OFF_HS); ga.wsc = (const float*)(ws + OFF_WSC) + 2048; phase_gemm<GM_QKV, true>(p, ws, ga, smem); }
    else if (PH == 16) phase_attn(p, ws, smem);
    else if (PH == 17 || PH == 27) {
        GemmArgs ga{}; ga.A = (const bf16_t*)(ws + OFF_R5 + 16ull * MiB); ga.Bt = (const bf16_t*)(ws + OFF_WOT); ga.N = 1024;
        ga.hs = (const float*)(ws + OFF_HS); ga.wsc = (const float*)(ws + OFF_WSC) + 8448;
        ga.xin = X; ga.xout = (PH == 27) ? (bf16_t*)p.out : X; ga.gate = mods + (size_t)2 * 16 * 3072 + 2048; ga.bias = p.b_o;
        phase_gemm<GM_RESID_BF, true>(p, ws, ga, smem);
    }
    else if (PH == 18) phase_adanorm<false, true, true>(p, ws, X, 3, smem);
    else if (PH == 19) { GemmArgs ga{}; ga.A = (const bf16_t*)(ws + OFF_R5 + 16ull * MiB); ga.Bt = (const bf16_t*)(ws + OFF_WPQT + (size_t)2048 * 1024); ga.N = 2048; ga.out = (bf16_t*)(ws + OFF_R3); ga.hs = (const float*)(ws + OFF_HS); ga.wsc = (const float*)(ws + OFF_WSC) + 5376; phase_gemm<GM_PLAIN, true>(p, ws, ga, smem); }
    else if (PH == 20) phase_topk(p, ws, 1, smem);
    else if (PH == 21) phase_peer_u(p, ws, 1);
    else if (PH == 22) phase_peer_act(p, ws, 1);
    else if (PH == 23) phase_peer_v<false>(p, ws, smem, 1);
    else if (PH == 24) phase_final(p, X);
    else if (PH == 25) phase_peer_v<true>(p, ws, smem, 0);
    else if (PH == 26) phase_peer_v<true>(p, ws, smem, 1);
    else if (PH == 29) phase_rowquant(ws);
}

extern __shared__ __attribute__((aligned(16))) char dyn_smem[];

#define LDS_GEMM 73728
#define LDS_BYTES (LDS_GEMM + 16)

#if !ONE_LAUNCH
template <int PH>
__global__ void __launch_bounds__(256, 2) k_phase(Params p) { run_phase<PH>(p, dyn_smem); }

template <int PH>
static void launch_phase(const Params& p, int grid, hipStream_t stream) {
    (void)hipFuncSetAttribute((const void*)k_phase<PH>, hipFuncAttributeMaxDynamicSharedMemorySize, LDS_BYTES);
    hipLaunchKernelGGL(k_phase<PH>, dim3(grid), dim3(256), LDS_BYTES, stream, p);
}
template <int PH>
static void launch_all(const Params& p, int grid, hipStream_t stream) {
    launch_phase<PH>(p, grid, stream);
    if constexpr (PH + 1 < NPHASES) launch_all<PH + 1>(p, grid, stream);
}
#else
template <int PH>
DI void fused_from(const Params& p, volatile LAS unsigned* st) {
    run_phase<PH>(p, dyn_smem);
    if ((PROBE_MASK >> PH) & 1u) run_phase<(PH == 13) ? 25 : (PH == 23) ? 26 : (PH == 17) ? 27 : PH>(p, dyn_smem);
    if constexpr (PH == 6) {
        { XcdBarrier bar_; bar_.bar = (unsigned*)(p.ws + OFF_BAR); bar_.x = xb_xcc_id(); bar_.st = st; xcd_barrier(bar_); }
        run_phase<29>(p, dyn_smem);
    }
    if constexpr (PH + 1 < NPHASES && PH != 3) {
        { XcdBarrier bar_; bar_.bar = (unsigned*)(p.ws + OFF_BAR); bar_.x = xb_xcc_id(); bar_.st = st; xcd_barrier(bar_); }
        fused_from<PH + 1>(p, st);
    } else if constexpr (PH + 1 < NPHASES) {
        fused_from<PH + 1>(p, st);
    }
}
__global__ void __launch_bounds__(256, 2) k_fused(Params p) {
    volatile LAS unsigned* st = (volatile LAS unsigned*)(dyn_smem + LDS_GEMM);
    if (threadIdx.x == 0) { st[0] = 0u; st[1] = 0u; st[2] = 0u; st[3] = 0u; }
    __syncthreads();
    (void)xcd_barrier_post((unsigned*)(p.ws + OFF_BAR), st);
    fused_from<0>(p, st);
}
#endif

extern "C" void kernel_launch(void* const* d_in, const int* in_sizes, int n_in, void* d_out, int out_size, void* d_ws, size_t ws_size,
                              hipStream_t stream) {
    (void)in_sizes; (void)n_in; (void)out_size;
    Params p{};
    const float** pp = (const float**)&p;
    for (int i = 0; i < 27; ++i) pp[i] = (const float*)d_in[i];
    p.out = (float*)d_out;
    p.ws = (char*)d_ws;
    if (ws_size < WS_NEEDED) fprintf(stderr, "workspace too small: %zu < %llu\n", ws_size, (unsigned long long)WS_NEEDED);
#if !ONE_LAUNCH
    const int grid = 512;
    launch_all<0>(p, grid, stream);
#else
    static int grid = 0;
    if (!grid) {
        int dev = 0, cus = 0, per_cu = 0;
        (void)hipGetDevice(&dev);
        (void)hipDeviceGetAttribute(&cus, hipDeviceAttributeMultiprocessorCount, dev);
        (void)hipFuncSetAttribute((const void*)k_fused, hipFuncAttributeMaxDynamicSharedMemorySize, LDS_BYTES);
        (void)hipOccupancyMaxActiveBlocksPerMultiprocessor(&per_cu, (const void*)k_fused, 256, LDS_BYTES);
        if (per_cu < 1) per_cu = 1;
        if (cus < 1) cus = 256;
        grid = cus * (per_cu < 2 ? per_cu : 2);
    }
    (void)hipMemsetAsync(d_ws, 0, XCD_BAR_WORDS * sizeof(unsigned), stream);
    hipLaunchKernelGGL(k_fused, dim3(grid), dim3(256), LDS_BYTES, stream, p);
#endif
}
```
